# Optimizing an MI355X kernel written in HIP

```python
import math
import jax
import jax.numpy as jnp
from jax import lax
import numpy as np


D_MODEL = 1024
BATCH = 1
SEQ = 16384
DEPTH = 2

CHUNK = 64
Q_BLOCK = 128
N_MEM = 256
HEAD_DIM = 64
EPS = 1e-6
A_HEADS = D_MODEL // (2 * HEAD_DIM)
IDX_HEADS = 8
IDX_DIM = 64
TOPK_MAX = 256
B_VDIM = 2 * HEAD_DIM
B_HEADS = D_MODEL // (2 * B_VDIM)
C_HEADS = D_MODEL // HEAD_DIM
C_BAND = 9
REL_CLIP = 256
T5_BUCKETS = 32
T5_MAX_DIST = 128
T5_HEADS = A_HEADS + B_HEADS
M_HEADS = 4
M_DIM = 128
D_FF = 2816

kernel_name = 'hybrid_chunk_causal_encoder'


def even_split_sizes():
    return [A_HEADS * HEAD_DIM, A_HEADS * HEAD_DIM, A_HEADS * HEAD_DIM,
            IDX_HEADS * IDX_DIM, IDX_DIM, IDX_HEADS,
            B_HEADS * 2 * HEAD_DIM, B_HEADS * 2 * HEAD_DIM, B_HEADS * B_VDIM]


def rmsnorm(x, g):
    xf = x.astype(jnp.float32)
    y = xf * lax.rsqrt(jnp.mean(xf * xf, axis=-1, keepdims=True) + EPS)
    return (y * g.astype(jnp.float32)).astype(x.dtype)


def swiglu(x, wg, wu, wd):
    return (jax.nn.silu(x @ wg) * (x @ wu)) @ wd


def t5_bucket(rel):
    nb = T5_BUCKETS // 2
    max_exact = nb // 2
    offset = (rel < 0).astype(jnp.int32) * nb
    n = jnp.abs(rel)
    nf = jnp.maximum(n, 1).astype(jnp.float32)
    large = max_exact + (jnp.log(nf / max_exact) / math.log(T5_MAX_DIST / max_exact)
                         * (nb - max_exact)).astype(jnp.int32)
    large = jnp.minimum(large, nb - 1)
    return offset + jnp.where(n < max_exact, n, large)


def dsa_attention(q, k, v, iq, ik, iw, bias_table):
    bsz, seq, heads, dh = q.shape
    top_k = min(TOPK_MAX, seq // 4)
    key_chunk = jnp.arange(seq, dtype=jnp.int32) // CHUNK
    bias_table = bias_table.astype(jnp.float32)

    def block(i):
        start = i * Q_BLOCK
        qpos = start + jnp.arange(Q_BLOCK, dtype=jnp.int32)
        qchunk = qpos // CHUNK
        qb = lax.dynamic_slice_in_dim(q, start, Q_BLOCK, axis=1)
        iqb = lax.dynamic_slice_in_dim(iq, start, Q_BLOCK, axis=1)
        iwb = lax.dynamic_slice_in_dim(iw, start, Q_BLOCK, axis=1).astype(jnp.float32) * IDX_HEADS ** -0.5
        idx_logits = jnp.einsum('bqhd,bsd->bqhs', iqb, ik).astype(jnp.float32) * IDX_DIM ** -0.5
        score = jnp.einsum('bqh,bqhs->bqs', iwb, jax.nn.relu(idx_logits))
        admissible = key_chunk[None, :] <= qchunk[:, None]
        score = jnp.where(admissible[None], score, -jnp.inf)
        _, sel = lax.top_k(score, top_k)
        valid = (sel // CHUNK) <= qchunk[None, :, None]
        kg = jax.vmap(lambda kk, ii: kk[ii])(k, sel)
        vg = jax.vmap(lambda vv, ii: vv[ii])(v, sel)
        logits = jnp.einsum('bqhd,bqkhd->bhqk', qb, kg).astype(jnp.float32) * dh ** -0.5
        bias = bias_table[t5_bucket(qpos[None, :, None] - sel)]
        logits = logits + jnp.transpose(bias, (0, 3, 1, 2))
        logits = jnp.where(valid[:, None], logits, -jnp.inf)
        p = jax.nn.softmax(logits, axis=-1).astype(v.dtype)
        return jnp.einsum('bhqk,bqkhd->bqhd', p, vg)

    out = lax.map(block, jnp.arange(seq // Q_BLOCK, dtype=jnp.int32))
    return jnp.transpose(out, (1, 0, 2, 3, 4)).reshape(bsz, seq, heads * dh)


def diff_attention(q, k, v, lam, subln_g, bias_table):
    bsz, seq, heads, _, dh = q.shape
    pos = jnp.arange(seq, dtype=jnp.int32)
    key_chunk = pos // CHUNK
    bias_table = bias_table.astype(jnp.float32)

    def block(i):
        start = i * Q_BLOCK
        qpos = start + jnp.arange(Q_BLOCK, dtype=jnp.int32)
        qb = lax.dynamic_slice_in_dim(q, start, Q_BLOCK, axis=1)
        logits = jnp.einsum('bqhmd,bshmd->bhmqs', qb, k).astype(jnp.float32) * dh ** -0.5
        bias = bias_table[t5_bucket(qpos[:, None] - pos[None, :])]
        logits = logits + jnp.transpose(bias, (2, 0, 1))[None, :, None]
        mask = key_chunk[None, :] <= (qpos // CHUNK)[:, None]
        logits = jnp.where(mask, logits, -jnp.inf)
        p = jax.nn.softmax(logits, axis=-1)
        attn = (p[:, :, 0] - lam * p[:, :, 1]).astype(v.dtype)
        o = jnp.einsum('bhqs,bshe->bqhe', attn, v)
        return rmsnorm(o, subln_g)

    out = lax.map(block, jnp.arange(seq // Q_BLOCK, dtype=jnp.int32))
    return jnp.transpose(out, (1, 0, 2, 3, 4)).reshape(bsz, seq, heads * v.shape[-1])


def chunk_band_attention(q, k, v, rel_bias):
    bsz, seq, heads, dh = q.shape
    pad = (C_BAND - 1) * CHUNK
    band = C_BAND * CHUNK
    kp = jnp.pad(k, ((0, 0), (pad, 0), (0, 0), (0, 0)))
    vp = jnp.pad(v, ((0, 0), (pad, 0), (0, 0), (0, 0)))
    qoff = jnp.arange(CHUNK, dtype=jnp.int32)
    koff = jnp.arange(band, dtype=jnp.int32)
    rel = (qoff[:, None] + pad) - koff[None, :]
    rel_idx = jnp.clip(rel, -REL_CLIP, REL_CLIP) + REL_CLIP
    bias = jnp.transpose(rel_bias.astype(jnp.float32)[rel_idx], (2, 0, 1))

    def one_chunk(c):
        qc = lax.dynamic_slice_in_dim(q, c * CHUNK, CHUNK, axis=1)
        kc = lax.dynamic_slice_in_dim(kp, c * CHUNK, band, axis=1)
        vc = lax.dynamic_slice_in_dim(vp, c * CHUNK, band, axis=1)
        valid = (c * CHUNK - pad + koff) >= 0
        logits = jnp.einsum('bqhd,bkhd->bhqk', qc, kc).astype(jnp.float32) * dh ** -0.5 + bias[None]
        logits = jnp.where(valid, logits, -jnp.inf)
        p = jax.nn.softmax(logits, axis=-1).astype(vc.dtype)
        return jnp.einsum('bhqk,bkhd->bqhd', p, vc)

    out = lax.map(one_chunk, jnp.arange(seq // CHUNK, dtype=jnp.int32))
    return jnp.transpose(out, (1, 0, 2, 3, 4)).reshape(bsz, seq, heads * dh)


def even_mixer(h, w_in, a_qg, a_kg, idx_kg, b_qg, b_kg, lq1, lk1, lq2, lk2, b_subln, w_out, t5_bias, layer_idx):
    bsz, seq, _ = h.shape
    cuts = [int(c) for c in np.cumsum(even_split_sizes())[:-1]]
    aq, ak, av, iq, ik, iw, bq, bk, bv = jnp.split(h @ w_in, cuts, axis=-1)
    aq = rmsnorm(aq.reshape(bsz, seq, A_HEADS, HEAD_DIM), a_qg)
    ak = rmsnorm(ak.reshape(bsz, seq, A_HEADS, HEAD_DIM), a_kg)
    av = av.reshape(bsz, seq, A_HEADS, HEAD_DIM)
    iq = iq.reshape(bsz, seq, IDX_HEADS, IDX_DIM)
    ik = rmsnorm(ik, idx_kg)
    out_a = dsa_attention(aq, ak, av, iq, ik, iw, t5_bias[:, :A_HEADS])
    bq = rmsnorm(bq.reshape(bsz, seq, B_HEADS, 2, HEAD_DIM), b_qg)
    bk = rmsnorm(bk.reshape(bsz, seq, B_HEADS, 2, HEAD_DIM), b_kg)
    bv = bv.reshape(bsz, seq, B_HEADS, B_VDIM)
    lambda_init = 0.8 - 0.6 * math.exp(-0.3 * layer_idx)
    lam = (jnp.exp(jnp.sum(lq1.astype(jnp.float32) * lk1.astype(jnp.float32)))
           - jnp.exp(jnp.sum(lq2.astype(jnp.float32) * lk2.astype(jnp.float32))) + lambda_init)
    out_b = diff_attention(bq, bk, bv, lam, b_subln, t5_bias[:, A_HEADS:]) * (1.0 - lambda_init)
    return jnp.concatenate([out_a, out_b], axis=-1) @ w_out


def odd_mixer(h, w_in, c_qg, c_kg, rel_bias, w_out):
    bsz, seq, _ = h.shape
    q, k, v = jnp.split(h @ w_in, 3, axis=-1)
    q = rmsnorm(q.reshape(bsz, seq, C_HEADS, HEAD_DIM), c_qg)
    k = rmsnorm(k.reshape(bsz, seq, C_HEADS, HEAD_DIM), c_kg)
    v = v.reshape(bsz, seq, C_HEADS, HEAD_DIM)
    return chunk_band_attention(q, k, v, rel_bias) @ w_out


def memory_xattn(h, m, wq, wkv, qg, kg, wo):
    bsz, seq, _ = h.shape
    q = rmsnorm((h @ wq).reshape(bsz, seq, M_HEADS, M_DIM), qg)
    k, v = jnp.split(m @ wkv, 2, axis=-1)
    k = rmsnorm(k.reshape(bsz, -1, M_HEADS, M_DIM), kg)
    v = v.reshape(bsz, -1, M_HEADS, M_DIM)
    logits = jnp.einsum('bshd,bmhd->bhsm', q, k).astype(jnp.float32) * M_DIM ** -0.5
    p = jax.nn.softmax(logits, axis=-1).astype(v.dtype)
    o = jnp.einsum('bhsm,bmhd->bshd', p, v).reshape(bsz, seq, M_HEADS * M_DIM)
    return o @ wo


def setup_inputs(seed: int = 0) -> dict:
    key = jax.random.key(seed)
    counter = [0]

    def nk():
        counter[0] += 1
        return jax.random.fold_in(key, counter[0])

    def dense(fan_in, fan_out):
        return jax.random.normal(nk(), (fan_in, fan_out), jnp.float32) * fan_in ** -0.5

    def gain(n):
        return 1.0 + 0.02 * jax.random.normal(nk(), (n,), jnp.float32)

    def small(shape, scale):
        return scale * jax.random.normal(nk(), shape, jnp.float32)

    p = {}
    p['x'] = jax.random.normal(nk(), (BATCH, SEQ, D_MODEL), jnp.float32)
    p['mem'] = jax.random.normal(nk(), (BATCH, N_MEM, D_MODEL), jnp.float32)
    p['t5_bias'] = small((T5_BUCKETS, T5_HEADS), 0.2)
    for layer in range(DEPTH):
        pre = 'l%d_' % layer
        p[pre + 'ffn1_norm'] = gain(D_MODEL)
        p[pre + 'ffn1_wg'] = dense(D_MODEL, D_FF)
        p[pre + 'ffn1_wu'] = dense(D_MODEL, D_FF)
        p[pre + 'ffn1_wd'] = dense(D_FF, D_MODEL)
        p[pre + 'mix_norm'] = gain(D_MODEL)
        if layer % 2 == 0:
            p[pre + 'w_in'] = dense(D_MODEL, sum(even_split_sizes()))
            p[pre + 'a_q_norm'] = gain(HEAD_DIM)
            p[pre + 'a_k_norm'] = gain(HEAD_DIM)
            p[pre + 'idx_k_norm'] = gain(IDX_DIM)
            p[pre + 'b_q_norm'] = gain(HEAD_DIM)
            p[pre + 'b_k_norm'] = gain(HEAD_DIM)
            p[pre + 'b_lq1'] = small((HEAD_DIM,), 0.1)
            p[pre + 'b_lk1'] = small((HEAD_DIM,), 0.1)
            p[pre + 'b_lq2'] = small((HEAD_DIM,), 0.1)
            p[pre + 'b_lk2'] = small((HEAD_DIM,), 0.1)
            p[pre + 'b_subln'] = gain(B_VDIM)
            p[pre + 'w_out'] = dense(A_HEADS * HEAD_DIM + B_HEADS * B_VDIM, D_MODEL)
        else:
            p[pre + 'w_in'] = dense(D_MODEL, 3 * C_HEADS * HEAD_DIM)
            p[pre + 'c_q_norm'] = gain(HEAD_DIM)
            p[pre + 'c_k_norm'] = gain(HEAD_DIM)
            p[pre + 'c_rel_bias'] = small((2 * REL_CLIP + 1, C_HEADS), 0.2)
            p[pre + 'w_out'] = dense(C_HEADS * HEAD_DIM, D_MODEL)
        p[pre + 'mem_norm'] = gain(D_MODEL)
        p[pre + 'mem_src_norm'] = gain(D_MODEL)
        p[pre + 'mem_wq'] = dense(D_MODEL, M_HEADS * M_DIM)
        p[pre + 'mem_wkv'] = dense(D_MODEL, 2 * M_HEADS * M_DIM)
        p[pre + 'mem_q_norm'] = gain(M_DIM)
        p[pre + 'mem_k_norm'] = gain(M_DIM)
        p[pre + 'mem_wo'] = dense(M_HEADS * M_DIM, D_MODEL)
        p[pre + 'ffn2_norm'] = gain(D_MODEL)
        p[pre + 'ffn2_wg'] = dense(D_MODEL, D_FF)
        p[pre + 'ffn2_wu'] = dense(D_MODEL, D_FF)
        p[pre + 'ffn2_wd'] = dense(D_FF, D_MODEL)
    return p


def reference(x, mem, t5_bias,
              l0_ffn1_norm, l0_ffn1_wg, l0_ffn1_wu, l0_ffn1_wd,
              l0_mix_norm, l0_w_in, l0_a_q_norm, l0_a_k_norm, l0_idx_k_norm,
              l0_b_q_norm, l0_b_k_norm, l0_b_lq1, l0_b_lk1, l0_b_lq2, l0_b_lk2, l0_b_subln, l0_w_out,
              l0_mem_norm, l0_mem_src_norm, l0_mem_wq, l0_mem_wkv, l0_mem_q_norm, l0_mem_k_norm, l0_mem_wo,
              l0_ffn2_norm, l0_ffn2_wg, l0_ffn2_wu, l0_ffn2_wd,
              l1_ffn1_norm, l1_ffn1_wg, l1_ffn1_wu, l1_ffn1_wd,
              l1_mix_norm, l1_w_in, l1_c_q_norm, l1_c_k_norm, l1_c_rel_bias, l1_w_out,
              l1_mem_norm, l1_mem_src_norm, l1_mem_wq, l1_mem_wkv, l1_mem_q_norm, l1_mem_k_norm, l1_mem_wo,
              l1_ffn2_norm, l1_ffn2_wg, l1_ffn2_wu, l1_ffn2_wd):
    ffn1 = [(l0_ffn1_norm, l0_ffn1_wg, l0_ffn1_wu, l0_ffn1_wd),
            (l1_ffn1_norm, l1_ffn1_wg, l1_ffn1_wu, l1_ffn1_wd)]
    mix = [(l0_mix_norm, (l0_w_in, l0_a_q_norm, l0_a_k_norm, l0_idx_k_norm, l0_b_q_norm, l0_b_k_norm,
                          l0_b_lq1, l0_b_lk1, l0_b_lq2, l0_b_lk2, l0_b_subln, l0_w_out)),
           (l1_mix_norm, (l1_w_in, l1_c_q_norm, l1_c_k_norm, l1_c_rel_bias, l1_w_out))]
    memx = [(l0_mem_norm, l0_mem_src_norm, l0_mem_wq, l0_mem_wkv, l0_mem_q_norm, l0_mem_k_norm, l0_mem_wo),
            (l1_mem_norm, l1_mem_src_norm, l1_mem_wq, l1_mem_wkv, l1_mem_q_norm, l1_mem_k_norm, l1_mem_wo)]
    ffn2 = [(l0_ffn2_norm, l0_ffn2_wg, l0_ffn2_wu, l0_ffn2_wd),
            (l1_ffn2_norm, l1_ffn2_wg, l1_ffn2_wu, l1_ffn2_wd)]
    h = x
    for layer in range(DEPTH):
        g, wg, wu, wd = ffn1[layer]
        h = h + 0.5 * swiglu(rmsnorm(h, g), wg, wu, wd)
        mix_g, mix_params = mix[layer]
        if layer % 2 == 0:
            h = h + even_mixer(rmsnorm(h, mix_g), *mix_params, t5_bias, layer)
        else:
            h = h + odd_mixer(rmsnorm(h, mix_g), *mix_params)
        mg, sg, wq, wkv, qg, kg, wo = memx[layer]
        h = h + memory_xattn(rmsnorm(h, mg), rmsnorm(mem, sg), wq, wkv, qg, kg, wo)
        g, wg, wu, wd = ffn2[layer]
        h = h + 0.5 * swiglu(rmsnorm(h, g), wg, wu, wd)
    return h
```

```cpp
#include <hip/hip_runtime.h>
#include <hip/hip_cooperative_groups.h>
#include <cstdio>
#include <cstdint>
namespace cg = cooperative_groups;

#define LAS __attribute__((address_space(3)))
typedef unsigned short bf16_t;
typedef short bf16x8 __attribute__((ext_vector_type(8)));
typedef short s16x4 __attribute__((ext_vector_type(4)));
typedef float f32x4 __attribute__((ext_vector_type(4)));
typedef float f32x2 __attribute__((ext_vector_type(2)));
typedef float f32x16 __attribute__((ext_vector_type(16)));
typedef unsigned u32x4 __attribute__((ext_vector_type(4)));
typedef unsigned u32x2 __attribute__((ext_vector_type(2)));
typedef int i32x4 __attribute__((ext_vector_type(4)));

constexpr int S = 16384, D = 1024, FF = 2816, NMEM = 256;
constexpr float EPS = 1e-6f;
constexpr float LOG2E = 1.4426950408889634f;
constexpr int NWIN0 = 3840, NWINQ = 3072, NWINI = 768;

constexpr size_t MiB = 1u << 20;
constexpr size_t WS_RS = 4 * MiB;
constexpr size_t WS_RSM = 6 * MiB;
constexpr size_t WS_QS = 6 * MiB + 64 * 1024;
constexpr size_t WS_SB = 6 * MiB + 128 * 1024;
constexpr size_t WS_LUT5 = 640 * 1024;
constexpr size_t WS_LUTB = 656 * 1024;
constexpr size_t WS_MISC = 700 * 1024;
constexpr size_t WS_BAR = 768 * 1024;
constexpr size_t WS_KVRAW = 1 * MiB;
constexpr size_t WS_KVRAW2 = 7 * MiB;
constexpr size_t WS_KMEM = 2 * MiB;
constexpr size_t WS_VMEM = 2 * MiB + 512 * 1024;
constexpr size_t WS_MEMB = 3 * MiB;
constexpr size_t WS_W = 8 * MiB;
constexpr size_t W_GU1 = WS_W, W_D1 = W_GU1 + (size_t)2 * FF * D * 2, W_GU2 = W_D1 + (size_t)D * FF * 2, W_D2 = W_GU2 + (size_t)2 * FF * D * 2;
constexpr size_t W_IN = W_D2 + (size_t)D * FF * 2, W_OUT = W_IN + (size_t)NWIN0 * D * 2, W_Q = W_OUT + (size_t)D * D * 2, W_KV = W_Q + (size_t)512 * D * 2, W_O = W_KV + (size_t)D * D * 2;
constexpr size_t W_END = W_O + (size_t)D * 512 * 2;
constexpr size_t W_KV2 = W_END;
static_assert(W_KV2 + (size_t)D * D * 2 <= 58 * MiB, "w_kv2 slot");
constexpr size_t W_INI = W_IN + 4 * MiB;
constexpr size_t WS_HB = 58 * MiB;
constexpr size_t WS_OCAT = 90 * MiB;
constexpr size_t WS_R = 122 * MiB;
constexpr size_t WS_END = 256 * MiB;
static_assert(W_END <= WS_HB, "weights fit");
constexpr size_t R_ACT = 0;
constexpr size_t R_AQ = 0, R_AK = 16 * MiB, R_AV = 32 * MiB, R_IQ = 48 * MiB, R_BQ = 64 * MiB, R_BK = 80 * MiB, R_BV = 96 * MiB, R_IK = 112 * MiB, R_IW = 114 * MiB;
constexpr size_t R_CQ = 0, R_CK = 32 * MiB, R_CV = 64 * MiB;
constexpr size_t R_QM = 96 * MiB, R_OM = 112 * MiB;
static_assert(WS_R + R_OM + 16 * MiB <= WS_END && WS_R + R_IW + MiB <= WS_END, "region R");

constexpr int LDS_BYTES = 160 * 1024 - 2048;
constexpr int NTHREADS = 512;
constexpr int MISC_OFF = LDS_BYTES - 256;

__device__ __forceinline__ unsigned cvt_pk_bf16(float lo, float hi) { unsigned r; asm("v_cvt_pk_bf16_f32 %0, %1, %2" : "=v"(r) : "v"(lo), "v"(hi)); return r; }
__device__ __forceinline__ unsigned f2bf(float f) { unsigned u = __builtin_bit_cast(unsigned, f); return (u + 0x7fffu + ((u >> 16) & 1u)) >> 16; }
__device__ __forceinline__ float bf2f(unsigned short b) { return __builtin_bit_cast(float, ((unsigned)b) << 16); }
__device__ __forceinline__ float wave_sum(float v) {
#pragma unroll
    for (int o = 1; o < 64; o <<= 1) v += __shfl_xor(v, o);
    return v;
}

__device__ __forceinline__ float sum_xor16(float x) { const unsigned u = __float_as_uint(x); auto r = __builtin_amdgcn_permlane16_swap(u, u, false, false); return __uint_as_float(r[0]) + __uint_as_float(r[1]); }
__device__ __forceinline__ float sum_xor32(float x) { const unsigned u = __float_as_uint(x); auto r = __builtin_amdgcn_permlane32_swap(u, u, false, false); return __uint_as_float(r[0]) + __uint_as_float(r[1]); }

namespace pg8 {
constexpr int BM = 256, BK = 64, HALF = 128, HTB = HALF * BK * 2, STAGE_BYTES = 8 * HTB, NXCD = 8, WGM = 8;
__host__ __device__ __forceinline__ int lds_byte(int r, int c) { const int st = (r >> 4) * 2 + (c >> 5), rr = r & 15, cc = c & 31, ob = rr * 64 + cc * 2; return st * 1024 + (ob ^ (((ob >> 9) & 1) << 5)); }
__host__ __device__ __forceinline__ void stage_rc(int b, int& R, int& C) { const int st = b / 1024, sb = b % 1024, swz = sb ^ (((sb >> 9) & 1) << 5); R = (st >> 1) * 16 + swz / 64; C = (st & 1) * 32 + (swz % 64) / 2; }
struct Unit { int pm, pn, ui; };
struct Gemm { const bf16_t* A; const bf16_t* Bt; int M, N, K; };
struct StaticOrder {
    int nM, nN, nwg, G, c;
    __device__ void init(int M, int N, int G_, int c_) { nM = M / BM; nN = N / BM; nwg = nM * nN; G = G_; c = c_; }
    __device__ bool next(int i, Unit& u) const {
        const long L = (long)i * G + c; if (L >= nwg) return false;
        int wgid = (int)L; { const int q = nwg / NXCD, r = nwg % NXCD, xcd = wgid % NXCD, off = wgid / NXCD; wgid = (xcd < r ? xcd * (q + 1) : r * (q + 1) + (xcd - r) * q) + off; }
        const int nig = WGM * nN, gid = wgid / nig, fm = gid * WGM, gsz = (nM - fm) < WGM ? (nM - fm) : WGM;
        u.pm = fm + ((wgid % nig) % gsz); u.pn = (wgid % nig) / gsz; u.ui = i; return true;
    }
};

template <class Epi>
__device__ __forceinline__ void gemm_phase(LAS unsigned char* lds, const Gemm g, const StaticOrder& S, const Epi& E) {
    int tid = threadIdx.x; asm volatile("" : "+v"(tid));
    const int wid = __builtin_amdgcn_readfirstlane(tid >> 6), lane = tid & 63, wr = wid >> 2, wc = wid & 3, fr = lane & 15, fq = lane >> 4;
    const int K = g.K, nt = K / BK;
    unsigned voffA[2];
#pragma unroll
    for (int i = 0; i < 2; ++i) { int R, C; stage_rc(tid * 16 + i * 8192, R, C); voffA[i] = (unsigned)(R * K + C) * 2u; }
    const size_t kstep = (size_t)(BK * 2);
    const size_t hstep = (size_t)HALF * K * 2;
    const size_t tstep = 2 * hstep;
    const unsigned ldsw = (unsigned)wid * 1024u;
    const int aoff = lds_byte(wr * 64 + fr, fq * 8), boff = lds_byte(wc * 32 + fr, fq * 8);
#define PG8_SA(b, h) (((b) * 2 + (h)) * HTB)
#define PG8_SB(b, h) ((4 + (b) * 2 + (h)) * HTB)
#define PG8_STAGE(bufoff, gbase) do { _Pragma("unroll") for (int _i = 0; _i < 2; ++_i) \
        __builtin_amdgcn_global_load_lds((const unsigned*)((const char*)(gbase) + voffA[_i]), (LAS unsigned*)(lds + (bufoff) + ldsw + _i * 8192), 16, 0, 0); } while (0)
#define PG8_LDA(dst, b, h) do { _Pragma("unroll") for (int m = 0; m < 4; ++m) _Pragma("unroll") for (int k = 0; k < 2; ++k) dst[m][k] = *(const LAS bf16x8*)(lds + PG8_SA(b, h) + aoff + m * 2048 + k * 1024); } while (0)
#define PG8_LDB(dst, b, h) do { _Pragma("unroll") for (int n = 0; n < 2; ++n) _Pragma("unroll") for (int k = 0; k < 2; ++k) dst[n][k] = *(const LAS bf16x8*)(lds + PG8_SB(b, h) + boff + n * 2048 + k * 1024); } while (0)
#define PG8_MMA(ai, bj, At, Bt) do { __builtin_amdgcn_s_setprio(1); _Pragma("unroll") for (int m = 0; m < 4; ++m) _Pragma("unroll") for (int n = 0; n < 2; ++n) _Pragma("unroll") for (int k = 0; k < 2; ++k) { \
        if constexpr (Epi::I8) acc[ai][bj][m][n] = __builtin_amdgcn_mfma_i32_16x16x64_i8(__builtin_bit_cast(i32x4, Bt[n][k]), __builtin_bit_cast(i32x4, At[m][k]), acc[ai][bj][m][n], 0, 0, 0); \
        else acc[ai][bj][m][n] = __builtin_amdgcn_mfma_f32_16x16x32_bf16(Bt[n][k], At[m][k], acc[ai][bj][m][n], 0, 0, 0); } __builtin_amdgcn_s_setprio(0); } while (0)
#define PG8_WAIT_V(n) asm volatile("s_waitcnt vmcnt(" #n ")" ::: "memory")
#define PG8_WAIT_L(n) asm volatile("s_waitcnt lgkmcnt(" #n ")" ::: "memory")
#define PG8_BAR __builtin_amdgcn_s_barrier()
#define PG8_SCHED __builtin_amdgcn_sched_barrier(0)
    Unit cur, nxt; int ui = 0;
    if (!S.next(0, cur)) return;
    using acc_t = typename Epi::acc_t;
    acc_t acc[2][2][4][2];
#pragma unroll
    for (int a = 0; a < 2; ++a)
#pragma unroll
        for (int b = 0; b < 2; ++b)
#pragma unroll
            for (int m = 0; m < 4; ++m)
#pragma unroll
                for (int n = 0; n < 2; ++n) acc[a][b][m][n] = acc_t{};
    bf16x8 At[4][2], B0[2][2], B1[2][2];
    const char* cA = (const char*)g.A + (size_t)cur.pm * tstep; const char* cB = (const char*)g.Bt + (size_t)cur.pn * tstep;
    PG8_STAGE(PG8_SB(0, 0), cB); PG8_STAGE(PG8_SB(0, 1), cB + hstep); PG8_STAGE(PG8_SA(0, 0), cA); PG8_STAGE(PG8_SA(0, 1), cA + hstep);
    if (wr == 1) PG8_BAR;
    PG8_WAIT_V(2); PG8_BAR;
    PG8_STAGE(PG8_SB(1, 0), cB + kstep); PG8_STAGE(PG8_SA(1, 0), cA + kstep); PG8_STAGE(PG8_SB(1, 1), cB + hstep + kstep);
    PG8_WAIT_V(6); PG8_BAR;
    for (;;) {
        const bool has_next = S.next(ui + 1, nxt);
        const char* nA = has_next ? (const char*)g.A + (size_t)nxt.pm * tstep : cA; const char* nB = has_next ? (const char*)g.Bt + (size_t)nxt.pn * tstep : cB;
        for (int t = 0; t < nt; t += 2) {
            const bool last = (t == nt - 2);
            const char* a1 = cA + (size_t)(t + 1) * kstep;
            const char* a2 = last ? nA : cA + (size_t)(t + 2) * kstep; const char* b2 = last ? nB : cB + (size_t)(t + 2) * kstep;
            const char* a3 = a2 + kstep; const char* b3 = b2 + kstep;
            PG8_LDB(B0, 0, 0); PG8_LDB(B1, 0, 1); PG8_SCHED; PG8_LDA(At, 0, 0); PG8_STAGE(PG8_SA(1, 1), a1 + hstep);
            PG8_WAIT_V(8); PG8_WAIT_L(0); PG8_BAR; PG8_MMA(0, 0, At, B0); PG8_MMA(0, 1, At, B1); PG8_BAR; PG8_SCHED;
            PG8_LDA(At, 0, 1); PG8_STAGE(PG8_SB(0, 0), b2); PG8_STAGE(PG8_SB(0, 1), b2 + hstep); PG8_STAGE(PG8_SA(0, 0), a2);
            PG8_WAIT_V(8); PG8_WAIT_L(0); PG8_BAR; PG8_MMA(1, 0, At, B0); PG8_MMA(1, 1, At, B1); PG8_BAR; PG8_SCHED;
            PG8_LDB(B0, 1, 0); PG8_LDB(B1, 1, 1); PG8_SCHED; PG8_LDA(At, 1, 0); PG8_STAGE(PG8_SA(0, 1), a2 + hstep);
            PG8_WAIT_V(8); PG8_WAIT_L(0); PG8_BAR; PG8_MMA(0, 0, At, B0); PG8_MMA(0, 1, At, B1); PG8_BAR; PG8_SCHED;
            PG8_LDA(At, 1, 1); PG8_STAGE(PG8_SB(1, 0), b3); PG8_STAGE(PG8_SB(1, 1), b3 + hstep); PG8_STAGE(PG8_SA(1, 0), a3);
            PG8_WAIT_V(8); PG8_WAIT_L(0); PG8_BAR; PG8_MMA(1, 0, At, B0); PG8_MMA(1, 1, At, B1); PG8_BAR; PG8_SCHED;
        }
        if (wr == 0) PG8_BAR;
        E(acc, cur, wr, wc, fr, fq);
        if (!has_next) break;
#pragma unroll
        for (int a = 0; a < 2; ++a)
#pragma unroll
            for (int b = 0; b < 2; ++b)
#pragma unroll
                for (int m = 0; m < 4; ++m)
#pragma unroll
                    for (int n = 0; n < 2; ++n) acc[a][b][m][n] = acc_t{};
        cur = nxt; cA = nA; cB = nB; ++ui;
        if (wr == 1) PG8_BAR;
    }
    PG8_WAIT_V(0);
    PG8_BAR;
#undef PG8_SA
#undef PG8_SB
#undef PG8_STAGE
#undef PG8_LDA
#undef PG8_LDB
#undef PG8_MMA
#undef PG8_WAIT_V
#undef PG8_WAIT_L
#undef PG8_BAR
#undef PG8_SCHED
}
}
using pg8::Unit;

__device__ __forceinline__ void load_rstd(const float* parts, int row0, int fq, float (&rs)[2][4]) {
    float s[2][4];
#pragma unroll
    for (int ai = 0; ai < 2; ++ai)
#pragma unroll
        for (int m = 0; m < 4; ++m) { const f32x4 a = *(const f32x4*)(parts + (size_t)(row0 + ai * 128 + m * 16) * 16 + 4 * fq);
            s[ai][m] = (a[0] + a[1]) + (a[2] + a[3]); }
#pragma unroll
    for (int ai = 0; ai < 2; ++ai)
#pragma unroll
        for (int m = 0; m < 4; ++m) { float t = sum_xor32(sum_xor16(s[ai][m])); rs[ai][m] = __builtin_amdgcn_rsqf(t * (1.0f / D) + EPS); }
}
struct EpiGU {
    using acc_t = f32x4; static constexpr bool I8 = false;
    bf16_t* act; const float* rowss;
    __device__ __forceinline__ void operator()(const f32x4 (&acc)[2][2][4][2], const Unit& u, int wr, int wc, int fr, int fq) const {
        const int row0 = u.pm * 256 + wr * 64 + fr, col0 = u.pn * 128 + wc * 32 + fq * 8;
        float rs[2][4]; load_rstd(rowss, row0, fq, rs);
#pragma unroll
        for (int ai = 0; ai < 2; ++ai)
#pragma unroll
            for (int m = 0; m < 4; ++m) {
                const float r = rs[ai][m]; float o[8];
#pragma unroll
                for (int bj = 0; bj < 2; ++bj)
#pragma unroll
                    for (int j = 0; j < 4; ++j) { const float gt = acc[ai][bj][m][0][j] * r, up = acc[ai][bj][m][1][j] * r;
                        o[bj * 4 + j] = gt * up * __builtin_amdgcn_rcpf(1.0f + __builtin_amdgcn_exp2f(-gt * LOG2E)); }
                u32x4 w; w.x = cvt_pk_bf16(o[0], o[1]); w.y = cvt_pk_bf16(o[2], o[3]); w.z = cvt_pk_bf16(o[4], o[5]); w.w = cvt_pk_bf16(o[6], o[7]);
                *(u32x4*)(act + (size_t)(row0 + ai * 128 + m * 16) * FF + col0) = w;
            }
    }
};
struct EpiGUq {
    using acc_t = i32x4; static constexpr bool I8 = true;
    bf16_t* act; const LAS float* tab;
    __device__ __forceinline__ void operator()(const i32x4 (&acc)[2][2][4][2], const Unit& u, int wr, int wc, int fr, int fq) const {
        const int row0 = u.pm * 256 + wr * 64 + fr, col0 = u.pn * 128 + wc * 32 + fq * 8;
        const LAS float* R = tab + u.ui * 512;
        f32x2 c1[2][2], c2[2][2];
#pragma unroll
        for (int bj = 0; bj < 2; ++bj) {
            const f32x4 x1 = *(const LAS f32x4*)(R + 256 + bj * 128 + wc * 32 + 4 * fq), x2 = *(const LAS f32x4*)(R + 256 + bj * 128 + wc * 32 + 16 + 4 * fq);
#pragma unroll
            for (int jp = 0; jp < 2; ++jp) { c1[bj][jp] = f32x2{x1[2 * jp], x1[2 * jp + 1]}; c2[bj][jp] = f32x2{x2[2 * jp], x2[2 * jp + 1]}; }
        }
#pragma unroll
        for (int ai = 0; ai < 2; ++ai)
#pragma unroll
            for (int m = 0; m < 4; ++m) {
                const int row = row0 + ai * 128 + m * 16; const float r = R[wr * 64 + fr + ai * 128 + m * 16]; const f32x2 r1{r, r}, r2{r * r, r * r}; u32x4 w;
#pragma unroll
                for (int bj = 0; bj < 2; ++bj)
#pragma unroll
                    for (int jp = 0; jp < 2; ++jp) {
                        const f32x2 ag{(float)acc[ai][bj][m][0][2 * jp], (float)acc[ai][bj][m][0][2 * jp + 1]}, au{(float)acc[ai][bj][m][1][2 * jp], (float)acc[ai][bj][m][1][2 * jp + 1]};
                        const f32x2 x = (ag * c1[bj][jp]) * r1, p = (ag * au) * c2[bj][jp];
                        f32x2 d{__builtin_amdgcn_exp2f(x[0]), __builtin_amdgcn_exp2f(x[1])}; d = d + f32x2{1.0f, 1.0f};
                        const f32x2 o = p * (f32x2{__builtin_amdgcn_rcpf(d[0]), __builtin_amdgcn_rcpf(d[1])} * r2);
                        w[bj * 2 + jp] = cvt_pk_bf16(o[0], o[1]);
                    }
                *(u32x4*)(act + (size_t)row * FF + col0) = w;
            }
    }
};
template <bool GU, class SO>
__device__ __forceinline__ void guq_prep(LAS float* tab, const SO& so, const float* rowss, const float* qs, const float* sb) {
    int tid = threadIdx.x; asm volatile("" : "+v"(tid));
    pg8::Unit u;
    for (int i = 0; so.next(i, u); ++i) {
        LAS float* R = tab + i * 512;
        if (tid < 256) {
            const int row = u.pm * 256 + tid; const f32x4* p = (const f32x4*)(rowss + (size_t)row * 16);
            const f32x4 s = (p[0] + p[1]) + (p[2] + p[3]);
            R[tid] = __builtin_amdgcn_rsqf(((s[0] + s[1]) + (s[2] + s[3])) * (1.0f / D) + EPS) * qs[row];
        } else {
            const int c = tid - 256;
            if constexpr (GU) { if (!(c & 16)) { const float sg = sb[u.pn * 256 + c], su = sb[u.pn * 256 + c + 16]; R[256 + c] = sg * -LOG2E; R[256 + c + 16] = sg * su; } }
            else R[256 + c] = sb[u.pn * 256 + c];
        }
    }
    __syncthreads();
}
constexpr float QRANGE = 4.5f;
__device__ __forceinline__ unsigned q8_pack4(f32x4 v, float q) {
    int a0 = (int)__builtin_rintf(v[0] * q), a1 = (int)__builtin_rintf(v[1] * q), a2 = (int)__builtin_rintf(v[2] * q), a3 = (int)__builtin_rintf(v[3] * q);
    a0 = min(max(a0, -127), 127); a1 = min(max(a1, -127), 127); a2 = min(max(a2, -127), 127); a3 = min(max(a3, -127), 127);
    return (unsigned)(a0 & 0xff) | ((unsigned)(a1 & 0xff) << 8) | ((unsigned)(a2 & 0xff) << 16) | ((unsigned)a3 << 24);
}
__device__ __forceinline__ f32x4 bf2_lo4(unsigned a, unsigned b) { return f32x4{__uint_as_float(a << 16), __uint_as_float(a & 0xffff0000u), __uint_as_float(b << 16), __uint_as_float(b & 0xffff0000u)}; }
template <bool HALF, bool BF, bool OF, bool Q> struct EpiRes {
    using acc_t = f32x4; static constexpr bool I8 = false;
    static constexpr float scale = HALF ? 0.5f : 1.0f;
    const void* base; void* out; signed char* hq; float* rowss_out; float* qs; const float* prev_parts;
    __device__ __forceinline__ void operator()(const f32x4 (&acc)[2][2][4][2], const Unit& u, int wr, int wc, int fr, int fq) const {
        const int row0 = u.pm * 256 + wr * 64 + fr, col0 = u.pn * 256 + wc * 32 + fq * 8;
        float rp[2][4];
        u32x4 bw[4][2];
        if constexpr (!BF) {
#pragma unroll
            for (int r = 0; r < 4; ++r)
#pragma unroll
                for (int bj = 0; bj < 2; ++bj) bw[r][bj] = *(const u32x4*)((const bf16_t*)base + (size_t)(row0 + r * 16) * D + col0 + bj * 128);
        }
        if constexpr (Q) load_rstd(prev_parts, row0, fq, rp);
#pragma unroll
        for (int r = 0; r < 8; ++r) {
            const int ai = r >> 2, m = r & 3;
            const int row = row0 + ai * 128 + m * 16; float ss = 0.f;
            float q = 0.f; if constexpr (Q) q = (127.0f / QRANGE) * rp[ai][m];
#pragma unroll
            for (int bj = 0; bj < 2; ++bj) {
                const size_t off = (size_t)row * D + col0 + bj * 128;
                f32x4 b0, b1;
                if constexpr (BF) { b0 = *(const f32x4*)((const float*)base + off); b1 = *(const f32x4*)((const float*)base + off + 4); }
                else { b0 = bf2_lo4(bw[m][bj].x, bw[m][bj].y); b1 = bf2_lo4(bw[m][bj].z, bw[m][bj].w); }
                const f32x4 h0 = b0 + acc[ai][bj][m][0] * scale, h1 = b1 + acc[ai][bj][m][1] * scale;
                if constexpr (OF) { *(f32x4*)((float*)out + off) = h0; *(f32x4*)((float*)out + off + 4) = h1; }
                else { u32x4 w; w.x = cvt_pk_bf16(h0[0], h0[1]); w.y = cvt_pk_bf16(h0[2], h0[3]); w.z = cvt_pk_bf16(h1[0], h1[1]); w.w = cvt_pk_bf16(h1[2], h1[3]); *(u32x4*)((bf16_t*)out + off) = w; }
                if constexpr (Q) { u32x2 w; w.x = q8_pack4(h0, q); w.y = q8_pack4(h1, q); *(u32x2*)(hq + off) = w; }
                ss += (h0[0] * h0[0] + h0[1] * h0[1]) + (h0[2] * h0[2] + h0[3] * h0[3]) + (h1[0] * h1[0] + h1[1] * h1[1]) + (h1[2] * h1[2] + h1[3] * h1[3]);
            }
            if constexpr (!BF) { if (r < 4) {
#pragma unroll
                for (int bj = 0; bj < 2; ++bj) bw[m][bj] = *(const u32x4*)((const bf16_t*)base + (size_t)(row0 + 128 + m * 16) * D + col0 + bj * 128); } }
            if constexpr (Q) { if (u.pn == 0 && wc == 0 && fq == 0) qs[row] = 1.0f / q; }
            if (rowss_out) { ss = sum_xor32(sum_xor16(ss)); if (fq == 0) rowss_out[(size_t)row * 16 + u.pn * 4 + wc] = ss; }
        }
    }
};

struct EpiBf16 {
    using acc_t = f32x4; static constexpr bool I8 = false;
    bf16_t* out; int ldc; const float* rowss;
    __device__ __forceinline__ void operator()(const f32x4 (&acc)[2][2][4][2], const Unit& u, int wr, int wc, int fr, int fq) const {
        const int row0 = u.pm * 256 + wr * 64 + fr, col0 = u.pn * 256 + wc * 32 + fq * 8;
        float rs[2][4]; load_rstd(rowss, row0, fq, rs);
#pragma unroll
        for (int ai = 0; ai < 2; ++ai)
#pragma unroll
            for (int m = 0; m < 4; ++m)
#pragma unroll
                for (int bj = 0; bj < 2; ++bj) { const f32x4 v0 = acc[ai][bj][m][0] * rs[ai][m], v1 = acc[ai][bj][m][1] * rs[ai][m];
                    u32x4 w; w.x = cvt_pk_bf16(v0[0], v0[1]); w.y = cvt_pk_bf16(v0[2], v0[3]); w.z = cvt_pk_bf16(v1[0], v1[1]); w.w = cvt_pk_bf16(v1[2], v1[3]);
                    *(u32x4*)(out + (size_t)(row0 + ai * 128 + m * 16) * ldc + col0 + bj * 128) = w; }
    }
};
struct EpiF32 {
    using acc_t = f32x4; static constexpr bool I8 = false;
    float* out; int ldc; const float* rowss;
    __device__ __forceinline__ void operator()(const f32x4 (&acc)[2][2][4][2], const Unit& u, int wr, int wc, int fr, int fq) const {
        const int row0 = u.pm * 256 + wr * 64 + fr, col0 = u.pn * 256 + wc * 32 + fq * 8;
        float rs[2][4]; load_rstd(rowss, row0, fq, rs);
#pragma unroll
        for (int ai = 0; ai < 2; ++ai)
#pragma unroll
            for (int m = 0; m < 4; ++m)
#pragma unroll
                for (int bj = 0; bj < 2; ++bj) { float* p = out + (size_t)(row0 + ai * 128 + m * 16) * ldc + col0 + bj * 128;
                    *(f32x4*)p = acc[ai][bj][m][0] * rs[ai][m]; *(f32x4*)(p + 4) = acc[ai][bj][m][1] * rs[ai][m]; }
    }
};
constexpr float C2 = 0.125f * LOG2E;
template <bool Q> struct WinAcc { using t = f32x4; }; template <> struct WinAcc<true> { using t = i32x4; };
template <int V> struct EpiWin {
    static constexpr bool I8 = (V != 2); using acc_t = typename WinAcc<I8>::t;
    unsigned char* R; const float* rowss; const LAS float* tab; const float* g0; const float* g1; const float* g2; const float* g3;
    template <bool NORM>
    __device__ __forceinline__ void emit(const acc_t (&acc)[2][2][4][2], int row0, int fq, const float (&rs)[2][4], const f32x4 (&cs)[2][2], bf16_t* out, int pitch, const float* gain, float post) const {
        f32x4 gv[2][2];
#pragma unroll
        for (int bj = 0; bj < 2; ++bj)
#pragma unroll
            for (int n = 0; n < 2; ++n) gv[bj][n] = NORM ? *(const f32x4*)(gain + 32 * bj + 8 * fq + 4 * n) * post : (f32x4){1.f, 1.f, 1.f, 1.f};
#pragma unroll
        for (int ai = 0; ai < 2; ++ai)
#pragma unroll
            for (int m = 0; m < 4; ++m) {
                f32x4 v[2][2]; float ss = 0.f;
#pragma unroll
                for (int bj = 0; bj < 2; ++bj)
#pragma unroll
                    for (int n = 0; n < 2; ++n) {
                        if constexpr (I8) v[bj][n] = __builtin_convertvector(acc[ai][bj][m][n], f32x4) * (cs[bj][n] * rs[ai][m]); else v[bj][n] = acc[ai][bj][m][n] * rs[ai][m];
                        const f32x4 t = v[bj][n]; ss += (t[0] * t[0] + t[1] * t[1]) + (t[2] * t[2] + t[3] * t[3]); }
                float inv = 1.f;
                if (NORM) { ss = sum_xor32(sum_xor16(ss)); inv = __builtin_amdgcn_rsqf(ss * (1.0f / 64.0f) + EPS); }
#pragma unroll
                for (int bj = 0; bj < 2; ++bj) { const f32x4 a = v[bj][0] * gv[bj][0] * inv, b = v[bj][1] * gv[bj][1] * inv;
                    u32x4 w; w.x = cvt_pk_bf16(a[0], a[1]); w.y = cvt_pk_bf16(a[2], a[3]); w.z = cvt_pk_bf16(b[0], b[1]); w.w = cvt_pk_bf16(b[2], b[3]);
                    *(u32x4*)(out + (size_t)(row0 + ai * 128 + m * 16) * pitch + 32 * bj + 8 * fq) = w; }
            }
    }
    __device__ __forceinline__ void operator()(const acc_t (&acc)[2][2][4][2], const Unit& u, int wr, int wc, int fr, int fq) const {
        const int row0 = u.pm * 256 + wr * 64 + fr; const int g = 4 * u.pn + wc;
        float rs[2][4]; f32x4 cs[2][2];
        if constexpr (I8) {
            const LAS float* T = tab + u.ui * 512;
#pragma unroll
            for (int ai = 0; ai < 2; ++ai)
#pragma unroll
                for (int m = 0; m < 4; ++m) rs[ai][m] = T[wr * 64 + fr + ai * 128 + m * 16];
#pragma unroll
            for (int bj = 0; bj < 2; ++bj)
#pragma unroll
                for (int n = 0; n < 2; ++n) cs[bj][n] = *(const LAS f32x4*)(T + 256 + bj * 128 + wc * 32 + n * 16 + 4 * fq);
        } else {
            load_rstd(rowss, row0, fq, rs);
#pragma unroll
            for (int bj = 0; bj < 2; ++bj)
#pragma unroll
                for (int n = 0; n < 2; ++n) cs[bj][n] = (f32x4){1.f, 1.f, 1.f, 1.f};
        }
        if constexpr (V == 1) {
            if (g < 16) emit<true>(acc, row0, fq, rs, cs, (bf16_t*)(R + R_CQ) + 64 * g, 1024, g0, C2);
            else if (g < 32) emit<true>(acc, row0, fq, rs, cs, (bf16_t*)(R + R_CK) + 64 * (g - 16), 1024, g1, 1.0f);
            else emit<false>(acc, row0, fq, rs, cs, (bf16_t*)(R + R_CV) + 64 * (g - 32), 1024, nullptr, 1.0f);
        } else if constexpr (V == 0) {
            if (g < 8) emit<true>(acc, row0, fq, rs, cs, (bf16_t*)(R + R_AQ) + 64 * g, 512, g0, C2);
            else if (g < 16) emit<true>(acc, row0, fq, rs, cs, (bf16_t*)(R + R_AK) + 64 * (g - 8), 512, g1, 1.0f);
            else if (g < 24) emit<false>(acc, row0, fq, rs, cs, (bf16_t*)(R + R_AV) + 64 * (g - 16), 512, nullptr, 1.0f);
            else if (g < 32) emit<true>(acc, row0, fq, rs, cs, (bf16_t*)(R + R_BQ) + 64 * (g - 24), 512, g2, C2);
            else if (g < 40) emit<true>(acc, row0, fq, rs, cs, (bf16_t*)(R + R_BK) + 64 * (g - 32), 512, g3, 1.0f);
            else emit<false>(acc, row0, fq, rs, cs, (bf16_t*)(R + R_BV) + 64 * (g - 40), 512, nullptr, 1.0f);
        } else {
            if (g < 8) emit<false>(acc, row0, fq, rs, cs, (bf16_t*)(R + R_IQ) + 64 * g, 512, nullptr, 1.0f);
            else if (g == 8) emit<true>(acc, row0, fq, rs, cs, (bf16_t*)(R + R_IK), 64, g0, 1.0f);
            else if (g == 9) {
                if (fq == 0) {
                    float* iw = (float*)(R + R_IW);
#pragma unroll
                    for (int ai = 0; ai < 2; ++ai)
#pragma unroll
                        for (int m = 0; m < 4; ++m) { float* p = iw + (size_t)(row0 + ai * 128 + m * 16) * 8;
                            *(f32x4*)p = acc[ai][0][m][0] * rs[ai][m]; *(f32x4*)(p + 4) = acc[ai][0][m][1] * rs[ai][m]; }
                }
            }
        }
    }
};

enum { MAP_P8 = 0, MAP_GU = 1, MAP_H64_L0 = 2, MAP_H64_L1 = 3, MAP_H64Q_L0 = 4, MAP_H64I_L0 = 5 };
__device__ __forceinline__ int conv_src(int mode, int Tg, int& which) {
    const int pn = Tg >> 8, T = Tg & 255, bj = T >> 7, wc = (T >> 5) & 3, n = (T >> 4) & 1, fq = (T >> 2) & 3, j = T & 3;
    which = 0;
    if (mode == MAP_P8) return 256 * pn + 128 * bj + 32 * wc + 8 * fq + 4 * n + j;
    if (mode == MAP_GU) { which = n; return 128 * pn + 32 * wc + 8 * fq + 4 * bj + j; }
    const int Lu = 64 * wc + 32 * bj + 8 * fq + 4 * n + j;
    if (mode == MAP_H64_L1) return 256 * pn + Lu;
    const int g = 4 * pn + (Lu >> 6), d = Lu & 63;
    if (mode == MAP_H64Q_L0) return g < 24 ? g * 64 + d : 2120 + (g - 24) * 64 + d;
    if (mode == MAP_H64I_L0) { if (g < 8) return 1536 + g * 64 + d; if (g == 8) return 2048 + d; if (g == 9) return d < 8 ? 2112 + d : -1; return -1; }
    if (g < 32) return g * 64 + d;
    if (g == 32) return 2048 + d;
    if (g == 33) return d < 8 ? 2112 + d : -1;
    if (g < 58) return 2120 + (g - 34) * 64 + d;
    return -1;
}
__device__ __forceinline__ void conv_load(const float* src0, const float* src1, const float* gain, int Nsrc, int Nrows, int mode, int item, int lane, f32x4 (&v)[8]) {
    const int nT = Nrows / 32, kb = item / nT, tb = item % nT, k0 = 64 * kb, T0 = 32 * tb;
    int which; const int col = conv_src(mode, T0 + 4 * (lane & 7), which);
    const size_t sel = which ? (size_t)(src1 - src0) : (size_t)0;
    const float* src = src0 + sel; const int kr = lane >> 3;
#pragma unroll
    for (int i = 0; i < 8; ++i) { const int kk = 8 * i + kr;
        f32x4 t = (f32x4){0.f, 0.f, 0.f, 0.f}; if (col >= 0) { t = *(const f32x4*)(src + (size_t)(k0 + kk) * Nsrc + col); if (gain) t = t * gain[k0 + kk]; }
        v[i] = t; }
}
__device__ __forceinline__ void conv_store(bf16_t* dst, int K, int Nrows, int item, LAS float* scr, int lane, const f32x4 (&v)[8]) {
    const int nT = Nrows / 32, kb = item / nT, tb = item % nT, k0 = 64 * kb, T0 = 32 * tb;
    const int tq = lane & 7, kr = lane >> 3;
#pragma unroll
    for (int i = 0; i < 8; ++i) { LAS float* p = scr + (8 * i + kr) * 33 + 4 * tq; p[0] = v[i][0]; p[1] = v[i][1]; p[2] = v[i][2]; p[3] = v[i][3]; }
    asm volatile("s_waitcnt lgkmcnt(0)" ::: "memory");
    const int c = lane & 7;
#pragma unroll
    for (int j = 0; j < 4; ++j) { const int n = (lane >> 3) + 8 * j; const LAS float* s = scr + (8 * c) * 33 + n;
        u32x4 o; o.x = cvt_pk_bf16(s[0 * 33], s[1 * 33]); o.y = cvt_pk_bf16(s[2 * 33], s[3 * 33]); o.z = cvt_pk_bf16(s[4 * 33], s[5 * 33]); o.w = cvt_pk_bf16(s[6 * 33], s[7 * 33]);
        *(u32x4*)(dst + (size_t)(T0 + n) * K + k0 + 8 * c) = o; }
    asm volatile("s_waitcnt lgkmcnt(0)" ::: "memory");
}
template <int MODE>
__device__ __forceinline__ void convq_item(const float* wg, const float* wu, int Nsrc, const float* gain, signed char* dst, float* sb, int item, LAS float* scr, LAS float* xch, int wave, int lane) {
    const int T0 = 32 * item, tq = lane & 7, kr = lane >> 3;
    int which; const int col = conv_src(MODE, T0 + 4 * tq, which);
    const size_t sel = which ? (size_t)(wu - wg) : (size_t)0; const float* src = wg + sel;
    f32x4 v[2][8]; f32x4 mx = (f32x4){0.f, 0.f, 0.f, 0.f};
#pragma unroll
    for (int kbi = 0; kbi < 2; ++kbi)
#pragma unroll
        for (int i = 0; i < 8; ++i) { const int k = 64 * (2 * wave + kbi) + 8 * i + kr; const f32x4 t = *(const f32x4*)(src + (size_t)k * Nsrc + col) * gain[k]; v[kbi][i] = t;
            mx[0] = fmaxf(mx[0], fabsf(t[0])); mx[1] = fmaxf(mx[1], fabsf(t[1])); mx[2] = fmaxf(mx[2], fabsf(t[2])); mx[3] = fmaxf(mx[3], fabsf(t[3])); }
#pragma unroll
    for (int j = 0; j < 4; ++j) { float m_ = mx[j]; m_ = fmaxf(m_, __shfl_xor(m_, 8)); m_ = fmaxf(m_, __shfl_xor(m_, 16)); m_ = fmaxf(m_, __shfl_xor(m_, 32)); mx[j] = m_; }
    if (kr == 0) { LAS float* p = xch + wave * 32 + 4 * tq; p[0] = mx[0]; p[1] = mx[1]; p[2] = mx[2]; p[3] = mx[3]; }
    asm volatile("s_waitcnt lgkmcnt(0)" ::: "memory"); __syncthreads();
    f32x4 inv;
#pragma unroll
    for (int j = 0; j < 4; ++j) { float c = 0.f;
#pragma unroll
        for (int w = 0; w < 8; ++w) c = fmaxf(c, xch[w * 32 + 4 * tq + j]);
        inv[j] = c > 0.f ? 127.0f / c : 0.f; if (wave == 0 && kr == 0) sb[T0 + 4 * tq + j] = c > 0.f ? c * (1.0f / 127.0f) : 1.0f; }
    const int c8 = lane & 7;
#pragma unroll
    for (int kbi = 0; kbi < 2; ++kbi) {
#pragma unroll
        for (int i = 0; i < 8; ++i) { LAS float* p = scr + (8 * i + kr) * 33 + 4 * tq; const f32x4 t = v[kbi][i] * inv; p[0] = __builtin_rintf(t[0]); p[1] = __builtin_rintf(t[1]); p[2] = __builtin_rintf(t[2]); p[3] = __builtin_rintf(t[3]); }
        asm volatile("s_waitcnt lgkmcnt(0)" ::: "memory");
#pragma unroll
        for (int jj = 0; jj < 4; ++jj) { const int n = (lane >> 3) + 8 * jj; const LAS float* s = scr + (8 * c8) * 33 + n;
            const unsigned lo = (unsigned)((int)s[0 * 33] & 0xff) | ((unsigned)((int)s[1 * 33] & 0xff) << 8) | ((unsigned)((int)s[2 * 33] & 0xff) << 16) | ((unsigned)(int)s[3 * 33] << 24);
            const unsigned hi = (unsigned)((int)s[4 * 33] & 0xff) | ((unsigned)((int)s[5 * 33] & 0xff) << 8) | ((unsigned)((int)s[6 * 33] & 0xff) << 16) | ((unsigned)(int)s[7 * 33] << 24);
            *(u32x2*)(dst + (size_t)(T0 + n) * D + 64 * (2 * wave + kbi) + 8 * c8) = (u32x2){lo, hi}; }
        asm volatile("s_waitcnt lgkmcnt(0)" ::: "memory");
    }
    __syncthreads();
}
__device__ __forceinline__ void row_load(const float* xrow, int lane, f32x4 (&v)[4]) {
    const f32x4* xr = (const f32x4*)xrow + lane;
#pragma unroll
    for (int j = 0; j < 4; ++j) v[j] = xr[64 * j];
}
__device__ __forceinline__ void row_to_q8(const f32x4 (&v)[4], signed char* qrow, float* dq, float* ssp, int lane) {
    float s = 0.f;
#pragma unroll
    for (int j = 0; j < 4; ++j) s += (v[j].x * v[j].x + v[j].y * v[j].y) + (v[j].z * v[j].z + v[j].w * v[j].w);
    s = wave_sum(s);
    const float q = (127.0f / QRANGE) * __builtin_amdgcn_rsqf(s * (1.0f / D) + EPS);
    unsigned* o4 = (unsigned*)qrow + lane;
#pragma unroll
    for (int j = 0; j < 4; ++j) o4[64 * j] = q8_pack4(v[j], q);
    if (lane < 16) ssp[lane] = lane == 0 ? s : 0.f;
    if (lane == 0) *dq = 1.0f / q;
}
__device__ __forceinline__ void row_to_bf16(const float* xrow, bf16_t* orow, float* ssp, int lane) {
    const f32x4* xr = (const f32x4*)xrow + lane; f32x4 v[4]; float s = 0.f;
#pragma unroll
    for (int j = 0; j < 4; ++j) { v[j] = xr[64 * j]; s += (v[j].x * v[j].x + v[j].y * v[j].y) + (v[j].z * v[j].z + v[j].w * v[j].w); }
    s = wave_sum(s);
    u32x2* o8 = (u32x2*)orow + lane;
#pragma unroll
    for (int j = 0; j < 4; ++j) { u32x2 w; w.x = cvt_pk_bf16(v[j].x, v[j].y); w.y = cvt_pk_bf16(v[j].z, v[j].w); o8[64 * j] = w; }
    if (lane < 16) ssp[lane] = lane == 0 ? s : 0.f;
}

__device__ __forceinline__ void glds16(const void* gsrc, unsigned lds_dst) { unsigned keep;
    asm volatile("s_mov_b32 %0, m0\n\ts_mov_b32 m0, %2\n\ts_nop 0\n\tglobal_load_lds_dwordx4 %1, off\n\ts_mov_b32 m0, %0" : "=&s"(keep) : "v"(gsrc), "s"(lds_dst) : "memory"); }
#define WAITV_BAR(N) do { asm volatile("s_waitcnt vmcnt(" #N ") lgkmcnt(0)" ::: "memory"); __builtin_amdgcn_s_barrier(); asm volatile("" ::: "memory"); } while (0)
#define DMA_SYNC() do { asm volatile("s_waitcnt vmcnt(0) lgkmcnt(0)" ::: "memory"); __syncthreads(); } while (0)
__device__ __forceinline__ int crow(int r, int hi) { return (r & 3) + 8 * (r >> 2) + 4 * hi; }
enum { AM_T5 = 0, AM_T5_BITMAP = 1, AM_BAND = 2, AM_MEM = 3 };
constexpr int ATT_NS = 4;
constexpr int ATT_LUT_OFF = 135168, ATT_WSF_OFF = ATT_LUT_OFF + 2560;
typedef short v4i16_t __attribute__((ext_vector_type(4)));
__device__ __forceinline__ s16x4 vtr(const LAS unsigned char* p) { return __builtin_bit_cast(s16x4, __builtin_amdgcn_ds_read_tr16_b64_v4i16((LAS v4i16_t*)p)); }
__device__ __forceinline__ void glds16x2(const void* g0, unsigned d0, const void* g1, unsigned d1) { unsigned keep;
    asm volatile("s_mov_b32 %0, m0\n\ts_mov_b32 m0, %3\n\ts_nop 0\n\tglobal_load_lds_dwordx4 %1, off\n\ts_mov_b32 m0, %4\n\ts_nop 0\n\tglobal_load_lds_dwordx4 %2, off\n\ts_mov_b32 m0, %0"
                 : "=&s"(keep) : "v"(g0), "v"(g1), "s"(d0), "s"(d1) : "memory"); }
__device__ __forceinline__ void glds16x3(const void* g0, unsigned d0, const void* g1, unsigned d1, const void* g2, unsigned d2) { unsigned keep;
    asm volatile("s_mov_b32 %0, m0\n\ts_mov_b32 m0, %4\n\ts_nop 0\n\tglobal_load_lds_dwordx4 %1, off\n\ts_mov_b32 m0, %5\n\ts_nop 0\n\tglobal_load_lds_dwordx4 %2, off\n\t"
                 "s_mov_b32 m0, %6\n\ts_nop 0\n\tglobal_load_lds_dwordx4 %3, off\n\ts_mov_b32 m0, %0"
                 : "=&s"(keep) : "v"(g0), "v"(g1), "v"(g2), "s"(d0), "s"(d1), "s"(d2) : "memory"); }
__device__ __forceinline__ void glds16x2_4(const void* g0, unsigned d0, const void* g1, unsigned d1, const void* g2, unsigned d2) { unsigned keep;
    asm volatile("s_mov_b32 %0, m0\n\ts_mov_b32 m0, %4\n\ts_nop 0\n\tglobal_load_lds_dwordx4 %1, off\n\ts_mov_b32 m0, %5\n\ts_nop 0\n\tglobal_load_lds_dwordx4 %2, off\n\t"
                 "s_mov_b32 m0, %6\n\ts_nop 0\n\tglobal_load_lds_dword %3, off\n\ts_mov_b32 m0, %0"
                 : "=&s"(keep) : "v"(g0), "v"(g1), "v"(g2), "s"(d0), "s"(d1), "s"(d2) : "memory"); }
__device__ __forceinline__ void glds4(const void* gsrc, unsigned lds_dst) { unsigned keep;
    asm volatile("s_mov_b32 %0, m0\n\ts_mov_b32 m0, %2\n\ts_nop 0\n\tglobal_load_lds_dword %1, off\n\ts_mov_b32 m0, %0" : "=&s"(keep) : "v"(gsrc), "s"(lds_dst) : "memory"); }
template <int N> __device__ __forceinline__ void waitv_bar() { asm volatile("s_waitcnt vmcnt(%0) lgkmcnt(0)" :: "n"(N) : "memory"); __builtin_amdgcn_s_barrier(); asm volatile("" ::: "memory"); }

template <int DQK, int DV, int MODE>
__device__ __forceinline__ void attn_unit(LAS unsigned char* lds, const bf16_t* __restrict__ Q, int qpitch, const bf16_t* __restrict__ K, int kpitch, const bf16_t* __restrict__ V, int vpitch,
                                          bf16_t* O, int opitch, int q0, const float* lut, const unsigned* bitmapT, const float* qgain) {
    constexpr int KB = 64 * DQK * 2, VB = 64 * DV * 2, NKP = DQK / 64, NVP = DV / 64;
    constexpr int BMB = (MODE == AM_T5_BITMAP) ? 2048 : 0, SLOT = KB + VB + BMB;
    constexpr int ND = (NKP + NVP) + (MODE == AM_T5_BITMAP ? 1 : 0);
    constexpr int NKS = DQK / 16, NDB = DV / 32;
    constexpr int EOFF = (MODE == AM_BAND) ? 575 : 191, LUTN = (MODE == AM_BAND) ? 640 : 256;
    static_assert(ATT_NS * SLOT <= ATT_LUT_OFF && 8 * 32 * DV * 2 <= ATT_LUT_OFF, "attention LDS map");
    int tid = threadIdx.x; asm volatile("" : "+v"(tid));
    const int lane = tid & 63, r32 = lane & 31, hi = lane >> 5; const int wid = __builtin_amdgcn_readfirstlane(tid >> 6);
    const int qrow = q0 + 32 * wid + r32;
    const int cqw = (q0 + 32 * wid) >> 6;
    int tlo, thi, wlo, whi;
    if (MODE == AM_MEM) { tlo = 0; thi = 3; wlo = 0; whi = 3; }
    else if (MODE == AM_BAND) { tlo = (q0 >> 6) - 8; if (tlo < 0) tlo = 0; thi = (q0 + 255) >> 6; wlo = cqw - 8; if (wlo < 0) wlo = 0; whi = cqw; }
    else { tlo = 0; thi = (q0 + 255) >> 6; wlo = 0; whi = cqw; }
    LAS float* lutl = (LAS float*)(lds + ATT_LUT_OFF);
    LAS float* wsf = (LAS float*)(lds + ATT_WSF_OFF) + wid * 64;
    const unsigned ldsb = (unsigned)(uintptr_t)lds;
#define ATT_KSRC(t, p_) (K + (size_t)((t) * 64 + lane) * kpitch + (wid + 8 * (p_)) * 8)
#define ATT_KDST(p_) ((unsigned)__builtin_amdgcn_readfirstlane((int)(sb_ + (wid + 8 * (p_)) * 1024)))
#define ATT_VSRC(t, p_) (V + (size_t)((t) * 64 + 16 * ((wid + 8 * (p_)) & 3) + (lane >> 2)) * vpitch + 32 * ((wid + 8 * (p_)) >> 2) + (lane & 3) * 8)
#define ATT_VDST(p_) ((unsigned)__builtin_amdgcn_readfirstlane((int)(sb_ + KB + (wid + 8 * (p_)) * 1024)))
#define ATT_DMA(t) do { const unsigned sb_ = (unsigned)__builtin_amdgcn_readfirstlane((int)(ldsb + (((t) - tlo) & 3) * SLOT)); \
        if (MODE == AM_T5_BITMAP && NKP == 1 && NVP == 1) glds16x2_4(ATT_KSRC(t, 0), ATT_KDST(0), ATT_VSRC(t, 0), ATT_VDST(0), bitmapT + (size_t)(2 * (t) + hi) * S + qrow, (unsigned)__builtin_amdgcn_readfirstlane((int)(sb_ + KB + VB + wid * 256))); \
        else if (MODE != AM_T5_BITMAP && NKP == 1 && NVP == 1) glds16x2(ATT_KSRC(t, 0), ATT_KDST(0), ATT_VSRC(t, 0), ATT_VDST(0)); \
        else if (MODE != AM_T5_BITMAP && NKP == 1 && NVP == 2) glds16x3(ATT_KSRC(t, 0), ATT_KDST(0), ATT_VSRC(t, 0), ATT_VDST(0), ATT_VSRC(t, 1), ATT_VDST(1)); \
        else { \
        _Pragma("unroll") for (int p_ = 0; p_ < NKP; ++p_) glds16(ATT_KSRC(t, p_), ATT_KDST(p_)); \
        _Pragma("unroll") for (int p_ = 0; p_ < NVP; ++p_) glds16(ATT_VSRC(t, p_), ATT_VDST(p_)); \
        if (MODE == AM_T5_BITMAP) glds4(bitmapT + (size_t)(2 * (t) + hi) * S + qrow, (unsigned)__builtin_amdgcn_readfirstlane((int)(sb_ + KB + VB + wid * 256))); } \
    } while (0)
    ATT_DMA(tlo); if (tlo + 1 <= thi) ATT_DMA(tlo + 1); if (tlo + 2 <= thi) ATT_DMA(tlo + 2);
    bf16x8 qr[NKS];
    if (MODE == AM_MEM) {
        float qf[NKS][8]; float ss = 0.f;
#pragma unroll
        for (int d0 = 0; d0 < NKS; ++d0) { const bf16x8 t = *(const bf16x8*)(Q + (size_t)qrow * qpitch + d0 * 16 + hi * 8);
#pragma unroll
            for (int j = 0; j < 8; ++j) { qf[d0][j] = bf2f((unsigned short)t[j]); ss += qf[d0][j] * qf[d0][j]; } }
        ss += __shfl_xor(ss, 32);
        const float inv = (1.0f / sqrtf(ss * (1.0f / DQK) + EPS)) * (LOG2E / sqrtf((float)DQK));
#pragma unroll
        for (int d0 = 0; d0 < NKS; ++d0) { const f32x4 ga = *(const f32x4*)(qgain + d0 * 16 + hi * 8), gb = *(const f32x4*)(qgain + d0 * 16 + hi * 8 + 4);
            u32x4 w; w.x = cvt_pk_bf16(qf[d0][0] * inv * ga[0], qf[d0][1] * inv * ga[1]); w.y = cvt_pk_bf16(qf[d0][2] * inv * ga[2], qf[d0][3] * inv * ga[3]);
            w.z = cvt_pk_bf16(qf[d0][4] * inv * gb[0], qf[d0][5] * inv * gb[1]); w.w = cvt_pk_bf16(qf[d0][6] * inv * gb[2], qf[d0][7] * inv * gb[3]);
            qr[d0] = __builtin_bit_cast(bf16x8, w); }
    } else {
#pragma unroll
        for (int d0 = 0; d0 < NKS; ++d0) qr[d0] = *(const bf16x8*)(Q + (size_t)qrow * qpitch + d0 * 16 + hi * 8);
    }
    if (MODE != AM_MEM) { for (int i = tid; i < LUTN; i += NTHREADS) lutl[i] = lut[i]; }
#pragma unroll
    for (int d0 = 0; d0 < NKS; ++d0) asm volatile("" : "+v"(qr[d0]));
    asm volatile("s_waitcnt vmcnt(0)" ::: "memory");
    f32x16 o[NDB];
#pragma unroll
    for (int d = 0; d < NDB; ++d) o[d] = f32x16{};
    float l_reg = 0.f;
    const int qoff = (32 * wid + r32 + q0) & 63;
    const int vb0 = ((lane >> 4) & 1) * 32 + (lane & 3) * 8 + (4 * hi + ((lane & 15) >> 2)) * 64;
    constexpr int NQK = 2 * NKS, CH = 32 / NQK;
    constexpr bool PIPE = (MODE != AM_MEM);
    f32x16 c0 = f32x16{}, c1 = f32x16{};
#define ATT_KFRAG(kb_, i) (*(const LAS bf16x8*)((kb_) + (2 * ((i) >> 1) + hi) * 1024 + (32 * ((i) & 1) + r32) * 16))
#define ATT_QK1(kb_, i, n0, n1) do { if ((i) == 0) n0 = __builtin_amdgcn_mfma_f32_32x32x16_bf16(ATT_KFRAG(kb_, i), qr[0], f32x16{}, 0, 0, 0); \
                                     else if ((i) == 1) n1 = __builtin_amdgcn_mfma_f32_32x32x16_bf16(ATT_KFRAG(kb_, i), qr[0], f32x16{}, 0, 0, 0); \
                                     else if (((i) & 1) == 0) n0 = __builtin_amdgcn_mfma_f32_32x32x16_bf16(ATT_KFRAG(kb_, i), qr[(i) >> 1], n0, 0, 0, 0); \
                                     else n1 = __builtin_amdgcn_mfma_f32_32x32x16_bf16(ATT_KFRAG(kb_, i), qr[(i) >> 1], n1, 0, 0, 0); } while (0)
#define ATT_SMB4(cv, b, bwv, P) asm volatile( \
        "v_exp_f32 %0, %7\n\tv_exp_f32 %1, %8\n\tv_exp_f32 %2, %9\n\tv_exp_f32 %3, %10\n\t" \
        "v_bfe_i32 %5, %11, %12, 1\n\tv_bfe_i32 %6, %11, %13, 1\n\tv_and_b32 %0, %0, %5\n\tv_and_b32 %1, %1, %6\n\t" \
        "v_bfe_i32 %5, %11, %14, 1\n\tv_bfe_i32 %6, %11, %15, 1\n\tv_and_b32 %2, %2, %5\n\tv_and_b32 %3, %3, %6\n\t" \
        "v_add_f32 %4, %4, %0\n\tv_add_f32 %4, %4, %1\n\tv_add_f32 %4, %4, %2\n\tv_add_f32 %4, %4, %3" \
        : "=&v"(pe[P]), "=&v"(pe[(P) + 1]), "=&v"(pe[(P) + 2]), "=&v"(pe[(P) + 3]), "+v"(sacc), "=&v"(tm0_), "=&v"(tm1_) \
        : "v"(cv[b]), "v"(cv[(b) + 1]), "v"(cv[(b) + 2]), "v"(cv[(b) + 3]), "v"(bwv), "n"(2 * (b)), "n"(2 * (b) + 1), "n"(2 * (b) + 2), "n"(2 * (b) + 3))
#define ATT_SMX4(cv, b, P) asm volatile( \
        "v_exp_f32 %0, %5\n\tv_exp_f32 %1, %6\n\tv_exp_f32 %2, %7\n\tv_exp_f32 %3, %8\n\t" \
        "v_add_f32 %4, %4, %0\n\tv_add_f32 %4, %4, %1\n\tv_add_f32 %4, %4, %2\n\tv_add_f32 %4, %4, %3" \
        : "=&v"(pe[P]), "=&v"(pe[(P) + 1]), "=&v"(pe[(P) + 2]), "=&v"(pe[(P) + 3]), "+v"(sacc) \
        : "v"(cv[b]), "v"(cv[(b) + 1]), "v"(cv[(b) + 2]), "v"(cv[(b) + 3]))
#define ATT_SM1(i) do { if (MODE == AM_T5_BITMAP) { float tm0_, tm1_; if ((i) < 4) ATT_SMB4(c0, 4 * (i), bw0, 4 * (i)); else ATT_SMB4(c1, 4 * ((i) - 4), bw1, 16 + 4 * ((i) - 4)); } \
    else if (MODE != AM_MEM) { if ((i) < 4) ATT_SMX4(c0, 4 * (i), 4 * (i)); else ATT_SMX4(c1, 4 * ((i) - 4), 16 + 4 * ((i) - 4)); } else \
    _Pragma("unroll") for (int v_ = CH * (i); v_ < CH * (i) + CH; ++v_) { \
        if (v_ < 16) { float e_ = __builtin_amdgcn_exp2f(c0[v_]); if (MODE == AM_T5_BITMAP) e_ = __uint_as_float(__float_as_uint(e_) & (unsigned)__builtin_amdgcn_sbfe((int)bw0, (v_ & 3) + 8 * (v_ >> 2), 1)); asm volatile("" : "+v"(e_)); c0[v_] = e_; sacc += e_; } \
        else { const int u_ = v_ - 16; float e_ = __builtin_amdgcn_exp2f(c1[u_]); if (MODE == AM_T5_BITMAP) e_ = __uint_as_float(__float_as_uint(e_) & (unsigned)__builtin_amdgcn_sbfe((int)bw1, (u_ & 3) + 8 * (u_ >> 2), 1)); asm volatile("" : "+v"(e_)); c1[u_] = e_; sacc += e_; } } \
        asm volatile("" : "+v"(sacc)); } while (0)
    if (tlo + 2 <= thi) waitv_bar<2 * ND>(); else if (tlo + 1 <= thi) waitv_bar<ND>(); else waitv_bar<0>();
    if (PIPE) {   const LAS unsigned char* kb = lds;
#pragma unroll
        for (int i = 0; i < NQK; ++i) ATT_QK1(kb, i, c0, c1);
        asm volatile("s_nop 7\n\ts_nop 7\n\ts_nop 3" : "+v"(c0), "+v"(c1));
    }
    for (int t = tlo; t <= thi; ++t) {
        const bool has_next = PIPE && (t + 1 <= thi);
        const bool nxt_act = has_next && (t + 1 >= wlo) && (t + 1 <= whi);
        if (!PIPE) { if (t > tlo) { if (t + 2 <= thi) waitv_bar<2 * ND>(); else if (t + 1 <= thi) waitv_bar<ND>(); else waitv_bar<0>(); } }
        else if (has_next) { if (t + 2 <= thi) waitv_bar<ND>(); else waitv_bar<0>(); }
        if (!PIPE && t + 3 <= thi) ATT_DMA(t + 3);
        const LAS unsigned char* kcur = lds + ((t - tlo) & 3) * SLOT; const LAS unsigned char* vbuf = kcur + KB;
        const LAS unsigned char* knxt = lds + ((t + 1 - tlo) & 3) * SLOT;
        f32x16 n0, n1;
        if (!PIPE) {
#pragma unroll
            for (int i = 0; i < NQK; ++i) ATT_QK1(kcur, i, c0, c1);
        }
        const bool act = (t >= wlo && t <= whi);
        constexpr int NPV = NDB * 4;
        float pe[32]; s16x4 vlo[4], vhi[4];
#define ATT_VLD(j) do { vlo[(j) & 3] = vtr(vbuf + vb0 + ((j) >> 2) * 4096 + ((j) & 3) * 1024); vhi[(j) & 3] = vtr(vbuf + vb0 + ((j) >> 2) * 4096 + ((j) & 3) * 1024 + 512); } while (0)
        if (act) {
            unsigned bw0 = 0, bw1 = 0;
            if (MODE == AM_T5_BITMAP) { const LAS unsigned* bw = (const LAS unsigned*)(vbuf + VB + wid * 256); bw0 = bw[r32] >> (4 * hi); bw1 = bw[32 + r32] >> (4 * hi); }
            if (MODE != AM_MEM) {
                const int dt = cqw - t;
                if (dt <= (MODE == AM_BAND ? 4 : 2)) {
                    const LAS float* lp = lutl + (EOFF - 64 * dt - qoff + 4 * hi);
#pragma unroll
                    for (int r = 0; r < 16; ++r) { c0[r] += lp[(r & 3) + 8 * (r >> 2)]; c1[r] += lp[32 + (r & 3) + 8 * (r >> 2)]; }
                }
            }
            float sacc = 0.f;
            bf16x8 kf[4];
            if (nxt_act) {
#pragma unroll
                for (int i = 0; i < 4; ++i) kf[i] = ATT_KFRAG(knxt, i);
                __builtin_amdgcn_sched_barrier(0);
#pragma unroll
                for (int i = 0; i < NQK; ++i) {
                    ATT_SM1(i);
                    __builtin_amdgcn_sched_barrier(0);
                    if (i == 0) n0 = __builtin_amdgcn_mfma_f32_32x32x16_bf16(kf[0], qr[0], f32x16{}, 0, 0, 0);
                    else if (i == 1) n1 = __builtin_amdgcn_mfma_f32_32x32x16_bf16(kf[1], qr[0], f32x16{}, 0, 0, 0);
                    else if ((i & 1) == 0) n0 = __builtin_amdgcn_mfma_f32_32x32x16_bf16(kf[i & 3], qr[i >> 1], n0, 0, 0, 0);
                    else n1 = __builtin_amdgcn_mfma_f32_32x32x16_bf16(kf[i & 3], qr[i >> 1], n1, 0, 0, 0);
                    if (i + 4 < NQK) kf[i & 3] = ATT_KFRAG(knxt, i + 4);
                    else ATT_VLD(i + 4 - NQK);
                    __builtin_amdgcn_sched_barrier(0);
                }
            } else {
#pragma unroll
                for (int j = 0; j < 4; ++j) ATT_VLD(j);
#pragma unroll
                for (int i = 0; i < NQK; ++i) ATT_SM1(i);
            }
            l_reg += sacc;
        } else if (nxt_act) {
#pragma unroll
            for (int i = 0; i < NQK; ++i) ATT_QK1(knxt, i, n0, n1);
        }
        if (PIPE && t + 3 <= thi) ATT_DMA(t + 3);
        if (act) {
            bf16x8 pw[4];
#pragma unroll
            for (int ks = 0; ks < 2; ++ks) {
                u32x4 a, c;
#define ATT_P0(v) (MODE != AM_MEM ? pe[v] : c0[v])
#define ATT_P1(v) (MODE != AM_MEM ? pe[16 + (v)] : c1[v])
                a.x = cvt_pk_bf16(ATT_P0(8 * ks + 0), ATT_P0(8 * ks + 1)); a.y = cvt_pk_bf16(ATT_P0(8 * ks + 2), ATT_P0(8 * ks + 3)); a.z = cvt_pk_bf16(ATT_P0(8 * ks + 4), ATT_P0(8 * ks + 5)); a.w = cvt_pk_bf16(ATT_P0(8 * ks + 6), ATT_P0(8 * ks + 7));
                c.x = cvt_pk_bf16(ATT_P1(8 * ks + 0), ATT_P1(8 * ks + 1)); c.y = cvt_pk_bf16(ATT_P1(8 * ks + 2), ATT_P1(8 * ks + 3)); c.z = cvt_pk_bf16(ATT_P1(8 * ks + 4), ATT_P1(8 * ks + 5)); c.w = cvt_pk_bf16(ATT_P1(8 * ks + 6), ATT_P1(8 * ks + 7));
#undef ATT_P0
#undef ATT_P1
                pw[ks] = __builtin_bit_cast(bf16x8, a); pw[2 + ks] = __builtin_bit_cast(bf16x8, c);
            }
            __builtin_amdgcn_sched_barrier(0);
#pragma unroll
            for (int j = 0; j < NPV; ++j) {
                const bf16x8 vf = (bf16x8){vlo[j & 3][0], vlo[j & 3][1], vlo[j & 3][2], vlo[j & 3][3], vhi[j & 3][0], vhi[j & 3][1], vhi[j & 3][2], vhi[j & 3][3]};
                o[j >> 2] = __builtin_amdgcn_mfma_f32_32x32x16_bf16(pw[j & 3], vf, o[j >> 2], 0, 0, 0);
                if (j + 4 < NPV) ATT_VLD(j + 4);
                __builtin_amdgcn_sched_barrier(0);
            }
        }
#undef ATT_VLD
        if (PIPE) { c0 = n0; c1 = n1; }
    }
#undef ATT_KFRAG
#undef ATT_QK1
#undef ATT_SM1
#undef ATT_SMB4
#undef ATT_SMX4
#undef ATT_DMA
#undef ATT_KSRC
#undef ATT_KDST
#undef ATT_VSRC
#undef ATT_VDST
    waitv_bar<0>();
    l_reg += __shfl_xor(l_reg, 32);
    if (hi == 0) wsf[r32] = l_reg;
    asm volatile("s_waitcnt lgkmcnt(0)" ::: "memory");
    float rli[16];
#pragma unroll
    for (int r = 0; r < 16; ++r) rli[r] = 1.0f / wsf[crow(r, hi)];
    LAS bf16_t* stg = (LAS bf16_t*)lds + wid * (32 * DV);
#pragma unroll
    for (int r = 0; r < 16; ++r) { const int orow = crow(r, hi);
#pragma unroll
        for (int db = 0; db < NDB; ++db) stg[orow * DV + db * 32 + r32] = (bf16_t)f2bf(o[db][r] * rli[r]); }
    asm volatile("s_waitcnt lgkmcnt(0)" ::: "memory");
    constexpr int LPR = DV / 8, RPI = 64 / LPR;
#pragma unroll
    for (int i = 0; i < 32 / RPI; ++i) { const int row = i * RPI + lane / LPR, ch = lane % LPR;
        const u32x4 v = *(const LAS u32x4*)(stg + row * DV + ch * 8);
        *(u32x4*)(O + (size_t)(q0 + 32 * wid + row) * opitch + ch * 8) = v; }
    DMA_SYNC();
}

constexpr int SEL_NB = 1024, SEL_TIECAP = 128, SEL_POOLCAP = 2048;
__device__ __forceinline__ void sel_pool_put(unsigned* pool, LAS unsigned* pcnt, float s, unsigned kq) {
    const unsigned g = __hip_atomic_fetch_add(pcnt, 1u, __ATOMIC_RELAXED, __HIP_MEMORY_SCOPE_WORKGROUP);
    if (g < (unsigned)SEL_POOLCAP) { __hip_atomic_store(pool + 2 * g, __float_as_uint(s), __ATOMIC_RELAXED, __HIP_MEMORY_SCOPE_AGENT); __hip_atomic_store(pool + 2 * g + 1, kq, __ATOMIC_RELAXED, __HIP_MEMORY_SCOPE_AGENT); }
}
__device__ __forceinline__ unsigned sel_pool_get(unsigned* pool, unsigned i) { return __hip_atomic_load(pool + i, __ATOMIC_RELAXED, __HIP_MEMORY_SCOPE_AGENT); }
constexpr int SEL_HIST_OFF = 0, SEL_TIE_OFF = 65536, SEL_IK_OFF = 98304, SEL_QI_OFF = 131072;
__device__ __forceinline__ void dsa_select_unit(LAS unsigned char* lds, int u, const bf16_t* __restrict__ iq, const bf16_t* __restrict__ ik, const float* __restrict__ iw, const float* __restrict__ ikgain, unsigned* bitmapT, unsigned* pool) {
    int tid = threadIdx.x; asm volatile("" : "+v"(tid));
    const int lane = tid & 63, r32 = lane & 31, hc = lane >> 5; const int wid = __builtin_amdgcn_readfirstlane(tid >> 6);
    const int cq = u >> 1, NT = cq + 1, qbase = 32 * u;
    if (cq <= 3) {
        for (int i = tid; i < 2 * NT * 32; i += NTHREADS) bitmapT[(size_t)(i >> 5) * S + qbase + (i & 31)] = 0xffffffffu;
        return;
    }
    LAS unsigned* hist = (LAS unsigned*)(lds + SEL_HIST_OFF);
    LAS unsigned* tie = (LAS unsigned*)(lds + SEL_TIE_OFF);
    LAS float* qinfo = (LAS float*)(lds + SEL_QI_OFF);
    const int rr = r32, half_r = (rr >> 2) & 1, reggrp = rr >> 4, head_r = ((rr >> 3) & 1) * 4 + (rr & 3), qi_r = 2 * half_r + reggrp;
    const int qrow_r = qbase + 4 * wid + qi_r;
    bf16x8 af[4]; float nrm = 0.f; float afv[4][8];
#pragma unroll
    for (int ks = 0; ks < 4; ++ks) { const bf16x8 t = *(const bf16x8*)(iq + (size_t)qrow_r * 512 + head_r * 64 + ks * 16 + hc * 8);
#pragma unroll
        for (int j = 0; j < 8; ++j) { afv[ks][j] = bf2f((unsigned short)t[j]); nrm += afv[ks][j] * afv[ks][j]; } }
    nrm += __shfl_xor(nrm, 32); nrm = sqrtf(nrm);
    float kmax = fabsf(ikgain[lane]);
#pragma unroll
    for (int o_ = 1; o_ < 64; o_ <<= 1) kmax = fmaxf(kmax, __shfl_xor(kmax, o_));
    kmax *= 8.0f * 1.02f;
    const float bound = nrm * kmax, rs_ = bound > 0.f ? 1.0f / bound : 0.f;
#pragma unroll
    for (int ks = 0; ks < 4; ++ks) { u32x4 w; w.x = cvt_pk_bf16(afv[ks][0] * rs_, afv[ks][1] * rs_); w.y = cvt_pk_bf16(afv[ks][2] * rs_, afv[ks][3] * rs_);
        w.z = cvt_pk_bf16(afv[ks][4] * rs_, afv[ks][5] * rs_); w.w = cvt_pk_bf16(afv[ks][6] * rs_, afv[ks][7] * rs_);
        af[ks] = __builtin_bit_cast(bf16x8, w); }
    LAS float* wtab = qinfo + 256;
    { const float wp = iw[(size_t)qrow_r * 8 + head_r] * bound;
      float cp = fmaxf(wp, 0.f), cm = fmaxf(-wp, 0.f);
      cp += __shfl_xor(cp, 1); cp += __shfl_xor(cp, 2); cp += __shfl_xor(cp, 8);
      cm += __shfl_xor(cm, 1); cm += __shfl_xor(cm, 2); cm += __shfl_xor(cm, 8);
      if (hc == 0) { const int ql = 4 * wid + qi_r; wtab[ql * 8 + head_r] = wp;
          if (head_r == 0) { const float lo_ = -cm, rng_ = fmaxf(cp + cm, 1e-20f); qinfo[ql * 8 + 0] = lo_; qinfo[ql * 8 + 1] = ((float)SEL_NB * (1.0f - 4e-6f)) / rng_; qinfo[ql * 8 + 4] = 0.f; } } }
    for (int i = tid; i < 32 * 512 / 4; i += NTHREADS) ((LAS u32x4*)hist)[i] = (u32x4){0u, 0u, 0u, 0u};
    LAS unsigned* pcnt = (LAS unsigned*)(qinfo + 512);
    if (tid == 0) *pcnt = 0u;
    DMA_SYNC();
    const int ql0 = 4 * wid + 2 * hc, ql1 = ql0 + 1;
    float wv[16];
#pragma unroll
    for (int i = 0; i < 16; ++i) wv[i] = wtab[(ql0 + (i >> 3)) * 8 + (i & 7)];
    float lo0 = qinfo[ql0 * 8 + 0], inv0 = qinfo[ql0 * 8 + 1], lo1 = qinfo[ql1 * 8 + 0], inv1 = qinfo[ql1 * 8 + 1];
#pragma unroll
    for (int i = 0; i < 16; ++i) asm volatile("" : "+v"(wv[i]));
#pragma unroll
    for (int ks = 0; ks < 4; ++ks) asm volatile("" : "+v"(af[ks]));
    lo0 = -lo0 * inv0 + 1e-3f; lo1 = -lo1 * inv1 + 1e-3f;
    asm volatile("" : "+v"(lo0), "+v"(inv0), "+v"(lo1), "+v"(inv1));
    const unsigned ikdst = (unsigned)__builtin_amdgcn_readfirstlane((int)((unsigned)(uintptr_t)lds + SEL_IK_OFF + wid * 1024));
#define SEL_DMA(t) glds16(ik + (size_t)((t) * 64 + lane) * 64 + wid * 8, (unsigned)__builtin_amdgcn_readfirstlane((int)(ikdst + (((t) & 3) * 8192))))
#define SEL_RELU(x) __builtin_amdgcn_fmed3f((x), 0.f, 1.0f)
#define SEL_FMAC(acc, a, b) do { float b_ = (b); asm volatile("v_fmac_f32 %0, %1, %2" : "+v"(acc) : "v"(a), "v"(b_)); } while (0)
#define SEL_FRAG(kb_, i) (*(const LAS bf16x8*)((kb_) + (2 * ((i) >> 1) + hc) * 1024 + (32 * ((i) & 1) + r32) * 16))
#define SEL_REDUCE1(A0, A1, i) do { float t0_, t1_; asm volatile( \
        "v_max_f32_e64 %4, %7, %7 clamp\n\tv_max_f32_e64 %5, %8, %8 clamp\n\tv_fmac_f32 %0, %6, %4\n\tv_fmac_f32 %1, %11, %5\n\t" \
        "v_max_f32_e64 %4, %9, %9 clamp\n\tv_max_f32_e64 %5, %10, %10 clamp\n\tv_fmac_f32 %2, %6, %4\n\tv_fmac_f32 %3, %11, %5" \
        : "+v"(sc[0][0]), "+v"(sc[0][1]), "+v"(sc[1][0]), "+v"(sc[1][1]), "=&v"(t0_), "=&v"(t1_) \
        : "v"(wv[i]), "v"(A0[i]), "v"(A0[8 + (i)]), "v"(A1[i]), "v"(A1[8 + (i)]), "v"(wv[8 + (i)])); } while (0)
#define SEL_LOOP_BEGIN() SEL_DMA(0); if (NT > 1) SEL_DMA(1); if (NT > 2) SEL_DMA(2); \
    WAITV_BAR(0); \
    f32x16 a0 = f32x16{}, a1 = f32x16{}, n0 = f32x16{}, n1 = f32x16{}; \
    { const LAS unsigned char* kb0_ = lds + SEL_IK_OFF; bf16x8 bfr_[8]; \
      _Pragma("unroll") for (int i = 0; i < 8; ++i) bfr_[i] = SEL_FRAG(kb0_, i); \
      _Pragma("unroll") for (int i = 0; i < 8; ++i) { if ((i & 1) == 0) a0 = __builtin_amdgcn_mfma_f32_32x32x16_bf16(af[i >> 1], bfr_[i], a0, 0, 0, 0); else a1 = __builtin_amdgcn_mfma_f32_32x32x16_bf16(af[i >> 1], bfr_[i], a1, 0, 0, 0); } } \
    asm volatile("s_nop 7\n\ts_nop 7\n\ts_nop 3" : "+v"(a0), "+v"(a1));
#define SEL_STEP(A0, A1, N0, N1, t, BODY, FIRST) do { \
        const bool has_next = (t) + 1 < NT; \
        if (FIRST) WAITV_BAR(0);                                      \
        float sc[2][2] = {{0.f, 0.f}, {0.f, 0.f}}; \
        if (has_next) { const LAS unsigned char* kbn_ = lds + SEL_IK_OFF + (((t) + 1) & 3) * 8192; bf16x8 bfr_[8]; \
            _Pragma("unroll") for (int i = 0; i < 8; ++i) bfr_[i] = SEL_FRAG(kbn_, i); \
            __builtin_amdgcn_sched_barrier(0); \
            _Pragma("unroll") for (int i = 0; i < 8; ++i) { \
                if (i == 0) N0 = __builtin_amdgcn_mfma_f32_32x32x16_bf16(af[0], bfr_[0], f32x16{}, 0, 0, 0); \
                else if (i == 1) N1 = __builtin_amdgcn_mfma_f32_32x32x16_bf16(af[0], bfr_[1], f32x16{}, 0, 0, 0); \
                else if ((i & 1) == 0) N0 = __builtin_amdgcn_mfma_f32_32x32x16_bf16(af[i >> 1], bfr_[i], N0, 0, 0, 0); else N1 = __builtin_amdgcn_mfma_f32_32x32x16_bf16(af[i >> 1], bfr_[i], N1, 0, 0, 0); \
                SEL_REDUCE1(A0, A1, i); __builtin_amdgcn_sched_barrier(0); } \
        } else { _Pragma("unroll") for (int i = 0; i < 8; ++i) SEL_REDUCE1(A0, A1, i); } \
        if (FIRST) { if ((t) + 3 < NT) SEL_DMA((t) + 3); if ((t) + 4 < NT) SEL_DMA((t) + 4); }     \
        BODY(t) } while (0)
#define SEL_LOOP(BODY) for (int t = 0; t < NT; t += 2) { SEL_STEP(a0, a1, n0, n1, t, BODY, true); if (t + 1 < NT) SEL_STEP(n0, n1, a0, a1, t + 1, BODY, false); }
#define SEL_F(s, nlo_, inv_) ({ float f_; asm("v_fma_f32 %0, %1, %2, %3" : "=v"(f_) : "v"(s), "v"(inv_), "v"(nlo_)); f_; })
    LAS unsigned* hrow = hist + (ql0 >> 1) * SEL_NB;
#define SEL_BODY1(t) _Pragma("unroll") for (int sub = 0; sub < 2; ++sub) { \
            const unsigned b0 = (unsigned)(int)SEL_F(sc[sub][0], lo0, inv0) & (unsigned)(SEL_NB - 1), b1 = (unsigned)(int)SEL_F(sc[sub][1], lo1, inv1) & (unsigned)(SEL_NB - 1); \
            __hip_atomic_fetch_add(hrow + b0, 1u, __ATOMIC_RELAXED, __HIP_MEMORY_SCOPE_WORKGROUP); \
            __hip_atomic_fetch_add(hrow + b1, 65536u, __ATOMIC_RELAXED, __HIP_MEMORY_SCOPE_WORKGROUP); }
    { SEL_LOOP_BEGIN() SEL_LOOP(SEL_BODY1) }
#undef SEL_BODY1
    DMA_SYNC();
    for (int qi = 0; qi < 4; ++qi) {
        const int ql = 4 * wid + qi;
        unsigned hw[16];
        { const LAS u32x4* hp = (const LAS u32x4*)(hist + (ql >> 1) * SEL_NB + 16 * lane); const int sh = 16 * (ql & 1);
#pragma unroll
          for (int j = 0; j < 4; ++j) { const u32x4 h4 = hp[j]; hw[4 * j + 0] = (h4.x >> sh) & 0xffffu; hw[4 * j + 1] = (h4.y >> sh) & 0xffffu; hw[4 * j + 2] = (h4.z >> sh) & 0xffffu; hw[4 * j + 3] = (h4.w >> sh) & 0xffffu; } }
        unsigned ls = 0;
#pragma unroll
        for (int j = 0; j < 16; ++j) ls += hw[j];
        unsigned suf = ls;
#pragma unroll
        for (int d = 1; d < 64; d <<= 1) { const unsigned t_ = __shfl_down(suf, d); if (lane + d < 64) suf += t_; }
        const unsigned excl = suf - ls;
        if (excl < 256u && suf >= 256u) {
            unsigned c = excl; int bstar = -1; unsigned cgt = 0;
#pragma unroll
            for (int bb = 15; bb >= 0; --bb) { const unsigned cnt = hw[bb];
                if (bstar < 0) { if (c + cnt >= 256u) { bstar = 16 * lane + bb; cgt = c; } else c += cnt; } }
            qinfo[ql * 8 + 2] = __int_as_float(bstar); qinfo[ql * 8 + 3] = __uint_as_float(cgt);
        }
    }
    DMA_SYNC();
    const int bs0 = __float_as_int(qinfo[ql0 * 8 + 2]), bs1 = __float_as_int(qinfo[ql1 * 8 + 2]);
    LAS unsigned* bm = hist;
    LAS unsigned* tcnt0 = (LAS unsigned*)(qinfo + ql0 * 8 + 4); LAS unsigned* tcnt1 = (LAS unsigned*)(qinfo + ql1 * 8 + 4);
    const float fl0 = (float)bs0, fh0 = (float)(bs0 + 1), fl1 = (float)bs1, fh1 = (float)(bs1 + 1);
#define SEL_BODY2(t) _Pragma("unroll") for (int sub = 0; sub < 2; ++sub) { \
            const float s0 = sc[sub][0], s1 = sc[sub][1]; \
            const float f0 = SEL_F(s0, lo0, inv0), f1 = SEL_F(s1, lo1, inv1); \
            const unsigned long long m0 = __ballot(f0 >= fh0), m1 = __ballot(f1 >= fh1); \
            if (r32 == 0) { bm[(2 * (t) + sub) * 32 + ql0] = hc ? (unsigned)(m0 >> 32) : (unsigned)m0; bm[(2 * (t) + sub) * 32 + ql1] = hc ? (unsigned)(m1 >> 32) : (unsigned)m1; } \
            const unsigned key = (unsigned)((t) * 64 + sub * 32 + r32); \
            const bool t0_ = (f0 >= fl0) && !(f0 >= fh0), t1_ = (f1 >= fl1) && !(f1 >= fh1); \
            if (__ballot(t0_ || t1_) != 0ull) {                  \
                if (t0_) { const unsigned slot = __hip_atomic_fetch_add(tcnt0, 1u, __ATOMIC_RELAXED, __HIP_MEMORY_SCOPE_WORKGROUP); \
                    if (slot < SEL_TIECAP) { tie[(ql0 * SEL_TIECAP + slot) * 2] = __float_as_uint(s0); tie[(ql0 * SEL_TIECAP + slot) * 2 + 1] = key; } \
                    else sel_pool_put(pool, pcnt, s0, key | ((unsigned)ql0 << 16)); } \
                if (t1_) { const unsigned slot = __hip_atomic_fetch_add(tcnt1, 1u, __ATOMIC_RELAXED, __HIP_MEMORY_SCOPE_WORKGROUP); \
                    if (slot < SEL_TIECAP) { tie[(ql1 * SEL_TIECAP + slot) * 2] = __float_as_uint(s1); tie[(ql1 * SEL_TIECAP + slot) * 2 + 1] = key; } \
                    else sel_pool_put(pool, pcnt, s1, key | ((unsigned)ql1 << 16)); } } }
    { SEL_LOOP_BEGIN() SEL_LOOP(SEL_BODY2) }
#undef SEL_BODY2
    DMA_SYNC();
#undef SEL_STEP
#undef SEL_LOOP
#undef SEL_F
#undef SEL_LOOP_BEGIN
#undef SEL_DMA
#undef SEL_FRAG
#undef SEL_REDUCE1
#undef SEL_RELU
#undef SEL_FMAC
    const unsigned pn = min(*pcnt, (unsigned)SEL_POOLCAP);
    LAS unsigned* pl = (LAS unsigned*)(lds + SEL_IK_OFF);
    if (pn) { for (unsigned i = tid; i < 2 * pn; i += NTHREADS) pl[i] = sel_pool_get(pool, i); DMA_SYNC(); }
    for (int qi = 0; qi < 4; ++qi) {
        const int ql = 4 * wid + qi;
        const unsigned tot = *(LAS unsigned*)(qinfo + ql * 8 + 4);
        const unsigned n = min(tot, (unsigned)SEL_TIECAP);
        const unsigned need = 256u - __float_as_uint(qinfo[ql * 8 + 3]);
        const LAS unsigned* tl = tie + ql * SEL_TIECAP * 2;
        if (tot <= (unsigned)SEL_TIECAP) {
            for (unsigned i0 = 0; i0 < n; i0 += 64) {
                const unsigned i = i0 + lane; const bool act = i < n;
                const float si = act ? __uint_as_float(tl[2 * i]) : 0.f; const unsigned ki = act ? tl[2 * i + 1] : 0u;
                unsigned rank = 0;
                for (unsigned j = 0; j < n; ++j) { const float sj = __uint_as_float(tl[2 * j]); const unsigned kj = tl[2 * j + 1]; rank += (sj > si || (sj == si && kj < ki)) ? 1u : 0u; }
                if (act && rank < need) __hip_atomic_fetch_or(bm + (ki >> 5) * 32 + ql, 1u << (ki & 31u), __ATOMIC_RELAXED, __HIP_MEMORY_SCOPE_WORKGROUP);
            }
        } else {
            const unsigned nt = n + pn;
#define SEL_ENT(i, valid, us, kr) do { unsigned sb_, kq_; if ((i) < n) { sb_ = tl[2 * (i)]; kq_ = tl[2 * (i) + 1] | ((unsigned)ql << 16); } else { sb_ = pl[2 * ((i) - n)]; kq_ = pl[2 * ((i) - n) + 1]; } \
            valid = (kq_ >> 16) == (unsigned)ql; sb_ = (sb_ == 0x80000000u) ? 0u : sb_; us = sb_ ^ ((unsigned)((int)sb_ >> 31) | 0x80000000u); kr = 16383u - (kq_ & 0xffffu); } while (0)
            if (nt <= 512u) {
                unsigned eu[8], ek[8]; bool ev[8];
#pragma unroll
                for (int r = 0; r < 8; ++r) { const unsigned i = 64u * r + lane; ev[r] = false; eu[r] = 0u; ek[r] = 0u; if (i < nt) SEL_ENT(i, ev[r], eu[r], ek[r]); }
                unsigned ts = 0u;
                for (int bit = 31; bit >= 0; --bit) { const unsigned cand = ts | (1u << bit); unsigned c = 0u;
#pragma unroll
                    for (int r = 0; r < 8; ++r) c += (unsigned)__popcll(__ballot(ev[r] && eu[r] >= cand));
                    if (c >= need) ts = cand; }
                unsigned cg = 0u;
#pragma unroll
                for (int r = 0; r < 8; ++r) cg += (unsigned)__popcll(__ballot(ev[r] && eu[r] > ts));
                const unsigned need2 = need - cg;
                unsigned kt = 0u;
                for (int bit = 13; bit >= 0; --bit) { const unsigned cand = kt | (1u << bit); unsigned c = 0u;
#pragma unroll
                    for (int r = 0; r < 8; ++r) c += (unsigned)__popcll(__ballot(ev[r] && eu[r] == ts && ek[r] >= cand));
                    if (c >= need2) kt = cand; }
#pragma unroll
                for (int r = 0; r < 8; ++r) if (ev[r] && (eu[r] > ts || (eu[r] == ts && ek[r] >= kt))) { const unsigned ki = 16383u - ek[r];
                    __hip_atomic_fetch_or(bm + (ki >> 5) * 32 + ql, 1u << (ki & 31u), __ATOMIC_RELAXED, __HIP_MEMORY_SCOPE_WORKGROUP); }
            } else {
            unsigned ts = 0u;
            for (int bit = 31; bit >= 0; --bit) { const unsigned cand = ts | (1u << bit); unsigned c = 0u;
                for (unsigned i0 = 0; i0 < nt; i0 += 64) { const unsigned i = i0 + lane; bool v = false; unsigned us = 0u, kr = 0u; if (i < nt) SEL_ENT(i, v, us, kr); c += (unsigned)__popcll(__ballot(v && us >= cand)); }
                if (c >= need) ts = cand; }
            unsigned cg = 0u;
            for (unsigned i0 = 0; i0 < nt; i0 += 64) { const unsigned i = i0 + lane; bool v = false; unsigned us = 0u, kr = 0u; if (i < nt) SEL_ENT(i, v, us, kr); cg += (unsigned)__popcll(__ballot(v && us > ts)); }
            const unsigned need2 = need - cg;
            unsigned kt = 0u;
            for (int bit = 13; bit >= 0; --bit) { const unsigned cand = kt | (1u << bit); unsigned c = 0u;
                for (unsigned i0 = 0; i0 < nt; i0 += 64) { const unsigned i = i0 + lane; bool v = false; unsigned us = 0u, kr = 0u; if (i < nt) SEL_ENT(i, v, us, kr); c += (unsigned)__popcll(__ballot(v && us == ts && kr >= cand)); }
                if (c >= need2) kt = cand; }
            for (unsigned i = lane; i < nt; i += 64) { bool v; unsigned us, kr; SEL_ENT(i, v, us, kr);
                if (v && (us > ts || (us == ts && kr >= kt))) { const unsigned ki = 16383u - kr; __hip_atomic_fetch_or(bm + (ki >> 5) * 32 + ql, 1u << (ki & 31u), __ATOMIC_RELAXED, __HIP_MEMORY_SCOPE_WORKGROUP); } }
            }
#undef SEL_ENT
        }
    }
    DMA_SYNC();
    for (int i = tid; i < 2 * NT * 32; i += NTHREADS) bitmapT[(size_t)(i >> 5) * S + qbase + (i & 31)] = bm[i];
    DMA_SYNC();
}

#define XB_TMO      128
#define XB_XCNT(j)  (256  + 64 * (j))
#define XB_XSUB(j)  (1280 + 64 * (j))
#define XB_XGEN(j)  (2304 + 64 * (j))
#define XB_TOP      3328
#define XB_TOPGEN   3392
#define XCD_BAR_WORDS 3456
#define XB_SPIN_CAP (1u << 22)
__device__ __forceinline__ unsigned xb_ld(unsigned* p)              { return __hip_atomic_load(p, __ATOMIC_RELAXED, __HIP_MEMORY_SCOPE_AGENT); }
__device__ __forceinline__ unsigned xb_add(unsigned* p, unsigned v) { return __hip_atomic_fetch_add(p, v, __ATOMIC_RELAXED, __HIP_MEMORY_SCOPE_AGENT); }
__device__ __forceinline__ unsigned xb_xcc_id() { return (unsigned)__builtin_amdgcn_s_getreg((3 << 11) | 20) & 0xFu; }
#define XB_SPIN(cond, bar) do { unsigned _sp = 0; while (cond) { __builtin_amdgcn_s_sleep(1); \
    if ((++_sp & 255u) == 0u) { if (xb_ld(&(bar)[XB_TMO])) break; if (_sp > XB_SPIN_CAP) { atomicAdd(&(bar)[XB_TMO], 1u); break; } } } } while (0)
struct XcdBarrier { unsigned* bar; unsigned x; volatile LAS unsigned* st; };
__device__ __forceinline__ XcdBarrier xcd_barrier_post(unsigned* bar, volatile LAS unsigned* st) {
    XcdBarrier b; b.bar = bar; b.x = xb_xcc_id(); b.st = st;
    return b;
}
__device__ __forceinline__ void xcd_barrier_complete(unsigned* bar, unsigned x, unsigned& nloc, unsigned& nx) {
    const unsigned G = gridDim.x * gridDim.y * gridDim.z;
    unsigned sum, cnt, mine, sp = 0u;
    for (;;) {
        sum = 0u; cnt = 0u; mine = 0u;
#pragma unroll
        for (unsigned j = 0; j < 16; ++j) { const unsigned c = xb_ld(&bar[XB_XCNT(j)]); sum += c; cnt += (c > 0u) ? 1u : 0u; mine = (j == x) ? c : mine; }
        if (sum == G) break;
        __builtin_amdgcn_s_sleep(1);
        if ((++sp & 255u) == 0u) { if (xb_ld(&bar[XB_TMO])) break; if (sp > XB_SPIN_CAP) { atomicAdd(&bar[XB_TMO], 1u); break; } }
    }
    nloc = mine > 0u ? mine : 1u; nx = cnt > 0u ? cnt : 1u;
}
__device__ __forceinline__ void xcd_barrier(const XcdBarrier& b) {
    asm volatile("s_waitcnt vmcnt(0)" ::: "memory");
    __syncthreads();
    if (threadIdx.x == 0) {
        unsigned* bar = b.bar;
        __builtin_amdgcn_s_waitcnt(0);
        unsigned nloc = b.st[0], nx = b.st[1];
        if (nloc == 0u) { xcd_barrier_complete(bar, b.x, nloc, nx); b.st[0] = nloc; b.st[1] = nx; }
        const unsigned old = xb_add(&bar[XB_XSUB(b.x)], 1u);
        const unsigned gen = old / nloc;
        if (old + 1u == (gen + 1u) * nloc) {
            __builtin_amdgcn_fence(__ATOMIC_RELEASE, "agent");
            asm volatile("s_waitcnt vmcnt(0)" ::: "memory");
            const unsigned og = xb_add(&bar[XB_TOP], 1u);
            const unsigned tg = og / nx;
            if (og + 1u == (tg + 1u) * nx) xb_add(&bar[XB_TOPGEN], 1u);
            else XB_SPIN(xb_ld(&bar[XB_TOPGEN]) == tg, bar);
            __builtin_amdgcn_fence(__ATOMIC_ACQUIRE, "agent");
            xb_add(&bar[XB_XGEN(b.x)], 1u);
            asm volatile("s_waitcnt vmcnt(0)" ::: "memory");
        } else {
            XB_SPIN(xb_ld(&bar[XB_XGEN(b.x)]) == gen, bar);
            __builtin_amdgcn_fence(__ATOMIC_ACQUIRE, "agent");
            asm volatile("s_waitcnt vmcnt(0)" ::: "memory");
        }
    }
    __syncthreads();
}

struct Args { const float* in[52]; float* out; unsigned char* ws; int ph_lo, ph_hi; };
enum { P_CONV = 0, P_KV, P_GU1, P_D1, P_WIN, P_MIXA, P_MIXB, P_MIXC, P_WOUT, P_WQ, P_MATT, P_WO, P_GU2, P_D2, P_PER_LAYER };
constexpr int PH_END = 2 * P_PER_LAYER;
#ifndef DBG_LAST
#define DBG_LAST PH_END
#endif

#define CONV_RUN(src0, src1, gain, dst, Nsrc, K, Nrows, mode) do { const int nitems_ = ((Nrows) / 32) * ((K) / 64); \
    f32x4 va_[8], vb_[8]; int it_ = gw; \
    if (it_ < nitems_) conv_load(src0, src1, gain, Nsrc, Nrows, mode, it_, lane, va_); \
    while (it_ < nitems_) { \
        if (it_ + NGW < nitems_) conv_load(src0, src1, gain, Nsrc, Nrows, mode, it_ + NGW, lane, vb_); \
        conv_store(dst, K, Nrows, it_, scr, lane, va_); it_ += NGW; if (it_ >= nitems_) break; \
        if (it_ + NGW < nitems_) conv_load(src0, src1, gain, Nsrc, Nrows, mode, it_ + NGW, lane, va_); \
        conv_store(dst, K, Nrows, it_, scr, lane, vb_); it_ += NGW; } } while (0)

__device__ __forceinline__ int t5_bucket(int rel) {
    const int off = rel < 0 ? 16 : 0; const int n = rel < 0 ? -rel : rel;
    if (n < 8) return off + n;
    int large = 8 + (int)(logf((float)n / 8.0f) / 2.772588722239781f * 8.0f);
    if (n == 64) large = 13;
    if (large > 15) large = 15;
    return off + large;
}

template <int L>
__device__ __forceinline__ void run_layer(const Args& a, LAS unsigned char* lds, cg::grid_group& grid, const XcdBarrier& xbar, int lo, int hi) {
    const int tid = threadIdx.x, lane = tid & 63, wave = __builtin_amdgcn_readfirstlane(tid >> 6);
    const int G = gridDim.x, bx = blockIdx.x;
    const int gw = bx * 8 + wave, NGW = G * 8;
    const int vcu = (G % 8 == 0) ? (bx % 8) * (G / 8) + bx / 8 : bx;
    unsigned char* ws = a.ws;
    constexpr int IB = (L == 0) ? 3 : 31;
    constexpr int MB = IB + ((L == 0) ? 17 : 10);
    constexpr int PB = L * P_PER_LAYER;
#define IN(k) (lo <= (PB + (k)) && (PB + (k)) < hi)
#define SYNC(k) do { if (IN(k) && (PB + (k) + 1) < hi) { if (PB + (k) == 0) { \
        if (bx == 0) { for (int i_ = threadIdx.x; i_ < XCD_BAR_WORDS; i_ += NTHREADS) __hip_atomic_store(&xbar.bar[i_], 0u, __ATOMIC_RELAXED, __HIP_MEMORY_SCOPE_AGENT); }     \
        grid.sync(); \
        if (threadIdx.x == 0) (void)xb_add(&xbar.bar[XB_XCNT(xbar.x)], 1u); } \
    else xcd_barrier(xbar); } } while (0)
    float* rsp = (float*)(ws + WS_RS); float* rsm = (float*)(ws + WS_RSM);
#define RSP(i) (rsp + (size_t)((i) & 1) * S * 16)
    bf16_t* hb = (bf16_t*)(ws + WS_HB); bf16_t* rb = (bf16_t*)a.out;
    bf16_t* osub = rb + (size_t)S * D;
    bf16_t* ocat = (bf16_t*)(ws + WS_OCAT);
    unsigned char* R = ws + WS_R;
    bf16_t* act = (bf16_t*)(R + R_ACT);
    float* lut5 = (float*)(ws + WS_LUT5); float* lutb = (float*)(ws + WS_LUTB);
    signed char* hq = (signed char*)(ws + WS_OCAT);
    float* qs = (float*)(ws + WS_QS); float* sb1 = (float*)(ws + WS_SB); float* sb2 = sb1 + 2 * FF; float* sbw = sb2 + 2 * FF;

#define CONVQ_RUN(MODE_, wg_, wu_, Nsrc_, Nrows_, gain_, dst_, sb_, first_, stride_) do { LAS float* xch_ = (LAS float*)(lds + 131072); \
        for (int it_ = (first_); it_ < (Nrows_) / 32; it_ += (stride_)) convq_item<MODE_>(wg_, wu_, Nsrc_, gain_, (signed char*)(dst_), sb_, it_, scr, xch_, wave, lane); } while (0)
#define CV_D1(IBx)   CONV_RUN(a.in[(IBx) + 3], a.in[(IBx) + 3], (const float*)nullptr, (bf16_t*)(ws + W_D1), D, FF, D, MAP_P8)
#define CV_WOUT(MBx) CONV_RUN(a.in[(MBx) - 1], a.in[(MBx) - 1], (const float*)nullptr, (bf16_t*)(ws + W_OUT), D, D, D, MAP_P8)
#define CV_WQ(MBx)   CONV_RUN(a.in[(MBx) + 2], a.in[(MBx) + 2], a.in[(MBx) + 0], (bf16_t*)(ws + W_Q), 512, D, 512, MAP_P8)
#define CV_WKV(MBx, slot_)  CONV_RUN(a.in[(MBx) + 3], a.in[(MBx) + 3], a.in[(MBx) + 1], (bf16_t*)(ws + (slot_)), D, D, D, MAP_P8)
#define CV_WO(MBx)   CONV_RUN(a.in[(MBx) + 6], a.in[(MBx) + 6], (const float*)nullptr, (bf16_t*)(ws + W_O), D, 512, D, MAP_P8)
#define CV_D2(MBx)   CONV_RUN(a.in[(MBx) + 10], a.in[(MBx) + 10], (const float*)nullptr, (bf16_t*)(ws + W_D2), D, FF, D, MAP_P8)
#define CV_GU1Q(IBx, f_, s_) CONVQ_RUN(MAP_GU, a.in[(IBx) + 1], a.in[(IBx) + 2], FF, 2 * FF, a.in[(IBx) + 0], ws + W_GU1, sb1, f_, s_)
#define CV_GU2Q(MBx, f_, s_) CONVQ_RUN(MAP_GU, a.in[(MBx) + 8], a.in[(MBx) + 9], FF, 2 * FF, a.in[(MBx) + 7], ws + W_GU2, sb2, f_, s_)
#define CV_WIN0Q(IBx, f_, s_) CONVQ_RUN(MAP_H64Q_L0, a.in[(IBx) + 5], a.in[(IBx) + 5], 3656, NWINQ, a.in[(IBx) + 4], ws + W_IN, sbw, f_, s_)
#define CV_WIN1Q(IBx, f_, s_) CONVQ_RUN(MAP_H64_L1, a.in[(IBx) + 5], a.in[(IBx) + 5], 3072, NWINQ, a.in[(IBx) + 4], ws + W_IN, sbw, f_, s_)
#define CV_WIN0I(IBx) CONV_RUN(a.in[(IBx) + 5], a.in[(IBx) + 5], a.in[(IBx) + 4], (bf16_t*)(ws + W_INI), 3656, D, NWINI, MAP_H64I_L0)
#define SIDE_BEGIN(fb, nb) if (bx >= (fb) && bx < (fb) + (nb)) { const int sf_ = bx - (fb), ss_ = (nb); const int gw = sf_ * 8 + wave, NGW = ss_ * 8; LAS float* scr = (LAS float*)(lds + wave * 16384); (void)gw; (void)NGW; (void)scr;
#define SIDE_END() }
#define KV_GEMM(cb, slot_, raw_) do { if (bx >= (cb) && bx < (cb) + 4) { \
        pg8::Gemm g_{(const bf16_t*)(ws + WS_MEMB), (const bf16_t*)(ws + (slot_)), NMEM, D, D}; pg8::StaticOrder so_; so_.init(NMEM, D, G, bx - (cb)); \
        EpiF32 E_{(float*)(ws + (raw_)), D, rsm}; pg8::gemm_phase(lds, g_, so_, E_); } } while (0)
#define KV_NORM(kgp, cb, raw_) do { if (bx >= (cb) && bx < (cb) + 8) { \
        const float* kv = (const float*)(ws + (raw_)); bf16_t* km = (bf16_t*)(ws + WS_KMEM); bf16_t* vm = (bf16_t*)(ws + WS_VMEM); const float* kg = (kgp); \
        for (int m = (bx - (cb)) * 8 + wave; m < NMEM; m += 64) { \
            const f32x4 k0 = *(const f32x4*)(kv + (size_t)m * D + 8 * lane), k1 = *(const f32x4*)(kv + (size_t)m * D + 8 * lane + 4); \
            float ss = (k0[0] * k0[0] + k0[1] * k0[1]) + (k0[2] * k0[2] + k0[3] * k0[3]) + (k1[0] * k1[0] + k1[1] * k1[1]) + (k1[2] * k1[2] + k1[3] * k1[3]); \
            ss += __shfl_xor(ss, 1); ss += __shfl_xor(ss, 2); ss += __shfl_xor(ss, 4); ss += __shfl_xor(ss, 8); \
            const float inv = 1.0f / sqrtf(ss * (1.0f / 128.0f) + EPS); \
            const int d = (8 * lane) & 127; const f32x4 ga = *(const f32x4*)(kg + d), gb = *(const f32x4*)(kg + d + 4); \
            u32x4 w; w.x = cvt_pk_bf16(k0[0] * inv * ga[0], k0[1] * inv * ga[1]); w.y = cvt_pk_bf16(k0[2] * inv * ga[2], k0[3] * inv * ga[3]); \
            w.z = cvt_pk_bf16(k1[0] * inv * gb[0], k1[1] * inv * gb[1]); w.w = cvt_pk_bf16(k1[2] * inv * gb[2], k1[3] * inv * gb[3]); \
            *(u32x4*)(km + (size_t)m * 512 + 8 * lane) = w; \
            const f32x4 v0 = *(const f32x4*)(kv + (size_t)m * D + 512 + 8 * lane), v1 = *(const f32x4*)(kv + (size_t)m * D + 512 + 8 * lane + 4); \
            u32x4 x; x.x = cvt_pk_bf16(v0[0], v0[1]); x.y = cvt_pk_bf16(v0[2], v0[3]); x.z = cvt_pk_bf16(v1[0], v1[1]); x.w = cvt_pk_bf16(v1[2], v1[3]); \
            *(u32x4*)(vm + (size_t)m * 512 + 8 * lane) = x; } } } while (0)
    const int SLK = G >> 1;

    if (L == 0 && IN(P_CONV)) {
        LAS float* scr = (LAS float*)(lds + wave * 16384);
        CV_GU1Q(3, bx, G); CV_D1(3);
        { f32x4 va[4], vb[4]; int m = gw;
          if (m < S) row_load(a.in[0] + (size_t)m * D, lane, va);
          while (m < S) {
              if (m + NGW < S) row_load(a.in[0] + (size_t)(m + NGW) * D, lane, vb);
              row_to_q8(va, hq + (size_t)m * D, qs + m, RSP(0) + (size_t)m * 16, lane); m += NGW; if (m >= S) break;
              if (m + NGW < S) row_load(a.in[0] + (size_t)(m + NGW) * D, lane, va);
              row_to_q8(vb, hq + (size_t)m * D, qs + m, RSP(0) + (size_t)m * 16, lane); m += NGW; } }
        for (int m = gw; m < NMEM; m += NGW) row_to_bf16(a.in[1] + (size_t)m * D, (bf16_t*)(ws + WS_MEMB) + (size_t)m * D, rsm + (size_t)m * 16, lane);
        for (int i = bx * NTHREADS + tid; i < 12 * 256; i += G * NTHREADS) { const int h = i >> 8, e = i & 255; const int rel = 191 - e;
            lut5[i] = (a.in[2][t5_bucket(rel) * 12 + h] - a.in[2][15 * 12 + h]) * LOG2E; }
        for (int i = bx * NTHREADS + tid; i < 16 * 640; i += G * NTHREADS) { const int h = i / 640, e = i % 640; int rel = 575 - e; rel = rel < -256 ? -256 : (rel > 256 ? 256 : rel);
            lutb[i] = (a.in[39][(rel + 256) * 16 + h] - a.in[39][512 * 16 + h]) * LOG2E; }
    }
    if (L == 0) SYNC(P_CONV);
    if (IN(P_GU1)) {
        pg8::Gemm g{(const bf16_t*)hq, (const bf16_t*)(ws + W_GU1), S, 2 * FF, D / 2}; pg8::StaticOrder so; so.init(S, 2 * FF, G, bx);
        LAS float* tab = (LAS float*)(lds + pg8::STAGE_BYTES); guq_prep<true>(tab, so, RSP(4 * L + 0), qs, sb1);
        EpiGUq E{act, tab};
        pg8::gemm_phase(lds, g, so, E);
        if (L == 0) { SIDE_BEGIN(SLK, G - SLK) CV_WIN0Q(3, sf_, ss_); CV_WIN0I(3); CV_WKV(20, W_KV); SIDE_END() }
        else { SIDE_BEGIN(SLK, G - SLK) CV_WIN1Q(31, sf_, ss_); CV_WOUT(41); CV_WQ(41); CV_WO(41); SIDE_END() }
    }
    SYNC(P_GU1);
    if (IN(P_D1)) {
        pg8::Gemm g{act, (const bf16_t*)(ws + W_D1), S, D, FF}; pg8::StaticOrder so; so.init(S, D, G, bx);
        if (L == 0) { EpiRes<true, true, false, true> E{a.in[0], rb, hq, RSP(4 * L + 1), qs, RSP(4 * L + 0)}; pg8::gemm_phase(lds, g, so, E); }
        else { EpiRes<true, false, false, true> E{rb, rb, hq, RSP(4 * L + 1), qs, RSP(4 * L + 0)}; pg8::gemm_phase(lds, g, so, E); }
    }
    SYNC(P_D1);
    if (IN(P_WIN)) {
        pg8::Gemm g{(const bf16_t*)hq, (const bf16_t*)(ws + W_IN), S, NWINQ, D / 2}; pg8::StaticOrder so; so.init(S, NWINQ, G, bx);
        LAS float* tab = (LAS float*)(lds + pg8::STAGE_BYTES); guq_prep<false>(tab, so, RSP(4 * L + 1), qs, sbw);
        if (L == 0) {
            { EpiWin<0> E{R, nullptr, tab, a.in[IB + 6], a.in[IB + 7], a.in[IB + 9], a.in[IB + 10]}; pg8::gemm_phase(lds, g, so, E); }
            pg8::Gemm gi{rb, (const bf16_t*)(ws + W_INI), S, NWINI, D}; pg8::StaticOrder si; si.init(S, NWINI, G, bx);
            EpiWin<2> Ei{R, RSP(4 * L + 1), nullptr, a.in[IB + 8], nullptr, nullptr, nullptr}; pg8::gemm_phase(lds, gi, si, Ei);
        } else { EpiWin<1> E{R, nullptr, tab, a.in[IB + 6], a.in[IB + 7], nullptr, nullptr}; pg8::gemm_phase(lds, g, so, E); }
        if (L == 0) { KV_GEMM((3 * G) >> 2, W_KV, WS_KVRAW);
            SIDE_BEGIN(((3 * G) >> 2) + 4, G - ((3 * G) >> 2) - 4) CV_WOUT(20); CV_WQ(20); CV_WO(20); CV_D1(31); CV_WKV(41, W_KV2); SIDE_END() }
    }
    SYNC(P_WIN);
    if (L == 0) {
        if (IN(P_MIXA)) {
            for (int pr = vcu; pr < 256; pr += G) {
                dsa_select_unit(lds, 511 - pr, (const bf16_t*)(R + R_IQ), (const bf16_t*)(R + R_IK), (const float*)(R + R_IW), a.in[IB + 8], (unsigned*)hb, (unsigned*)(ws + W_GU1 + 6 * MiB) + (size_t)bx * 2 * SEL_POOLCAP);
                dsa_select_unit(lds, pr, (const bf16_t*)(R + R_IQ), (const bf16_t*)(R + R_IK), (const float*)(R + R_IW), a.in[IB + 8], (unsigned*)hb, (unsigned*)(ws + W_GU1 + 6 * MiB) + (size_t)bx * 2 * SEL_POOLCAP);
            }
            for (int pr = vcu; pr < 256; pr += G) { const int hm = pr >> 5, s = pr & 31;
#pragma unroll 1
                for (int k = 0; k < 2; ++k) { const int qb = k ? s : 63 - s;
                    attn_unit<64, 128, AM_T5>(lds, (const bf16_t*)(R + R_BQ) + hm * 64, 512, (const bf16_t*)(R + R_BK) + hm * 64, 512, (const bf16_t*)(R + R_BV) + (hm >> 1) * 128, 512,
                                              osub + hm * 128, 1024, qb * 256, lut5 + (8 + (hm >> 1)) * 256, nullptr, nullptr); }
            }
        }
        SYNC(P_MIXA);
        if (IN(P_MIXB)) {
            const float lq1 = a.in[IB + 11][lane], lk1 = a.in[IB + 12][lane], lq2 = a.in[IB + 13][lane], lk2 = a.in[IB + 14][lane];
            const float lam = __expf(wave_sum(lq1 * lk1)) - __expf(wave_sum(lq2 * lk2)) + 0.2f;
            const float g0 = a.in[IB + 15][2 * lane], g1 = a.in[IB + 15][2 * lane + 1];
            unsigned wn[8];
            if (gw < S) {
#pragma unroll
                for (int j = 0; j < 8; ++j) wn[j] = *(const unsigned*)(osub + (size_t)gw * 1024 + j * 128 + 2 * lane);
            }
            for (int m = gw; m < S; m += NGW) {
                unsigned w[8];
#pragma unroll
                for (int j = 0; j < 8; ++j) w[j] = wn[j];
                if (m + NGW < S) {
#pragma unroll
                    for (int j = 0; j < 8; ++j) wn[j] = *(const unsigned*)(osub + (size_t)(m + NGW) * 1024 + j * 128 + 2 * lane);
                }
                asm volatile("" ::: "memory");
#pragma unroll
                for (int h = 0; h < 4; ++h) {
                    const float a0 = bf2f((unsigned short)(w[2 * h] & 0xffffu)) - lam * bf2f((unsigned short)(w[2 * h + 1] & 0xffffu));
                    const float a1 = bf2f((unsigned short)(w[2 * h] >> 16)) - lam * bf2f((unsigned short)(w[2 * h + 1] >> 16));
                    const float inv = 0.8f / sqrtf(wave_sum(a0 * a0 + a1 * a1) * (1.0f / 128.0f) + EPS);
                    *(unsigned*)(ocat + (size_t)m * 1024 + 512 + h * 128 + 2 * lane) = cvt_pk_bf16(a0 * inv * g0, a1 * inv * g1);
                }
            }
        }
        if (IN(P_MIXC)) {
            for (int pr = vcu; pr < 256; pr += G) { const int hd = pr >> 5, s = pr & 31;
#pragma unroll 1
                for (int k = 0; k < 2; ++k) { const int qb = k ? s : 63 - s;
                    attn_unit<64, 64, AM_T5_BITMAP>(lds, (const bf16_t*)(R + R_AQ) + hd * 64, 512, (const bf16_t*)(R + R_AK) + hd * 64, 512, (const bf16_t*)(R + R_AV) + hd * 64, 512,
                                                    ocat + hd * 64, 1024, qb * 256, lut5 + hd * 256, (const unsigned*)hb, nullptr); }
            }
        }
        SYNC(P_MIXC);
    } else {
        if (IN(P_MIXA)) {
            for (int u = vcu; u < 1024; u += G) { const int hd = u >> 6, qb = u & 63;
                attn_unit<64, 64, AM_BAND>(lds, (const bf16_t*)(R + R_CQ) + hd * 64, 1024, (const bf16_t*)(R + R_CK) + hd * 64, 1024, (const bf16_t*)(R + R_CV) + hd * 64, 1024,
                                           ocat + hd * 64, 1024, qb * 256, lutb + hd * 640, nullptr, nullptr); }
        }
        SYNC(P_MIXA);
    }
    if (IN(P_WOUT)) {
        pg8::Gemm g{ocat, (const bf16_t*)(ws + W_OUT), S, D, D}; pg8::StaticOrder so; so.init(S, D, G, bx);
        EpiRes<false, false, false, false> E{rb, rb, nullptr, RSP(4 * L + 2), nullptr, nullptr};
        pg8::gemm_phase(lds, g, so, E);
    }
    SYNC(P_WOUT);
    if (IN(P_WQ)) {
        pg8::Gemm g{rb, (const bf16_t*)(ws + W_Q), S, 512, D}; pg8::StaticOrder so; so.init(S, 512, G, bx);
        EpiBf16 E{(bf16_t*)(R + R_QM), 512, RSP(4 * L + 2)};
        pg8::gemm_phase(lds, g, so, E);
        KV_NORM(a.in[MB + 5], G - 8, L == 0 ? WS_KVRAW : WS_KVRAW2);
        if (L == 0) { KV_GEMM(G - 12, W_KV2, WS_KVRAW2);
            SIDE_BEGIN(SLK, G - SLK - 12) CV_GU2Q(20, sf_, ss_); CV_D2(20); SIDE_END() }
        else { SIDE_BEGIN(SLK, G - SLK - 8) CV_GU2Q(41, sf_, ss_); CV_D2(41); SIDE_END() }
    }
    SYNC(P_WQ);
    if (IN(P_MATT)) {
        for (int u = vcu; u < 256; u += G) { const int hd = u >> 6, qb = u & 63;
            attn_unit<128, 128, AM_MEM>(lds, (const bf16_t*)(R + R_QM) + hd * 128, 512, (const bf16_t*)(ws + WS_KMEM) + hd * 128, 512, (const bf16_t*)(ws + WS_VMEM) + hd * 128, 512,
                                        (bf16_t*)(R + R_OM) + hd * 128, 512, qb * 256, nullptr, nullptr, a.in[MB + 4]); }
    }
    SYNC(P_MATT);
    if (IN(P_WO)) {
        pg8::Gemm g{(const bf16_t*)(R + R_OM), (const bf16_t*)(ws + W_O), S, D, 512}; pg8::StaticOrder so; so.init(S, D, G, bx);
        EpiRes<false, false, false, true> E{rb, L == 1 ? hb : rb, hq, RSP(4 * L + 3), qs, RSP(4 * L + 2)};
        pg8::gemm_phase(lds, g, so, E);
    }
    SYNC(P_WO);
    if (IN(P_GU2)) {
        pg8::Gemm g{(const bf16_t*)hq, (const bf16_t*)(ws + W_GU2), S, 2 * FF, D / 2}; pg8::StaticOrder so; so.init(S, 2 * FF, G, bx);
        LAS float* tab = (LAS float*)(lds + pg8::STAGE_BYTES); guq_prep<true>(tab, so, RSP(4 * L + 3), qs, sb2);
        EpiGUq E{act, tab};
        pg8::gemm_phase(lds, g, so, E);
        if (L == 0) { SIDE_BEGIN(SLK, G - SLK) CV_GU1Q(31, sf_, ss_); SIDE_END() }
    }
    SYNC(P_GU2);
    if (IN(P_D2)) {
        pg8::Gemm g{act, (const bf16_t*)(ws + W_D2), S, D, FF}; pg8::StaticOrder so; so.init(S, D, G, bx);
        if (L == 0) { EpiRes<true, false, false, true> E{rb, rb, hq, RSP(4), qs, RSP(3)}; pg8::gemm_phase(lds, g, so, E); }
        else { EpiRes<true, false, true, false> E{hb, a.out, nullptr, nullptr, nullptr, nullptr}; pg8::gemm_phase(lds, g, so, E); }
    }
    SYNC(P_D2);
#undef IN
#undef SYNC
}

__global__ void __launch_bounds__(NTHREADS, 2) mk_fwd(Args a) {
    extern __shared__ __attribute__((aligned(16))) unsigned char lds_raw[];
    LAS unsigned char* lds = (LAS unsigned char*)lds_raw;
    cg::grid_group grid = cg::this_grid();
    const int lo = a.ph_lo, hi = a.ph_hi;
    if (threadIdx.x < 64) ((LAS unsigned*)(lds + MISC_OFF))[threadIdx.x] = 0u;
    __syncthreads();
    const XcdBarrier xbar = xcd_barrier_post((unsigned*)(a.ws + WS_BAR), (volatile LAS unsigned*)(lds + MISC_OFF) + 8);
    run_layer<0>(a, lds, grid, xbar, lo, hi);
    run_layer<1>(a, lds, grid, xbar, lo, hi);
}

extern "C" void kernel_launch(void* const* d_in, const int* in_sizes, int n_in, void* d_out, int out_size, void* d_ws, size_t ws_size, hipStream_t stream) {
    static int grid = 0;
    if (grid == 0) {
        if (n_in != 52 || out_size != S * D || ws_size < WS_END) { fprintf(stderr, "kernel_launch: unexpected shapes n_in %d out %d ws %zu\n", n_in, out_size, ws_size); grid = -1; return; }
        int dev = 0, cus = 0, per_cu = 0;
        (void)hipGetDevice(&dev); (void)hipDeviceGetAttribute(&cus, hipDeviceAttributeMultiprocessorCount, dev);
        (void)hipFuncSetAttribute((const void*)mk_fwd, hipFuncAttributeMaxDynamicSharedMemorySize, LDS_BYTES);
        (void)hipOccupancyMaxActiveBlocksPerMultiprocessor(&per_cu, (const void*)mk_fwd, NTHREADS, LDS_BYTES);
        if (per_cu < 1) { fprintf(stderr, "kernel_launch: occupancy query says %d\n", per_cu); per_cu = 1; }
        grid = cus * 1;
        (void)hipGetLastError();
    }
    if (grid < 0) return;
    Args a{};
    for (int i = 0; i < 52; ++i) a.in[i] = (const float*)d_in[i];
    a.out = (float*)d_out; a.ws = (unsigned char*)d_ws;
    a.ph_lo = 0; a.ph_hi = DBG_LAST;
    void* args[] = {&a};
    hipError_t e = hipLaunchCooperativeKernel((const void*)mk_fwd, dim3(grid), dim3(NTHREADS), args, LDS_BYTES, stream);
    if (e != hipSuccess) fprintf(stderr, "kernel_launch: cooperative launch failed: %s\n", hipGetErrorString(e));
}
```

```cpp
#include <hip/hip_runtime.h>
#include <hip/hip_cooperative_groups.h>
#include <cstdio>
#include <cstdint>
namespace cg = cooperative_groups;

#define LAS __attribute__((address_space(3)))
typedef unsigned short bf16_t;
typedef short bf16x8 __attribute__((ext_vector_type(8)));
typedef short s16x4 __attribute__((ext_vector_type(4)));
typedef float f32x4 __attribute__((ext_vector_type(4)));
typedef float f32x2 __attribute__((ext_vector_type(2)));
typedef float f32x16 __attribute__((ext_vector_type(16)));
typedef unsigned u32x4 __attribute__((ext_vector_type(4)));
typedef unsigned u32x2 __attribute__((ext_vector_type(2)));
typedef int i32x4 __attribute__((ext_vector_type(4)));

constexpr int S = 16384, D = 1024, FF = 2816, NMEM = 256;
constexpr float EPS = 1e-6f;
constexpr float LOG2E = 1.4426950408889634f;
constexpr int NWIN0 = 3840, NWINQ = 3072, NWINI = 768;

constexpr size_t MiB = 1u << 20;
constexpr size_t WS_RS = 4 * MiB;
constexpr size_t WS_RSM = 6 * MiB;
constexpr size_t WS_QS = 6 * MiB + 64 * 1024;
constexpr size_t WS_SB = 6 * MiB + 128 * 1024;
constexpr size_t WS_LUT5 = 640 * 1024;
constexpr size_t WS_LUTB = 656 * 1024;
constexpr size_t WS_MISC = 700 * 1024;
constexpr size_t WS_BAR = 768 * 1024;
constexpr size_t WS_KVRAW = 1 * MiB;
constexpr size_t WS_KVRAW2 = 7 * MiB;
constexpr size_t WS_KMEM = 2 * MiB;
constexpr size_t WS_VMEM = 2 * MiB + 512 * 1024;
constexpr size_t WS_MEMB = 3 * MiB;
constexpr size_t WS_W = 8 * MiB;
constexpr size_t W_GU1 = WS_W, W_D1 = W_GU1 + (size_t)2 * FF * D * 2, W_GU2 = W_D1 + (size_t)D * FF * 2, W_D2 = W_GU2 + (size_t)2 * FF * D * 2;
constexpr size_t W_IN = W_D2 + (size_t)D * FF * 2, W_OUT = W_IN + (size_t)NWIN0 * D * 2, W_Q = W_OUT + (size_t)D * D * 2, W_KV = W_Q + (size_t)512 * D * 2, W_O = W_KV + (size_t)D * D * 2;
constexpr size_t W_END = W_O + (size_t)D * 512 * 2;
constexpr size_t W_KV2 = W_END;
static_assert(W_KV2 + (size_t)D * D * 2 <= 58 * MiB, "w_kv2 slot");
constexpr size_t W_INI = W_IN + 4 * MiB;
constexpr size_t WS_HB = 58 * MiB;
constexpr size_t WS_OCAT = 90 * MiB;
constexpr size_t WS_R = 122 * MiB;
constexpr size_t WS_END = 256 * MiB;
static_assert(W_END <= WS_HB, "weights fit");
constexpr size_t R_ACT = 0;
constexpr size_t R_AQ = 0, R_AK = 16 * MiB, R_AV = 32 * MiB, R_IQ = 48 * MiB, R_BQ = 64 * MiB, R_BK = 80 * MiB, R_BV = 96 * MiB, R_IK = 112 * MiB, R_IW = 114 * MiB;
constexpr size_t R_CQ = 0, R_CK = 32 * MiB, R_CV = 64 * MiB;
constexpr size_t R_QM = 96 * MiB, R_OM = 112 * MiB;
static_assert(WS_R + R_OM + 16 * MiB <= WS_END && WS_R + R_IW + MiB <= WS_END, "region R");

constexpr int LDS_BYTES = 160 * 1024 - 2048;
constexpr int NTHREADS = 512;
constexpr int MISC_OFF = LDS_BYTES - 256;

__device__ __forceinline__ unsigned cvt_pk_bf16(float lo, float hi) { unsigned r; asm("v_cvt_pk_bf16_f32 %0, %1, %2" : "=v"(r) : "v"(lo), "v"(hi)); return r; }
__device__ __forceinline__ unsigned f2bf(float f) { unsigned u = __builtin_bit_cast(unsigned, f); return (u + 0x7fffu + ((u >> 16) & 1u)) >> 16; }
__device__ __forceinline__ float bf2f(unsigned short b) { return __builtin_bit_cast(float, ((unsigned)b) << 16); }
__device__ __forceinline__ float wave_sum(float v) {
#pragma unroll
    for (int o = 1; o < 64; o <<= 1) v += __shfl_xor(v, o);
    return v;
}

__device__ __forceinline__ float sum_xor16(float x) { const unsigned u = __float_as_uint(x); auto r = __builtin_amdgcn_permlane16_swap(u, u, false, false); return __uint_as_float(r[0]) + __uint_as_float(r[1]); }
__device__ __forceinline__ float sum_xor32(float x) { const unsigned u = __float_as_uint(x); auto r = __builtin_amdgcn_permlane32_swap(u, u, false, false); return __uint_as_float(r[0]) + __uint_as_float(r[1]); }

namespace pg8 {
constexpr int BM = 256, BK = 64, HALF = 128, HTB = HALF * BK * 2, STAGE_BYTES = 8 * HTB, NXCD = 8, WGM = 8;
__host__ __device__ __forceinline__ int lds_byte(int r, int c) { const int st = (r >> 4) * 2 + (c >> 5), rr = r & 15, cc = c & 31, ob = rr * 64 + cc * 2; return st * 1024 + (ob ^ (((ob >> 9) & 1) << 5)); }
__host__ __device__ __forceinline__ void stage_rc(int b, int& R, int& C) { const int st = b / 1024, sb = b % 1024, swz = sb ^ (((sb >> 9) & 1) << 5); R = (st >> 1) * 16 + swz / 64; C = (st & 1) * 32 + (swz % 64) / 2; }
struct Unit { int pm, pn, ui; };
struct Gemm { const bf16_t* A; const bf16_t* Bt; int M, N, K; };
struct StaticOrder {
    int nM, nN, nwg, G, c;
    __device__ void init(int M, int N, int G_, int c_) { nM = M / BM; nN = N / BM; nwg = nM * nN; G = G_; c = c_; }
    __device__ bool next(int i, Unit& u) const {
        const long L = (long)i * G + c; if (L >= nwg) return false;
        int wgid = (int)L; { const int q = nwg / NXCD, r = nwg % NXCD, xcd = wgid % NXCD, off = wgid / NXCD; wgid = (xcd < r ? xcd * (q + 1) : r * (q + 1) + (xcd - r) * q) + off; }
        const int nig = WGM * nN, gid = wgid / nig, fm = gid * WGM, gsz = (nM - fm) < WGM ? (nM - fm) : WGM;
        u.pm = fm + ((wgid % nig) % gsz); u.pn = (wgid % nig) / gsz; u.ui = i; return true;
    }
};

template <class Epi>
__device__ __forceinline__ void gemm_phase(LAS unsigned char* lds, const Gemm g, const StaticOrder& S, const Epi& E) {
    int tid = threadIdx.x; asm volatile("" : "+v"(tid));
    const int wid = __builtin_amdgcn_readfirstlane(tid >> 6), lane = tid & 63, wr = wid >> 2, wc = wid & 3, fr = lane & 15, fq = lane >> 4;
    const int K = g.K, nt = K / BK;
    unsigned voffA[2];
#pragma unroll
    for (int i = 0; i < 2; ++i) { int R, C; stage_rc(tid * 16 + i * 8192, R, C); voffA[i] = (unsigned)(R * K + C) * 2u; }
    const size_t kstep = (size_t)(BK * 2);
    const size_t hstep = (size_t)HALF * K * 2;
    const size_t tstep = 2 * hstep;
    const unsigned ldsw = (unsigned)wid * 1024u;
    const int aoff = lds_byte(wr * 64 + fr, fq * 8), boff = lds_byte(wc * 32 + fr, fq * 8);
#define PG8_SA(b, h) (((b) * 2 + (h)) * HTB)
#define PG8_SB(b, h) ((4 + (b) * 2 + (h)) * HTB)
#define PG8_STAGE(bufoff, gbase) do { _Pragma("unroll") for (int _i = 0; _i < 2; ++_i) \
        __builtin_amdgcn_global_load_lds((const unsigned*)((const char*)(gbase) + voffA[_i]), (LAS unsigned*)(lds + (bufoff) + ldsw + _i * 8192), 16, 0, 0); } while (0)
#define PG8_LDA(dst, b, h) do { _Pragma("unroll") for (int m = 0; m < 4; ++m) _Pragma("unroll") for (int k = 0; k < 2; ++k) dst[m][k] = *(const LAS bf16x8*)(lds + PG8_SA(b, h) + aoff + m * 2048 + k * 1024); } while (0)
#define PG8_LDB(dst, b, h) do { _Pragma("unroll") for (int n = 0; n < 2; ++n) _Pragma("unroll") for (int k = 0; k < 2; ++k) dst[n][k] = *(const LAS bf16x8*)(lds + PG8_SB(b, h) + boff + n * 2048 + k * 1024); } while (0)
#define PG8_MMA(ai, bj, At, Bt) do { __builtin_amdgcn_s_setprio(1); _Pragma("unroll") for (int m = 0; m < 4; ++m) _Pragma("unroll") for (int n = 0; n < 2; ++n) _Pragma("unroll") for (int k = 0; k < 2; ++k) { \
        if constexpr (Epi::I8) acc[ai][bj][m][n] = __builtin_amdgcn_mfma_i32_16x16x64_i8(__builtin_bit_cast(i32x4, Bt[n][k]), __builtin_bit_cast(i32x4, At[m][k]), acc[ai][bj][m][n], 0, 0, 0); \
        else acc[ai][bj][m][n] = __builtin_amdgcn_mfma_f32_16x16x32_bf16(Bt[n][k], At[m][k], acc[ai][bj][m][n], 0, 0, 0); } __builtin_amdgcn_s_setprio(0); } while (0)
#define PG8_WAIT_V(n) asm volatile("s_waitcnt vmcnt(" #n ")" ::: "memory")
#define PG8_WAIT_L(n) asm volatile("s_waitcnt lgkmcnt(" #n ")" ::: "memory")
#define PG8_BAR __builtin_amdgcn_s_barrier()
#define PG8_SCHED __builtin_amdgcn_sched_barrier(0)
    Unit cur, nxt; int ui = 0;
    if (!S.next(0, cur)) return;
    using acc_t = typename Epi::acc_t;
    acc_t acc[2][2][4][2];
#pragma unroll
    for (int a = 0; a < 2; ++a)
#pragma unroll
        for (int b = 0; b < 2; ++b)
#pragma unroll
            for (int m = 0; m < 4; ++m)
#pragma unroll
                for (int n = 0; n < 2; ++n) acc[a][b][m][n] = acc_t{};
    bf16x8 At[4][2], B0[2][2], B1[2][2];
    const char* cA = (const char*)g.A + (size_t)cur.pm * tstep; const char* cB = (const char*)g.Bt + (size_t)cur.pn * tstep;
    PG8_STAGE(PG8_SB(0, 0), cB); PG8_STAGE(PG8_SB(0, 1), cB + hstep); PG8_STAGE(PG8_SA(0, 0), cA); PG8_STAGE(PG8_SA(0, 1), cA + hstep);
    if (wr == 1) PG8_BAR;
    PG8_WAIT_V(2); PG8_BAR;
    PG8_STAGE(PG8_SB(1, 0), cB + kstep); PG8_STAGE(PG8_SA(1, 0), cA + kstep); PG8_STAGE(PG8_SB(1, 1), cB + hstep + kstep);
    PG8_WAIT_V(6); PG8_BAR;
    for (;;) {
        const bool has_next = S.next(ui + 1, nxt);
        const char* nA = has_next ? (const char*)g.A + (size_t)nxt.pm * tstep : cA; const char* nB = has_next ? (const char*)g.Bt + (size_t)nxt.pn * tstep : cB;
        for (int t = 0; t < nt; t += 2) {
            const bool last = (t == nt - 2);
            const char* a1 = cA + (size_t)(t + 1) * kstep;
            const char* a2 = last ? nA : cA + (size_t)(t + 2) * kstep; const char* b2 = last ? nB : cB + (size_t)(t + 2) * kstep;
            const char* a3 = a2 + kstep; const char* b3 = b2 + kstep;
            PG8_LDB(B0, 0, 0); PG8_LDB(B1, 0, 1); PG8_SCHED; PG8_LDA(At, 0, 0); PG8_STAGE(PG8_SA(1, 1), a1 + hstep);
            PG8_WAIT_V(8); PG8_WAIT_L(0); PG8_BAR; PG8_MMA(0, 0, At, B0); PG8_MMA(0, 1, At, B1); PG8_BAR; PG8_SCHED;
            PG8_LDA(At, 0, 1); PG8_STAGE(PG8_SB(0, 0), b2); PG8_STAGE(PG8_SB(0, 1), b2 + hstep); PG8_STAGE(PG8_SA(0, 0), a2);
            PG8_WAIT_V(8); PG8_WAIT_L(0); PG8_BAR; PG8_MMA(1, 0, At, B0); PG8_MMA(1, 1, At, B1); PG8_BAR; PG8_SCHED;
            PG8_LDB(B0, 1, 0); PG8_LDB(B1, 1, 1); PG8_SCHED; PG8_LDA(At, 1, 0); PG8_STAGE(PG8_SA(0, 1), a2 + hstep);
            PG8_WAIT_V(8); PG8_WAIT_L(0); PG8_BAR; PG8_MMA(0, 0, At, B0); PG8_MMA(0, 1, At, B1); PG8_BAR; PG8_SCHED;
            PG8_LDA(At, 1, 1); PG8_STAGE(PG8_SB(1, 0), b3); PG8_STAGE(PG8_SB(1, 1), b3 + hstep); PG8_STAGE(PG8_SA(1, 0), a3);
            PG8_WAIT_V(8); PG8_WAIT_L(0); PG8_BAR; PG8_MMA(1, 0, At, B0); PG8_MMA(1, 1, At, B1); PG8_BAR; PG8_SCHED;
        }
        if (wr == 0) PG8_BAR;
        E(acc, cur, wr, wc, fr, fq);
        if (!has_next) break;
#pragma unroll
        for (int a = 0; a < 2; ++a)
#pragma unroll
            for (int b = 0; b < 2; ++b)
#pragma unroll
                for (int m = 0; m < 4; ++m)
#pragma unroll
                    for (int n = 0; n < 2; ++n) acc[a][b][m][n] = acc_t{};
        cur = nxt; cA = nA; cB = nB; ++ui;
        if (wr == 1) PG8_BAR;
    }
    PG8_WAIT_V(0);
    PG8_BAR;
#undef PG8_SA
#undef PG8_SB
#undef PG8_STAGE
#undef PG8_LDA
#undef PG8_LDB
#undef PG8_MMA
#undef PG8_WAIT_V
#undef PG8_WAIT_L
#undef PG8_BAR
#undef PG8_SCHED
}
}
using pg8::Unit;

__device__ __forceinline__ void load_rstd(const float* parts, int row0, int fq, float (&rs)[2][4]) {
    float s[2][4];
#pragma unroll
    for (int ai = 0; ai < 2; ++ai)
#pragma unroll
        for (int m = 0; m < 4; ++m) { const f32x4 a = *(const f32x4*)(parts + (size_t)(row0 + ai * 128 + m * 16) * 16 + 4 * fq);
            s[ai][m] = (a[0] + a[1]) + (a[2] + a[3]); }
#pragma unroll
    for (int ai = 0; ai < 2; ++ai)
#pragma unroll
        for (int m = 0; m < 4; ++m) { float t = sum_xor32(sum_xor16(s[ai][m])); rs[ai][m] = __builtin_amdgcn_rsqf(t * (1.0f / D) + EPS); }
}
struct EpiGU {
    using acc_t = f32x4; static constexpr bool I8 = false;
    bf16_t* act; const float* rowss;
    __device__ __forceinline__ void operator()(const f32x4 (&acc)[2][2][4][2], const Unit& u, int wr, int wc, int fr, int fq) const {
        const int row0 = u.pm * 256 + wr * 64 + fr, col0 = u.pn * 128 + wc * 32 + fq * 8;
        float rs[2][4]; load_rstd(rowss, row0, fq, rs);
#pragma unroll
        for (int ai = 0; ai < 2; ++ai)
#pragma unroll
            for (int m = 0; m < 4; ++m) {
                const float r = rs[ai][m]; float o[8];
#pragma unroll
                for (int bj = 0; bj < 2; ++bj)
#pragma unroll
                    for (int j = 0; j < 4; ++j) { const float gt = acc[ai][bj][m][0][j] * r, up = acc[ai][bj][m][1][j] * r;
                        o[bj * 4 + j] = gt * up * __builtin_amdgcn_rcpf(1.0f + __builtin_amdgcn_exp2f(-gt * LOG2E)); }
                u32x4 w; w.x = cvt_pk_bf16(o[0], o[1]); w.y = cvt_pk_bf16(o[2], o[3]); w.z = cvt_pk_bf16(o[4], o[5]); w.w = cvt_pk_bf16(o[6], o[7]);
                *(u32x4*)(act + (size_t)(row0 + ai * 128 + m * 16) * FF + col0) = w;
            }
    }
};
struct EpiGUq {
    using acc_t = i32x4; static constexpr bool I8 = true;
    bf16_t* act; const LAS float* tab;
    __device__ __forceinline__ void operator()(const i32x4 (&acc)[2][2][4][2], const Unit& u, int wr, int wc, int fr, int fq) const {
        const int row0 = u.pm * 256 + wr * 64 + fr, col0 = u.pn * 128 + wc * 32 + fq * 8;
        const LAS float* R = tab + u.ui * 512;
        f32x2 c1[2][2], c2[2][2];
#pragma unroll
        for (int bj = 0; bj < 2; ++bj) {
            const f32x4 x1 = *(const LAS f32x4*)(R + 256 + bj * 128 + wc * 32 + 4 * fq), x2 = *(const LAS f32x4*)(R + 256 + bj * 128 + wc * 32 + 16 + 4 * fq);
#pragma unroll
            for (int jp = 0; jp < 2; ++jp) { c1[bj][jp] = f32x2{x1[2 * jp], x1[2 * jp + 1]}; c2[bj][jp] = f32x2{x2[2 * jp], x2[2 * jp + 1]}; }
        }
#pragma unroll
        for (int ai = 0; ai < 2; ++ai)
#pragma unroll
            for (int m = 0; m < 4; ++m) {
                const int row = row0 + ai * 128 + m * 16; const float r = R[wr * 64 + fr + ai * 128 + m * 16]; const f32x2 r1{r, r}, r2{r * r, r * r}; u32x4 w;
#pragma unroll
                for (int bj = 0; bj < 2; ++bj)
#pragma unroll
                    for (int jp = 0; jp < 2; ++jp) {
                        const f32x2 ag{(float)acc[ai][bj][m][0][2 * jp], (float)acc[ai][bj][m][0][2 * jp + 1]}, au{(float)acc[ai][bj][m][1][2 * jp], (float)acc[ai][bj][m][1][2 * jp + 1]};
                        const f32x2 x = (ag * c1[bj][jp]) * r1, p = (ag * au) * c2[bj][jp];
                        f32x2 d{__builtin_amdgcn_exp2f(x[0]), __builtin_amdgcn_exp2f(x[1])}; d = d + f32x2{1.0f, 1.0f};
                        const f32x2 o = p * (f32x2{__builtin_amdgcn_rcpf(d[0]), __builtin_amdgcn_rcpf(d[1])} * r2);
                        w[bj * 2 + jp] = cvt_pk_bf16(o[0], o[1]);
                    }
                *(u32x4*)(act + (size_t)row * FF + col0) = w;
            }
    }
};
template <bool GU, class SO>
__device__ __forceinline__ void guq_prep(LAS float* tab, const SO& so, const float* rowss, const float* qs, const float* sb) {
    int tid = threadIdx.x; asm volatile("" : "+v"(tid));
    pg8::Unit u;
    for (int i = 0; so.next(i, u); ++i) {
        LAS float* R = tab + i * 512;
        if (tid < 256) {
            const int row = u.pm * 256 + tid; const f32x4* p = (const f32x4*)(rowss + (size_t)row * 16);
            const f32x4 s = (p[0] + p[1]) + (p[2] + p[3]);
            R[tid] = __builtin_amdgcn_rsqf(((s[0] + s[1]) + (s[2] + s[3])) * (1.0f / D) + EPS) * qs[row];
        } else {
            const int c = tid - 256;
            if constexpr (GU) { if (!(c & 16)) { const float sg = sb[u.pn * 256 + c], su = sb[u.pn * 256 + c + 16]; R[256 + c] = sg * -LOG2E; R[256 + c + 16] = sg * su; } }
            else R[256 + c] = sb[u.pn * 256 + c];
        }
    }
    __syncthreads();
}
constexpr float QRANGE = 4.5f;
__device__ __forceinline__ unsigned q8_pack4(f32x4 v, float q) {
    int a0 = (int)__builtin_rintf(v[0] * q), a1 = (int)__builtin_rintf(v[1] * q), a2 = (int)__builtin_rintf(v[2] * q), a3 = (int)__builtin_rintf(v[3] * q);
    a0 = min(max(a0, -127), 127); a1 = min(max(a1, -127), 127); a2 = min(max(a2, -127), 127); a3 = min(max(a3, -127), 127);
    return (unsigned)(a0 & 0xff) | ((unsigned)(a1 & 0xff) << 8) | ((unsigned)(a2 & 0xff) << 16) | ((unsigned)a3 << 24);
}
__device__ __forceinline__ f32x4 bf2_lo4(unsigned a, unsigned b) { return f32x4{__uint_as_float(a << 16), __uint_as_float(a & 0xffff0000u), __uint_as_float(b << 16), __uint_as_float(b & 0xffff0000u)}; }
template <bool HALF, bool BF, bool OF, bool Q> struct EpiRes {
    using acc_t = f32x4; static constexpr bool I8 = false;
    static constexpr float scale = HALF ? 0.5f : 1.0f;
    const void* base; void* out; signed char* hq; float* rowss_out; float* qs; const float* prev_parts;
    __device__ __forceinline__ void operator()(const f32x4 (&acc)[2][2][4][2], const Unit& u, int wr, int wc, int fr, int fq) const {
        const int row0 = u.pm * 256 + wr * 64 + fr, col0 = u.pn * 256 + wc * 32 + fq * 8;
        float rp[2][4];
#pragma unroll
        for (int ai = 0; ai < 2; ++ai) {
            u32x4 bw[2][4][2];
            if constexpr (!BF) {
#pragma unroll
                for (int m = 0; m < 4; ++m)
#pragma unroll
                    for (int bj = 0; bj < 2; ++bj) bw[ai][m][bj] = *(const u32x4*)((const bf16_t*)base + (size_t)(row0 + ai * 128 + m * 16) * D + col0 + bj * 128);
            }
            if constexpr (Q) { if (ai == 0) load_rstd(prev_parts, row0, fq, rp); }
#pragma unroll
            for (int m = 0; m < 4; ++m) {
                const int row = row0 + ai * 128 + m * 16; float ss = 0.f;
                float q = 0.f; if constexpr (Q) q = (127.0f / QRANGE) * rp[ai][m];
#pragma unroll
                for (int bj = 0; bj < 2; ++bj) {
                    const size_t off = (size_t)row * D + col0 + bj * 128;
                    f32x4 b0, b1;
                    if constexpr (BF) { b0 = *(const f32x4*)((const float*)base + off); b1 = *(const f32x4*)((const float*)base + off + 4); }
                    else { b0 = bf2_lo4(bw[ai][m][bj].x, bw[ai][m][bj].y); b1 = bf2_lo4(bw[ai][m][bj].z, bw[ai][m][bj].w); }
                    const f32x4 h0 = b0 + acc[ai][bj][m][0] * scale, h1 = b1 + acc[ai][bj][m][1] * scale;
                    if constexpr (OF) { *(f32x4*)((float*)out + off) = h0; *(f32x4*)((float*)out + off + 4) = h1; }
                    else { u32x4 w; w.x = cvt_pk_bf16(h0[0], h0[1]); w.y = cvt_pk_bf16(h0[2], h0[3]); w.z = cvt_pk_bf16(h1[0], h1[1]); w.w = cvt_pk_bf16(h1[2], h1[3]); *(u32x4*)((bf16_t*)out + off) = w; }
                    if constexpr (Q) { u32x2 w; w.x = q8_pack4(h0, q); w.y = q8_pack4(h1, q); *(u32x2*)(hq + off) = w; }
                    ss += (h0[0] * h0[0] + h0[1] * h0[1]) + (h0[2] * h0[2] + h0[3] * h0[3]) + (h1[0] * h1[0] + h1[1] * h1[1]) + (h1[2] * h1[2] + h1[3] * h1[3]);
                }
                if constexpr (Q) { if (u.pn == 0 && wc == 0 && fq == 0) qs[row] = 1.0f / q; }
                if (rowss_out) { ss = sum_xor32(sum_xor16(ss)); if (fq == 0) rowss_out[(size_t)row * 16 + u.pn * 4 + wc] = ss; }
            }
        }
    }
};

struct EpiBf16 {
    using acc_t = f32x4; static constexpr bool I8 = false;
    bf16_t* out; int ldc; const float* rowss;
    __device__ __forceinline__ void operator()(const f32x4 (&acc)[2][2][4][2], const Unit& u, int wr, int wc, int fr, int fq) const {
        const int row0 = u.pm * 256 + wr * 64 + fr, col0 = u.pn * 256 + wc * 32 + fq * 8;
        float rs[2][4]; load_rstd(rowss, row0, fq, rs);
#pragma unroll
        for (int ai = 0; ai < 2; ++ai)
#pragma unroll
            for (int m = 0; m < 4; ++m)
#pragma unroll
                for (int bj = 0; bj < 2; ++bj) { const f32x4 v0 = acc[ai][bj][m][0] * rs[ai][m], v1 = acc[ai][bj][m][1] * rs[ai][m];
                    u32x4 w; w.x = cvt_pk_bf16(v0[0], v0[1]); w.y = cvt_pk_bf16(v0[2], v0[3]); w.z = cvt_pk_bf16(v1[0], v1[1]); w.w = cvt_pk_bf16(v1[2], v1[3]);
                    *(u32x4*)(out + (size_t)(row0 + ai * 128 + m * 16) * ldc + col0 + bj * 128) = w; }
    }
};
struct EpiF32 {
    using acc_t = f32x4; static constexpr bool I8 = false;
    float* out; int ldc; const float* rowss;
    __device__ __forceinline__ void operator()(const f32x4 (&acc)[2][2][4][2], const Unit& u, int wr, int wc, int fr, int fq) const {
        const int row0 = u.pm * 256 + wr * 64 + fr, col0 = u.pn * 256 + wc * 32 + fq * 8;
        float rs[2][4]; load_rstd(rowss, row0, fq, rs);
#pragma unroll
        for (int ai = 0; ai < 2; ++ai)
#pragma unroll
            for (int m = 0; m < 4; ++m)
#pragma unroll
                for (int bj = 0; bj < 2; ++bj) { float* p = out + (size_t)(row0 + ai * 128 + m * 16) * ldc + col0 + bj * 128;
                    *(f32x4*)p = acc[ai][bj][m][0] * rs[ai][m]; *(f32x4*)(p + 4) = acc[ai][bj][m][1] * rs[ai][m]; }
    }
};
constexpr float C2 = 0.125f * LOG2E;
template <bool Q> struct WinAcc { using t = f32x4; }; template <> struct WinAcc<true> { using t = i32x4; };
template <int V> struct EpiWin {
    static constexpr bool I8 = (V != 2); using acc_t = typename WinAcc<I8>::t;
    unsigned char* R; const float* rowss; const LAS float* tab; const float* g0; const float* g1; const float* g2; const float* g3;
    template <bool NORM>
    __device__ __forceinline__ void emit(const acc_t (&acc)[2][2][4][2], int row0, int fq, const float (&rs)[2][4], const f32x4 (&cs)[2][2], bf16_t* out, int pitch, const float* gain, float post) const {
        f32x4 gv[2][2];
#pragma unroll
        for (int bj = 0; bj < 2; ++bj)
#pragma unroll
            for (int n = 0; n < 2; ++n) gv[bj][n] = NORM ? *(const f32x4*)(gain + 32 * bj + 8 * fq + 4 * n) * post : (f32x4){1.f, 1.f, 1.f, 1.f};
#pragma unroll
        for (int ai = 0; ai < 2; ++ai)
#pragma unroll
            for (int m = 0; m < 4; ++m) {
                f32x4 v[2][2]; float ss = 0.f;
#pragma unroll
                for (int bj = 0; bj < 2; ++bj)
#pragma unroll
                    for (int n = 0; n < 2; ++n) {
                        if constexpr (I8) v[bj][n] = __builtin_convertvector(acc[ai][bj][m][n], f32x4) * (cs[bj][n] * rs[ai][m]); else v[bj][n] = acc[ai][bj][m][n] * rs[ai][m];
                        const f32x4 t = v[bj][n]; ss += (t[0] * t[0] + t[1] * t[1]) + (t[2] * t[2] + t[3] * t[3]); }
                float inv = 1.f;
                if (NORM) { ss = sum_xor32(sum_xor16(ss)); inv = __builtin_amdgcn_rsqf(ss * (1.0f / 64.0f) + EPS); }
#pragma unroll
                for (int bj = 0; bj < 2; ++bj) { const f32x4 a = v[bj][0] * gv[bj][0] * inv, b = v[bj][1] * gv[bj][1] * inv;
                    u32x4 w; w.x = cvt_pk_bf16(a[0], a[1]); w.y = cvt_pk_bf16(a[2], a[3]); w.z = cvt_pk_bf16(b[0], b[1]); w.w = cvt_pk_bf16(b[2], b[3]);
                    *(u32x4*)(out + (size_t)(row0 + ai * 128 + m * 16) * pitch + 32 * bj + 8 * fq) = w; }
            }
    }
    __device__ __forceinline__ void operator()(const acc_t (&acc)[2][2][4][2], const Unit& u, int wr, int wc, int fr, int fq) const {
        const int row0 = u.pm * 256 + wr * 64 + fr; const int g = 4 * u.pn + wc;
        float rs[2][4]; f32x4 cs[2][2];
        if constexpr (I8) {
            const LAS float* T = tab + u.ui * 512;
#pragma unroll
            for (int ai = 0; ai < 2; ++ai)
#pragma unroll
                for (int m = 0; m < 4; ++m) rs[ai][m] = T[wr * 64 + fr + ai * 128 + m * 16];
#pragma unroll
            for (int bj = 0; bj < 2; ++bj)
#pragma unroll
                for (int n = 0; n < 2; ++n) cs[bj][n] = *(const LAS f32x4*)(T + 256 + bj * 128 + wc * 32 + n * 16 + 4 * fq);
        } else {
            load_rstd(rowss, row0, fq, rs);
#pragma unroll
            for (int bj = 0; bj < 2; ++bj)
#pragma unroll
                for (int n = 0; n < 2; ++n) cs[bj][n] = (f32x4){1.f, 1.f, 1.f, 1.f};
        }
        if constexpr (V == 1) {
            if (g < 16) emit<true>(acc, row0, fq, rs, cs, (bf16_t*)(R + R_CQ) + 64 * g, 1024, g0, C2);
            else if (g < 32) emit<true>(acc, row0, fq, rs, cs, (bf16_t*)(R + R_CK) + 64 * (g - 16), 1024, g1, 1.0f);
            else emit<false>(acc, row0, fq, rs, cs, (bf16_t*)(R + R_CV) + 64 * (g - 32), 1024, nullptr, 1.0f);
        } else if constexpr (V == 0) {
            if (g < 8) emit<true>(acc, row0, fq, rs, cs, (bf16_t*)(R + R_AQ) + 64 * g, 512, g0, C2);
            else if (g < 16) emit<true>(acc, row0, fq, rs, cs, (bf16_t*)(R + R_AK) + 64 * (g - 8), 512, g1, 1.0f);
            else if (g < 24) emit<false>(acc, row0, fq, rs, cs, (bf16_t*)(R + R_AV) + 64 * (g - 16), 512, nullptr, 1.0f);
            else if (g < 32) emit<true>(acc, row0, fq, rs, cs, (bf16_t*)(R + R_BQ) + 64 * (g - 24), 512, g2, C2);
            else if (g < 40) emit<true>(acc, row0, fq, rs, cs, (bf16_t*)(R + R_BK) + 64 * (g - 32), 512, g3, 1.0f);
            else emit<false>(acc, row0, fq, rs, cs, (bf16_t*)(R + R_BV) + 64 * (g - 40), 512, nullptr, 1.0f);
        } else {
            if (g < 8) emit<false>(acc, row0, fq, rs, cs, (bf16_t*)(R + R_IQ) + 64 * g, 512, nullptr, 1.0f);
            else if (g == 8) emit<true>(acc, row0, fq, rs, cs, (bf16_t*)(R + R_IK), 64, g0, 1.0f);
            else if (g == 9) {
                if (fq == 0) {
                    float* iw = (float*)(R + R_IW);
#pragma unroll
                    for (int ai = 0; ai < 2; ++ai)
#pragma unroll
                        for (int m = 0; m < 4; ++m) { float* p = iw + (size_t)(row0 + ai * 128 + m * 16) * 8;
                            *(f32x4*)p = acc[ai][0][m][0] * rs[ai][m]; *(f32x4*)(p + 4) = acc[ai][0][m][1] * rs[ai][m]; }
                }
            }
        }
    }
};

enum { MAP_P8 = 0, MAP_GU = 1, MAP_H64_L0 = 2, MAP_H64_L1 = 3, MAP_H64Q_L0 = 4, MAP_H64I_L0 = 5 };
__device__ __forceinline__ int conv_src(int mode, int Tg, int& which) {
    const int pn = Tg >> 8, T = Tg & 255, bj = T >> 7, wc = (T >> 5) & 3, n = (T >> 4) & 1, fq = (T >> 2) & 3, j = T & 3;
    which = 0;
    if (mode == MAP_P8) return 256 * pn + 128 * bj + 32 * wc + 8 * fq + 4 * n + j;
    if (mode == MAP_GU) { which = n; return 128 * pn + 32 * wc + 8 * fq + 4 * bj + j; }
    const int Lu = 64 * wc + 32 * bj + 8 * fq + 4 * n + j;
    if (mode == MAP_H64_L1) return 256 * pn + Lu;
    const int g = 4 * pn + (Lu >> 6), d = Lu & 63;
    if (mode == MAP_H64Q_L0) return g < 24 ? g * 64 + d : 2120 + (g - 24) * 64 + d;
    if (mode == MAP_H64I_L0) { if (g < 8) return 1536 + g * 64 + d; if (g == 8) return 2048 + d; if (g == 9) return d < 8 ? 2112 + d : -1; return -1; }
    if (g < 32) return g * 64 + d;
    if (g == 32) return 2048 + d;
    if (g == 33) return d < 8 ? 2112 + d : -1;
    if (g < 58) return 2120 + (g - 34) * 64 + d;
    return -1;
}
__device__ __forceinline__ void conv_load(const float* src0, const float* src1, const float* gain, int Nsrc, int Nrows, int mode, int item, int lane, f32x4 (&v)[8]) {
    const int nT = Nrows / 32, kb = item / nT, tb = item % nT, k0 = 64 * kb, T0 = 32 * tb;
    int which; const int col = conv_src(mode, T0 + 4 * (lane & 7), which);
    const size_t sel = which ? (size_t)(src1 - src0) : (size_t)0;
    const float* src = src0 + sel; const int kr = lane >> 3;
#pragma unroll
    for (int i = 0; i < 8; ++i) { const int kk = 8 * i + kr;
        f32x4 t = (f32x4){0.f, 0.f, 0.f, 0.f}; if (col >= 0) { t = *(const f32x4*)(src + (size_t)(k0 + kk) * Nsrc + col); if (gain) t = t * gain[k0 + kk]; }
        v[i] = t; }
}
__device__ __forceinline__ void conv_store(bf16_t* dst, int K, int Nrows, int item, LAS float* scr, int lane, const f32x4 (&v)[8]) {
    const int nT = Nrows / 32, kb = item / nT, tb = item % nT, k0 = 64 * kb, T0 = 32 * tb;
    const int tq = lane & 7, kr = lane >> 3;
#pragma unroll
    for (int i = 0; i < 8; ++i) { LAS float* p = scr + (8 * i + kr) * 33 + 4 * tq; p[0] = v[i][0]; p[1] = v[i][1]; p[2] = v[i][2]; p[3] = v[i][3]; }
    asm volatile("s_waitcnt lgkmcnt(0)" ::: "memory");
    const int c = lane & 7;
#pragma unroll
    for (int j = 0; j < 4; ++j) { const int n = (lane >> 3) + 8 * j; const LAS float* s = scr + (8 * c) * 33 + n;
        u32x4 o; o.x = cvt_pk_bf16(s[0 * 33], s[1 * 33]); o.y = cvt_pk_bf16(s[2 * 33], s[3 * 33]); o.z = cvt_pk_bf16(s[4 * 33], s[5 * 33]); o.w = cvt_pk_bf16(s[6 * 33], s[7 * 33]);
        *(u32x4*)(dst + (size_t)(T0 + n) * K + k0 + 8 * c) = o; }
    asm volatile("s_waitcnt lgkmcnt(0)" ::: "memory");
}
template <int MODE>
__device__ __forceinline__ void convq_item(const float* wg, const float* wu, int Nsrc, const float* gain, signed char* dst, float* sb, int item, LAS float* scr, LAS float* xch, int wave, int lane) {
    const int T0 = 32 * item, tq = lane & 7, kr = lane >> 3;
    int which; const int col = conv_src(MODE, T0 + 4 * tq, which);
    const size_t sel = which ? (size_t)(wu - wg) : (size_t)0; const float* src = wg + sel;
    f32x4 v[2][8]; f32x4 mx = (f32x4){0.f, 0.f, 0.f, 0.f};
#pragma unroll
    for (int kbi = 0; kbi < 2; ++kbi)
#pragma unroll
        for (int i = 0; i < 8; ++i) { const int k = 64 * (2 * wave + kbi) + 8 * i + kr; const f32x4 t = *(const f32x4*)(src + (size_t)k * Nsrc + col) * gain[k]; v[kbi][i] = t;
            mx[0] = fmaxf(mx[0], fabsf(t[0])); mx[1] = fmaxf(mx[1], fabsf(t[1])); mx[2] = fmaxf(mx[2], fabsf(t[2])); mx[3] = fmaxf(mx[3], fabsf(t[3])); }
#pragma unroll
    for (int j = 0; j < 4; ++j) { float m_ = mx[j]; m_ = fmaxf(m_, __shfl_xor(m_, 8)); m_ = fmaxf(m_, __shfl_xor(m_, 16)); m_ = fmaxf(m_, __shfl_xor(m_, 32)); mx[j] = m_; }
    if (kr == 0) { LAS float* p = xch + wave * 32 + 4 * tq; p[0] = mx[0]; p[1] = mx[1]; p[2] = mx[2]; p[3] = mx[3]; }
    asm volatile("s_waitcnt lgkmcnt(0)" ::: "memory"); __syncthreads();
    f32x4 inv;
#pragma unroll
    for (int j = 0; j < 4; ++j) { float c = 0.f;
#pragma unroll
        for (int w = 0; w < 8; ++w) c = fmaxf(c, xch[w * 32 + 4 * tq + j]);
        inv[j] = c > 0.f ? 127.0f / c : 0.f; if (wave == 0 && kr == 0) sb[T0 + 4 * tq + j] = c > 0.f ? c * (1.0f / 127.0f) : 1.0f; }
    const int c8 = lane & 7;
#pragma unroll
    for (int kbi = 0; kbi < 2; ++kbi) {
#pragma unroll
        for (int i = 0; i < 8; ++i) { LAS float* p = scr + (8 * i + kr) * 33 + 4 * tq; const f32x4 t = v[kbi][i] * inv; p[0] = __builtin_rintf(t[0]); p[1] = __builtin_rintf(t[1]); p[2] = __builtin_rintf(t[2]); p[3] = __builtin_rintf(t[3]); }
        asm volatile("s_waitcnt lgkmcnt(0)" ::: "memory");
#pragma unroll
        for (int jj = 0; jj < 4; ++jj) { const int n = (lane >> 3) + 8 * jj; const LAS float* s = scr + (8 * c8) * 33 + n;
            const unsigned lo = (unsigned)((int)s[0 * 33] & 0xff) | ((unsigned)((int)s[1 * 33] & 0xff) << 8) | ((unsigned)((int)s[2 * 33] & 0xff) << 16) | ((unsigned)(int)s[3 * 33] << 24);
            const unsigned hi = (unsigned)((int)s[4 * 33] & 0xff) | ((unsigned)((int)s[5 * 33] & 0xff) << 8) | ((unsigned)((int)s[6 * 33] & 0xff) << 16) | ((unsigned)(int)s[7 * 33] << 24);
            *(u32x2*)(dst + (size_t)(T0 + n) * D + 64 * (2 * wave + kbi) + 8 * c8) = (u32x2){lo, hi}; }
        asm volatile("s_waitcnt lgkmcnt(0)" ::: "memory");
    }
    __syncthreads();
}
__device__ __forceinline__ void row_load(const float* xrow, int lane, f32x4 (&v)[4]) {
    const f32x4* xr = (const f32x4*)xrow + lane;
#pragma unroll
    for (int j = 0; j < 4; ++j) v[j] = xr[64 * j];
}
__device__ __forceinline__ void row_to_q8(const f32x4 (&v)[4], signed char* qrow, float* dq, float* ssp, int lane) {
    float s = 0.f;
#pragma unroll
    for (int j = 0; j < 4; ++j) s += (v[j].x * v[j].x + v[j].y * v[j].y) + (v[j].z * v[j].z + v[j].w * v[j].w);
    s = wave_sum(s);
    const float q = (127.0f / QRANGE) * __builtin_amdgcn_rsqf(s * (1.0f / D) + EPS);
    unsigned* o4 = (unsigned*)qrow + lane;
#pragma unroll
    for (int j = 0; j < 4; ++j) o4[64 * j] = q8_pack4(v[j], q);
    if (lane < 16) ssp[lane] = lane == 0 ? s : 0.f;
    if (lane == 0) *dq = 1.0f / q;
}
__device__ __forceinline__ void row_to_bf16(const float* xrow, bf16_t* orow, float* ssp, int lane) {
    const f32x4* xr = (const f32x4*)xrow + lane; f32x4 v[4]; float s = 0.f;
#pragma unroll
    for (int j = 0; j < 4; ++j) { v[j] = xr[64 * j]; s += (v[j].x * v[j].x + v[j].y * v[j].y) + (v[j].z * v[j].z + v[j].w * v[j].w); }
    s = wave_sum(s);
    u32x2* o8 = (u32x2*)orow + lane;
#pragma unroll
    for (int j = 0; j < 4; ++j) { u32x2 w; w.x = cvt_pk_bf16(v[j].x, v[j].y); w.y = cvt_pk_bf16(v[j].z, v[j].w); o8[64 * j] = w; }
    if (lane < 16) ssp[lane] = lane == 0 ? s : 0.f;
}

__device__ __forceinline__ void glds16(const void* gsrc, unsigned lds_dst) { unsigned keep;
    asm volatile("s_mov_b32 %0, m0\n\ts_mov_b32 m0, %2\n\ts_nop 0\n\tglobal_load_lds_dwordx4 %1, off\n\ts_mov_b32 m0, %0" : "=&s"(keep) : "v"(gsrc), "s"(lds_dst) : "memory"); }
#define WAITV_BAR(N) do { asm volatile("s_waitcnt vmcnt(" #N ") lgkmcnt(0)" ::: "memory"); __builtin_amdgcn_s_barrier(); asm volatile("" ::: "memory"); } while (0)
#define DMA_SYNC() do { asm volatile("s_waitcnt vmcnt(0) lgkmcnt(0)" ::: "memory"); __syncthreads(); } while (0)
__device__ __forceinline__ int crow(int r, int hi) { return (r & 3) + 8 * (r >> 2) + 4 * hi; }
enum { AM_T5 = 0, AM_T5_BITMAP = 1, AM_BAND = 2, AM_MEM = 3 };
constexpr int ATT_NS = 4;
constexpr int ATT_LUT_OFF = 135168, ATT_WSF_OFF = ATT_LUT_OFF + 2560;
typedef short v4i16_t __attribute__((ext_vector_type(4)));
__device__ __forceinline__ s16x4 vtr(const LAS unsigned char* p) { return __builtin_bit_cast(s16x4, __builtin_amdgcn_ds_read_tr16_b64_v4i16((LAS v4i16_t*)p)); }
__device__ __forceinline__ void glds16x2(const void* g0, unsigned d0, const void* g1, unsigned d1) { unsigned keep;
    asm volatile("s_mov_b32 %0, m0\n\ts_mov_b32 m0, %3\n\ts_nop 0\n\tglobal_load_lds_dwordx4 %1, off\n\ts_mov_b32 m0, %4\n\ts_nop 0\n\tglobal_load_lds_dwordx4 %2, off\n\ts_mov_b32 m0, %0"
                 : "=&s"(keep) : "v"(g0), "v"(g1), "s"(d0), "s"(d1) : "memory"); }
__device__ __forceinline__ void glds16x3(const void* g0, unsigned d0, const void* g1, unsigned d1, const void* g2, unsigned d2) { unsigned keep;
    asm volatile("s_mov_b32 %0, m0\n\ts_mov_b32 m0, %4\n\ts_nop 0\n\tglobal_load_lds_dwordx4 %1, off\n\ts_mov_b32 m0, %5\n\ts_nop 0\n\tglobal_load_lds_dwordx4 %2, off\n\t"
                 "s_mov_b32 m0, %6\n\ts_nop 0\n\tglobal_load_lds_dwordx4 %3, off\n\ts_mov_b32 m0, %0"
                 : "=&s"(keep) : "v"(g0), "v"(g1), "v"(g2), "s"(d0), "s"(d1), "s"(d2) : "memory"); }
__device__ __forceinline__ void glds16x2_4(const void* g0, unsigned d0, const void* g1, unsigned d1, const void* g2, unsigned d2) { unsigned keep;
    asm volatile("s_mov_b32 %0, m0\n\ts_mov_b32 m0, %4\n\ts_nop 0\n\tglobal_load_lds_dwordx4 %1, off\n\ts_mov_b32 m0, %5\n\ts_nop 0\n\tglobal_load_lds_dwordx4 %2, off\n\t"
                 "s_mov_b32 m0, %6\n\ts_nop 0\n\tglobal_load_lds_dword %3, off\n\ts_mov_b32 m0, %0"
                 : "=&s"(keep) : "v"(g0), "v"(g1), "v"(g2), "s"(d0), "s"(d1), "s"(d2) : "memory"); }
__device__ __forceinline__ void glds4(const void* gsrc, unsigned lds_dst) { unsigned keep;
    asm volatile("s_mov_b32 %0, m0\n\ts_mov_b32 m0, %2\n\ts_nop 0\n\tglobal_load_lds_dword %1, off\n\ts_mov_b32 m0, %0" : "=&s"(keep) : "v"(gsrc), "s"(lds_dst) : "memory"); }
template <int N> __device__ __forceinline__ void waitv_bar() { asm volatile("s_waitcnt vmcnt(%0) lgkmcnt(0)" :: "n"(N) : "memory"); __builtin_amdgcn_s_barrier(); asm volatile("" ::: "memory"); }

template <int DQK, int DV, int MODE>
__device__ __forceinline__ void attn_unit(LAS unsigned char* lds, const bf16_t* __restrict__ Q, int qpitch, const bf16_t* __restrict__ K, int kpitch, const bf16_t* __restrict__ V, int vpitch,
                                          bf16_t* O, int opitch, int q0, const float* lut, const unsigned* bitmapT, const float* qgain) {
    constexpr int KB = 64 * DQK * 2, VB = 64 * DV * 2, NKP = DQK / 64, NVP = DV / 64;
    constexpr int BMB = (MODE == AM_T5_BITMAP) ? 2048 : 0, SLOT = KB + VB + BMB;
    constexpr int ND = (NKP + NVP) + (MODE == AM_T5_BITMAP ? 1 : 0);
    constexpr int NKS = DQK / 16, NDB = DV / 32;
    constexpr int EOFF = (MODE == AM_BAND) ? 575 : 191, LUTN = (MODE == AM_BAND) ? 640 : 256;
    static_assert(ATT_NS * SLOT <= ATT_LUT_OFF && 8 * 32 * DV * 2 <= ATT_LUT_OFF, "attention LDS map");
    int tid = threadIdx.x; asm volatile("" : "+v"(tid));
    const int lane = tid & 63, r32 = lane & 31, hi = lane >> 5; const int wid = __builtin_amdgcn_readfirstlane(tid >> 6);
    const int qrow = q0 + 32 * wid + r32;
    const int cqw = (q0 + 32 * wid) >> 6;
    int tlo, thi, wlo, whi;
    if (MODE == AM_MEM) { tlo = 0; thi = 3; wlo = 0; whi = 3; }
    else if (MODE == AM_BAND) { tlo = (q0 >> 6) - 8; if (tlo < 0) tlo = 0; thi = (q0 + 255) >> 6; wlo = cqw - 8; if (wlo < 0) wlo = 0; whi = cqw; }
    else { tlo = 0; thi = (q0 + 255) >> 6; wlo = 0; whi = cqw; }
    LAS float* lutl = (LAS float*)(lds + ATT_LUT_OFF);
    LAS float* wsf = (LAS float*)(lds + ATT_WSF_OFF) + wid * 64;
    const unsigned ldsb = (unsigned)(uintptr_t)lds;
#define ATT_KSRC(t, p_) (K + (size_t)((t) * 64 + lane) * kpitch + (wid + 8 * (p_)) * 8)
#define ATT_KDST(p_) ((unsigned)__builtin_amdgcn_readfirstlane((int)(sb_ + (wid + 8 * (p_)) * 1024)))
#define ATT_VSRC(t, p_) (V + (size_t)((t) * 64 + 16 * ((wid + 8 * (p_)) & 3) + (lane >> 2)) * vpitch + 32 * ((wid + 8 * (p_)) >> 2) + (lane & 3) * 8)
#define ATT_VDST(p_) ((unsigned)__builtin_amdgcn_readfirstlane((int)(sb_ + KB + (wid + 8 * (p_)) * 1024)))
#define ATT_DMA(t) do { const unsigned sb_ = (unsigned)__builtin_amdgcn_readfirstlane((int)(ldsb + (((t) - tlo) & 3) * SLOT)); \
        if (MODE == AM_T5_BITMAP && NKP == 1 && NVP == 1) glds16x2_4(ATT_KSRC(t, 0), ATT_KDST(0), ATT_VSRC(t, 0), ATT_VDST(0), bitmapT + (size_t)(2 * (t) + hi) * S + qrow, (unsigned)__builtin_amdgcn_readfirstlane((int)(sb_ + KB + VB + wid * 256))); \
        else if (MODE != AM_T5_BITMAP && NKP == 1 && NVP == 1) glds16x2(ATT_KSRC(t, 0), ATT_KDST(0), ATT_VSRC(t, 0), ATT_VDST(0)); \
        else if (MODE != AM_T5_BITMAP && NKP == 1 && NVP == 2) glds16x3(ATT_KSRC(t, 0), ATT_KDST(0), ATT_VSRC(t, 0), ATT_VDST(0), ATT_VSRC(t, 1), ATT_VDST(1)); \
        else { \
        _Pragma("unroll") for (int p_ = 0; p_ < NKP; ++p_) glds16(ATT_KSRC(t, p_), ATT_KDST(p_)); \
        _Pragma("unroll") for (int p_ = 0; p_ < NVP; ++p_) glds16(ATT_VSRC(t, p_), ATT_VDST(p_)); \
        if (MODE == AM_T5_BITMAP) glds4(bitmapT + (size_t)(2 * (t) + hi) * S + qrow, (unsigned)__builtin_amdgcn_readfirstlane((int)(sb_ + KB + VB + wid * 256))); } \
    } while (0)
    ATT_DMA(tlo); if (tlo + 1 <= thi) ATT_DMA(tlo + 1); if (tlo + 2 <= thi) ATT_DMA(tlo + 2);
    bf16x8 qr[NKS];
    if (MODE == AM_MEM) {
        float qf[NKS][8]; float ss = 0.f;
#pragma unroll
        for (int d0 = 0; d0 < NKS; ++d0) { const bf16x8 t = *(const bf16x8*)(Q + (size_t)qrow * qpitch + d0 * 16 + hi * 8);
#pragma unroll
            for (int j = 0; j < 8; ++j) { qf[d0][j] = bf2f((unsigned short)t[j]); ss += qf[d0][j] * qf[d0][j]; } }
        ss += __shfl_xor(ss, 32);
        const float inv = (1.0f / sqrtf(ss * (1.0f / DQK) + EPS)) * (LOG2E / sqrtf((float)DQK));
#pragma unroll
        for (int d0 = 0; d0 < NKS; ++d0) { const f32x4 ga = *(const f32x4*)(qgain + d0 * 16 + hi * 8), gb = *(const f32x4*)(qgain + d0 * 16 + hi * 8 + 4);
            u32x4 w; w.x = cvt_pk_bf16(qf[d0][0] * inv * ga[0], qf[d0][1] * inv * ga[1]); w.y = cvt_pk_bf16(qf[d0][2] * inv * ga[2], qf[d0][3] * inv * ga[3]);
            w.z = cvt_pk_bf16(qf[d0][4] * inv * gb[0], qf[d0][5] * inv * gb[1]); w.w = cvt_pk_bf16(qf[d0][6] * inv * gb[2], qf[d0][7] * inv * gb[3]);
            qr[d0] = __builtin_bit_cast(bf16x8, w); }
    } else {
#pragma unroll
        for (int d0 = 0; d0 < NKS; ++d0) qr[d0] = *(const bf16x8*)(Q + (size_t)qrow * qpitch + d0 * 16 + hi * 8);
    }
    if (MODE != AM_MEM) { for (int i = tid; i < LUTN; i += NTHREADS) lutl[i] = lut[i]; }
#pragma unroll
    for (int d0 = 0; d0 < NKS; ++d0) asm volatile("" : "+v"(qr[d0]));
    asm volatile("s_waitcnt vmcnt(0)" ::: "memory");
    f32x16 o[NDB];
#pragma unroll
    for (int d = 0; d < NDB; ++d) o[d] = f32x16{};
    float l_reg = 0.f;
    const int qoff = (32 * wid + r32 + q0) & 63;
    const int vb0 = ((lane >> 4) & 1) * 32 + (lane & 3) * 8 + (4 * hi + ((lane & 15) >> 2)) * 64;
    constexpr int NQK = 2 * NKS, CH = 32 / NQK;
    constexpr bool PIPE = (MODE != AM_MEM);
    f32x16 c0 = f32x16{}, c1 = f32x16{};
#define ATT_KFRAG(kb_, i) (*(const LAS bf16x8*)((kb_) + (2 * ((i) >> 1) + hi) * 1024 + (32 * ((i) & 1) + r32) * 16))
#define ATT_QK1(kb_, i, n0, n1) do { if ((i) == 0) n0 = __builtin_amdgcn_mfma_f32_32x32x16_bf16(ATT_KFRAG(kb_, i), qr[0], f32x16{}, 0, 0, 0); \
                                     else if ((i) == 1) n1 = __builtin_amdgcn_mfma_f32_32x32x16_bf16(ATT_KFRAG(kb_, i), qr[0], f32x16{}, 0, 0, 0); \
                                     else if (((i) & 1) == 0) n0 = __builtin_amdgcn_mfma_f32_32x32x16_bf16(ATT_KFRAG(kb_, i), qr[(i) >> 1], n0, 0, 0, 0); \
                                     else n1 = __builtin_amdgcn_mfma_f32_32x32x16_bf16(ATT_KFRAG(kb_, i), qr[(i) >> 1], n1, 0, 0, 0); } while (0)
#define ATT_SMB4(cv, b, bwv, P) asm volatile( \
        "v_exp_f32 %0, %7\n\tv_exp_f32 %1, %8\n\tv_exp_f32 %2, %9\n\tv_exp_f32 %3, %10\n\t" \
        "v_bfe_i32 %5, %11, %12, 1\n\tv_bfe_i32 %6, %11, %13, 1\n\tv_and_b32 %0, %0, %5\n\tv_and_b32 %1, %1, %6\n\t" \
        "v_bfe_i32 %5, %11, %14, 1\n\tv_bfe_i32 %6, %11, %15, 1\n\tv_and_b32 %2, %2, %5\n\tv_and_b32 %3, %3, %6\n\t" \
        "v_add_f32 %4, %4, %0\n\tv_add_f32 %4, %4, %1\n\tv_add_f32 %4, %4, %2\n\tv_add_f32 %4, %4, %3" \
        : "=&v"(pe[P]), "=&v"(pe[(P) + 1]), "=&v"(pe[(P) + 2]), "=&v"(pe[(P) + 3]), "+v"(sacc), "=&v"(tm0_), "=&v"(tm1_) \
        : "v"(cv[b]), "v"(cv[(b) + 1]), "v"(cv[(b) + 2]), "v"(cv[(b) + 3]), "v"(bwv), "n"(2 * (b)), "n"(2 * (b) + 1), "n"(2 * (b) + 2), "n"(2 * (b) + 3))
#define ATT_SMX4(cv, b, P) asm volatile( \
        "v_exp_f32 %0, %5\n\tv_exp_f32 %1, %6\n\tv_exp_f32 %2, %7\n\tv_exp_f32 %3, %8\n\t" \
        "v_add_f32 %4, %4, %0\n\tv_add_f32 %4, %4, %1\n\tv_add_f32 %4, %4, %2\n\tv_add_f32 %4, %4, %3" \
        : "=&v"(pe[P]), "=&v"(pe[(P) + 1]), "=&v"(pe[(P) + 2]), "=&v"(pe[(P) + 3]), "+v"(sacc) \
        : "v"(cv[b]), "v"(cv[(b) + 1]), "v"(cv[(b) + 2]), "v"(cv[(b) + 3]))
#define ATT_SM1(i) do { if (MODE == AM_T5_BITMAP) { float tm0_, tm1_; if ((i) < 4) ATT_SMB4(c0, 4 * (i), bw0, 4 * (i)); else ATT_SMB4(c1, 4 * ((i) - 4), bw1, 16 + 4 * ((i) - 4)); } \
    else if (MODE != AM_MEM) { if ((i) < 4) ATT_SMX4(c0, 4 * (i), 4 * (i)); else ATT_SMX4(c1, 4 * ((i) - 4), 16 + 4 * ((i) - 4)); } else \
    _Pragma("unroll") for (int v_ = CH * (i); v_ < CH * (i) + CH; ++v_) { \
        if (v_ < 16) { float e_ = __builtin_amdgcn_exp2f(c0[v_]); if (MODE == AM_T5_BITMAP) e_ = __uint_as_float(__float_as_uint(e_) & (unsigned)__builtin_amdgcn_sbfe((int)bw0, (v_ & 3) + 8 * (v_ >> 2), 1)); asm volatile("" : "+v"(e_)); c0[v_] = e_; sacc += e_; } \
        else { const int u_ = v_ - 16; float e_ = __builtin_amdgcn_exp2f(c1[u_]); if (MODE == AM_T5_BITMAP) e_ = __uint_as_float(__float_as_uint(e_) & (unsigned)__builtin_amdgcn_sbfe((int)bw1, (u_ & 3) + 8 * (u_ >> 2), 1)); asm volatile("" : "+v"(e_)); c1[u_] = e_; sacc += e_; } } \
        asm volatile("" : "+v"(sacc)); } while (0)
    if (tlo + 2 <= thi) waitv_bar<2 * ND>(); else if (tlo + 1 <= thi) waitv_bar<ND>(); else waitv_bar<0>();
    if (PIPE) {   const LAS unsigned char* kb = lds;
#pragma unroll
        for (int i = 0; i < NQK; ++i) ATT_QK1(kb, i, c0, c1);
        asm volatile("s_nop 7\n\ts_nop 7\n\ts_nop 3" : "+v"(c0), "+v"(c1));
    }
    for (int t = tlo; t <= thi; ++t) {
        const bool has_next = PIPE && (t + 1 <= thi);
        const bool nxt_act = has_next && (t + 1 >= wlo) && (t + 1 <= whi);
        if (!PIPE) { if (t > tlo) { if (t + 2 <= thi) waitv_bar<2 * ND>(); else if (t + 1 <= thi) waitv_bar<ND>(); else waitv_bar<0>(); } }
        else if (has_next) { if (t + 2 <= thi) waitv_bar<ND>(); else waitv_bar<0>(); }
        if (!PIPE && t + 3 <= thi) ATT_DMA(t + 3);
        const LAS unsigned char* kcur = lds + ((t - tlo) & 3) * SLOT; const LAS unsigned char* vbuf = kcur + KB;
        const LAS unsigned char* knxt = lds + ((t + 1 - tlo) & 3) * SLOT;
        f32x16 n0, n1;
        if (!PIPE) {
#pragma unroll
            for (int i = 0; i < NQK; ++i) ATT_QK1(kcur, i, c0, c1);
        }
        const bool act = (t >= wlo && t <= whi);
        constexpr int NPV = NDB * 4;
        float pe[32]; s16x4 vlo[4], vhi[4];
#define ATT_VLD(j) do { vlo[(j) & 3] = vtr(vbuf + vb0 + ((j) >> 2) * 4096 + ((j) & 3) * 1024); vhi[(j) & 3] = vtr(vbuf + vb0 + ((j) >> 2) * 4096 + ((j) & 3) * 1024 + 512); } while (0)
        if (act) {
            unsigned bw0 = 0, bw1 = 0;
            if (MODE == AM_T5_BITMAP) { const LAS unsigned* bw = (const LAS unsigned*)(vbuf + VB + wid * 256); bw0 = bw[r32] >> (4 * hi); bw1 = bw[32 + r32] >> (4 * hi); }
            if (MODE != AM_MEM) {
                const int dt = cqw - t;
                if (dt <= (MODE == AM_BAND ? 4 : 2)) {
                    const LAS float* lp = lutl + (EOFF - 64 * dt - qoff + 4 * hi);
#pragma unroll
                    for (int r = 0; r < 16; ++r) { c0[r] += lp[(r & 3) + 8 * (r >> 2)]; c1[r] += lp[32 + (r & 3) + 8 * (r >> 2)]; }
                }
            }
            float sacc = 0.f;
            bf16x8 kf[4];
            if (nxt_act) {
#pragma unroll
                for (int i = 0; i < 4; ++i) kf[i] = ATT_KFRAG(knxt, i);
                __builtin_amdgcn_sched_barrier(0);
#pragma unroll
                for (int i = 0; i < NQK; ++i) {
                    ATT_SM1(i);
                    __builtin_amdgcn_sched_barrier(0);
                    if (i == 0) n0 = __builtin_amdgcn_mfma_f32_32x32x16_bf16(kf[0], qr[0], f32x16{}, 0, 0, 0);
                    else if (i == 1) n1 = __builtin_amdgcn_mfma_f32_32x32x16_bf16(kf[1], qr[0], f32x16{}, 0, 0, 0);
                    else if ((i & 1) == 0) n0 = __builtin_amdgcn_mfma_f32_32x32x16_bf16(kf[i & 3], qr[i >> 1], n0, 0, 0, 0);
                    else n1 = __builtin_amdgcn_mfma_f32_32x32x16_bf16(kf[i & 3], qr[i >> 1], n1, 0, 0, 0);
                    if (i + 4 < NQK) kf[i & 3] = ATT_KFRAG(knxt, i + 4);
                    else ATT_VLD(i + 4 - NQK);
                    __builtin_amdgcn_sched_barrier(0);
                }
            } else {
#pragma unroll
                for (int j = 0; j < 4; ++j) ATT_VLD(j);
#pragma unroll
                for (int i = 0; i < NQK; ++i) ATT_SM1(i);
            }
            l_reg += sacc;
        } else if (nxt_act) {
#pragma unroll
            for (int i = 0; i < NQK; ++i) ATT_QK1(knxt, i, n0, n1);
        }
        if (PIPE && t + 3 <= thi) ATT_DMA(t + 3);
        if (act) {
            bf16x8 pw[4];
#define ATT_P0(v) (MODE != AM_MEM ? pe[v] : c0[v])
#define ATT_P1(v) (MODE != AM_MEM ? pe[16 + (v)] : c1[v])
#define ATT_PACK(jj) do { u32x4 a_; if ((jj) < 2) { a_.x = cvt_pk_bf16(ATT_P0(8 * (jj) + 0), ATT_P0(8 * (jj) + 1)); a_.y = cvt_pk_bf16(ATT_P0(8 * (jj) + 2), ATT_P0(8 * (jj) + 3)); a_.z = cvt_pk_bf16(ATT_P0(8 * (jj) + 4), ATT_P0(8 * (jj) + 5)); a_.w = cvt_pk_bf16(ATT_P0(8 * (jj) + 6), ATT_P0(8 * (jj) + 7)); } \
        else { a_.x = cvt_pk_bf16(ATT_P1(8 * ((jj) - 2) + 0), ATT_P1(8 * ((jj) - 2) + 1)); a_.y = cvt_pk_bf16(ATT_P1(8 * ((jj) - 2) + 2), ATT_P1(8 * ((jj) - 2) + 3)); a_.z = cvt_pk_bf16(ATT_P1(8 * ((jj) - 2) + 4), ATT_P1(8 * ((jj) - 2) + 5)); a_.w = cvt_pk_bf16(ATT_P1(8 * ((jj) - 2) + 6), ATT_P1(8 * ((jj) - 2) + 7)); } \
        pw[jj] = __builtin_bit_cast(bf16x8, a_); asm volatile("s_nop 3" : "+v"(pw[jj])); } while (0)
            ATT_PACK(0);
            __builtin_amdgcn_sched_barrier(0);
#pragma unroll
            for (int j = 0; j < NPV; ++j) {
                const bf16x8 vf = (bf16x8){vlo[j & 3][0], vlo[j & 3][1], vlo[j & 3][2], vlo[j & 3][3], vhi[j & 3][0], vhi[j & 3][1], vhi[j & 3][2], vhi[j & 3][3]};
                o[j >> 2] = __builtin_amdgcn_mfma_f32_32x32x16_bf16(pw[j & 3], vf, o[j >> 2], 0, 0, 0);
                if (j + 4 < NPV) ATT_VLD(j + 4);
                if (j < 3) ATT_PACK(j + 1);
                __builtin_amdgcn_sched_barrier(0);
            }
#undef ATT_PACK
#undef ATT_P0
#undef ATT_P1
        }
#undef ATT_VLD
        if (PIPE) { c0 = n0; c1 = n1; }
    }
#undef ATT_KFRAG
#undef ATT_QK1
#undef ATT_SM1
#undef ATT_SMB4
#undef ATT_SMX4
#undef ATT_DMA
#undef ATT_KSRC
#undef ATT_KDST
#undef ATT_VSRC
#undef ATT_VDST
    waitv_bar<0>();
    l_reg += __shfl_xor(l_reg, 32);
    if (hi == 0) wsf[r32] = l_reg;
    asm volatile("s_waitcnt lgkmcnt(0)" ::: "memory");
    float rli[16];
#pragma unroll
    for (int r = 0; r < 16; ++r) rli[r] = 1.0f / wsf[crow(r, hi)];
    LAS bf16_t* stg = (LAS bf16_t*)lds + wid * (32 * DV);
#pragma unroll
    for (int r = 0; r < 16; ++r) { const int orow = crow(r, hi);
#pragma unroll
        for (int db = 0; db < NDB; ++db) stg[orow * DV + db * 32 + r32] = (bf16_t)f2bf(o[db][r] * rli[r]); }
    asm volatile("s_waitcnt lgkmcnt(0)" ::: "memory");
    constexpr int LPR = DV / 8, RPI = 64 / LPR;
#pragma unroll
    for (int i = 0; i < 32 / RPI; ++i) { const int row = i * RPI + lane / LPR, ch = lane % LPR;
        const u32x4 v = *(const LAS u32x4*)(stg + row * DV + ch * 8);
        *(u32x4*)(O + (size_t)(q0 + 32 * wid + row) * opitch + ch * 8) = v; }
    DMA_SYNC();
}

constexpr int SEL_NB = 1024, SEL_TIECAP = 128, SEL_POOLCAP = 2048;
__device__ __forceinline__ void sel_pool_put(unsigned* pool, LAS unsigned* pcnt, float s, unsigned kq) {
    const unsigned g = __hip_atomic_fetch_add(pcnt, 1u, __ATOMIC_RELAXED, __HIP_MEMORY_SCOPE_WORKGROUP);
    if (g < (unsigned)SEL_POOLCAP) { __hip_atomic_store(pool + 2 * g, __float_as_uint(s), __ATOMIC_RELAXED, __HIP_MEMORY_SCOPE_AGENT); __hip_atomic_store(pool + 2 * g + 1, kq, __ATOMIC_RELAXED, __HIP_MEMORY_SCOPE_AGENT); }
}
__device__ __forceinline__ unsigned sel_pool_get(unsigned* pool, unsigned i) { return __hip_atomic_load(pool + i, __ATOMIC_RELAXED, __HIP_MEMORY_SCOPE_AGENT); }
constexpr int SEL_HIST_OFF = 0, SEL_TIE_OFF = 65536, SEL_IK_OFF = 98304, SEL_QI_OFF = 131072;
__device__ __forceinline__ void dsa_select_unit(LAS unsigned char* lds, int u, const bf16_t* __restrict__ iq, const bf16_t* __restrict__ ik, const float* __restrict__ iw, const float* __restrict__ ikgain, unsigned* bitmapT, unsigned* pool) {
    int tid = threadIdx.x; asm volatile("" : "+v"(tid));
    const int lane = tid & 63, r32 = lane & 31, hc = lane >> 5; const int wid = __builtin_amdgcn_readfirstlane(tid >> 6);
    const int cq = u >> 1, NT = cq + 1, qbase = 32 * u;
    if (cq <= 3) {
        for (int i = tid; i < 2 * NT * 32; i += NTHREADS) bitmapT[(size_t)(i >> 5) * S + qbase + (i & 31)] = 0xffffffffu;
        return;
    }
    LAS unsigned* hist = (LAS unsigned*)(lds + SEL_HIST_OFF);
    LAS unsigned* tie = (LAS unsigned*)(lds + SEL_TIE_OFF);
    LAS float* qinfo = (LAS float*)(lds + SEL_QI_OFF);
    const int rr = r32, half_r = (rr >> 2) & 1, reggrp = rr >> 4, head_r = ((rr >> 3) & 1) * 4 + (rr & 3), qi_r = 2 * half_r + reggrp;
    const int qrow_r = qbase + 4 * wid + qi_r;
    bf16x8 af[4]; float nrm = 0.f; float afv[4][8];
#pragma unroll
    for (int ks = 0; ks < 4; ++ks) { const bf16x8 t = *(const bf16x8*)(iq + (size_t)qrow_r * 512 + head_r * 64 + ks * 16 + hc * 8);
#pragma unroll
        for (int j = 0; j < 8; ++j) { afv[ks][j] = bf2f((unsigned short)t[j]); nrm += afv[ks][j] * afv[ks][j]; } }
    nrm += __shfl_xor(nrm, 32); nrm = sqrtf(nrm);
    float kmax = fabsf(ikgain[lane]);
#pragma unroll
    for (int o_ = 1; o_ < 64; o_ <<= 1) kmax = fmaxf(kmax, __shfl_xor(kmax, o_));
    kmax *= 8.0f * 1.02f;
    const float bound = nrm * kmax, rs_ = bound > 0.f ? 1.0f / bound : 0.f;
#pragma unroll
    for (int ks = 0; ks < 4; ++ks) { u32x4 w; w.x = cvt_pk_bf16(afv[ks][0] * rs_, afv[ks][1] * rs_); w.y = cvt_pk_bf16(afv[ks][2] * rs_, afv[ks][3] * rs_);
        w.z = cvt_pk_bf16(afv[ks][4] * rs_, afv[ks][5] * rs_); w.w = cvt_pk_bf16(afv[ks][6] * rs_, afv[ks][7] * rs_);
        af[ks] = __builtin_bit_cast(bf16x8, w); }
    LAS float* wtab = qinfo + 256;
    { const float wp = iw[(size_t)qrow_r * 8 + head_r] * bound;
      float cp = fmaxf(wp, 0.f), cm = fmaxf(-wp, 0.f);
      cp += __shfl_xor(cp, 1); cp += __shfl_xor(cp, 2); cp += __shfl_xor(cp, 8);
      cm += __shfl_xor(cm, 1); cm += __shfl_xor(cm, 2); cm += __shfl_xor(cm, 8);
      if (hc == 0) { const int ql = 4 * wid + qi_r; wtab[ql * 8 + head_r] = wp;
          if (head_r == 0) { const float lo_ = -cm, rng_ = fmaxf(cp + cm, 1e-20f); qinfo[ql * 8 + 0] = lo_; qinfo[ql * 8 + 1] = ((float)SEL_NB * (1.0f - 4e-6f)) / rng_; qinfo[ql * 8 + 4] = 0.f; } } }
    for (int i = tid; i < 32 * 512 / 4; i += NTHREADS) ((LAS u32x4*)hist)[i] = (u32x4){0u, 0u, 0u, 0u};
    LAS unsigned* pcnt = (LAS unsigned*)(qinfo + 512);
    if (tid == 0) *pcnt = 0u;
    DMA_SYNC();
    const int ql0 = 4 * wid + 2 * hc, ql1 = ql0 + 1;
    float wv[16];
#pragma unroll
    for (int i = 0; i < 16; ++i) wv[i] = wtab[(ql0 + (i >> 3)) * 8 + (i & 7)];
    float lo0 = qinfo[ql0 * 8 + 0], inv0 = qinfo[ql0 * 8 + 1], lo1 = qinfo[ql1 * 8 + 0], inv1 = qinfo[ql1 * 8 + 1];
#pragma unroll
    for (int i = 0; i < 16; ++i) asm volatile("" : "+v"(wv[i]));
#pragma unroll
    for (int ks = 0; ks < 4; ++ks) asm volatile("" : "+v"(af[ks]));
    lo0 = -lo0 * inv0 + 1e-3f; lo1 = -lo1 * inv1 + 1e-3f;
    asm volatile("" : "+v"(lo0), "+v"(inv0), "+v"(lo1), "+v"(inv1));
    const unsigned ikdst = (unsigned)__builtin_amdgcn_readfirstlane((int)((unsigned)(uintptr_t)lds + SEL_IK_OFF + wid * 1024));
#define SEL_DMA(t) glds16(ik + (size_t)((t) * 64 + lane) * 64 + wid * 8, (unsigned)__builtin_amdgcn_readfirstlane((int)(ikdst + (((t) & 3) * 8192))))
#define SEL_RELU(x) __builtin_amdgcn_fmed3f((x), 0.f, 1.0f)
#define SEL_FMAC(acc, a, b) do { float b_ = (b); asm volatile("v_fmac_f32 %0, %1, %2" : "+v"(acc) : "v"(a), "v"(b_)); } while (0)
#define SEL_FRAG(kb_, i) (*(const LAS bf16x8*)((kb_) + (2 * ((i) >> 1) + hc) * 1024 + (32 * ((i) & 1) + r32) * 16))
#define SEL_REDUCE1(A0, A1, i) do { float t0_, t1_; asm volatile( \
        "v_max_f32_e64 %4, %7, %7 clamp\n\tv_max_f32_e64 %5, %8, %8 clamp\n\tv_fmac_f32 %0, %6, %4\n\tv_fmac_f32 %1, %11, %5\n\t" \
        "v_max_f32_e64 %4, %9, %9 clamp\n\tv_max_f32_e64 %5, %10, %10 clamp\n\tv_fmac_f32 %2, %6, %4\n\tv_fmac_f32 %3, %11, %5" \
        : "+v"(sc[0][0]), "+v"(sc[0][1]), "+v"(sc[1][0]), "+v"(sc[1][1]), "=&v"(t0_), "=&v"(t1_) \
        : "v"(wv[i]), "v"(A0[i]), "v"(A0[8 + (i)]), "v"(A1[i]), "v"(A1[8 + (i)]), "v"(wv[8 + (i)])); } while (0)
#define SEL_LOOP_BEGIN() SEL_DMA(0); if (NT > 1) SEL_DMA(1); if (NT > 2) SEL_DMA(2); \
    WAITV_BAR(0); \
    f32x16 a0 = f32x16{}, a1 = f32x16{}, n0 = f32x16{}, n1 = f32x16{}; \
    { const LAS unsigned char* kb0_ = lds + SEL_IK_OFF; bf16x8 bfr_[8]; \
      _Pragma("unroll") for (int i = 0; i < 8; ++i) bfr_[i] = SEL_FRAG(kb0_, i); \
      _Pragma("unroll") for (int i = 0; i < 8; ++i) { if ((i & 1) == 0) a0 = __builtin_amdgcn_mfma_f32_32x32x16_bf16(af[i >> 1], bfr_[i], a0, 0, 0, 0); else a1 = __builtin_amdgcn_mfma_f32_32x32x16_bf16(af[i >> 1], bfr_[i], a1, 0, 0, 0); } } \
    asm volatile("s_nop 7\n\ts_nop 7\n\ts_nop 3" : "+v"(a0), "+v"(a1));
#define SEL_STEP(A0, A1, N0, N1, t, BODY, FIRST) do { \
        const bool has_next = (t) + 1 < NT; \
        if (FIRST) WAITV_BAR(0);                                      \
        float sc[2][2] = {{0.f, 0.f}, {0.f, 0.f}}; \
        if (has_next) { const LAS unsigned char* kbn_ = lds + SEL_IK_OFF + (((t) + 1) & 3) * 8192; bf16x8 bfr_[8]; \
            _Pragma("unroll") for (int i = 0; i < 8; ++i) bfr_[i] = SEL_FRAG(kbn_, i); \
            __builtin_amdgcn_sched_barrier(0); \
            _Pragma("unroll") for (int i = 0; i < 8; ++i) { \
                if (i == 0) N0 = __builtin_amdgcn_mfma_f32_32x32x16_bf16(af[0], bfr_[0], f32x16{}, 0, 0, 0); \
                else if (i == 1) N1 = __builtin_amdgcn_mfma_f32_32x32x16_bf16(af[0], bfr_[1], f32x16{}, 0, 0, 0); \
                else if ((i & 1) == 0) N0 = __builtin_amdgcn_mfma_f32_32x32x16_bf16(af[i >> 1], bfr_[i], N0, 0, 0, 0); else N1 = __builtin_amdgcn_mfma_f32_32x32x16_bf16(af[i >> 1], bfr_[i], N1, 0, 0, 0); \
                SEL_REDUCE1(A0, A1, i); __builtin_amdgcn_sched_barrier(0); } \
        } else { _Pragma("unroll") for (int i = 0; i < 8; ++i) SEL_REDUCE1(A0, A1, i); } \
        if (FIRST) { if ((t) + 3 < NT) SEL_DMA((t) + 3); if ((t) + 4 < NT) SEL_DMA((t) + 4); }     \
        BODY(t) } while (0)
#define SEL_LOOP(BODY) for (int t = 0; t < NT; t += 2) { SEL_STEP(a0, a1, n0, n1, t, BODY, true); if (t + 1 < NT) SEL_STEP(n0, n1, a0, a1, t + 1, BODY, false); }
#define SEL_F(s, nlo_, inv_) ({ float f_; asm("v_fma_f32 %0, %1, %2, %3" : "=v"(f_) : "v"(s), "v"(inv_), "v"(nlo_)); f_; })
    LAS unsigned* hrow = hist + (ql0 >> 1) * SEL_NB;
#define SEL_BODY1(t) _Pragma("unroll") for (int sub = 0; sub < 2; ++sub) { \
            const unsigned b0 = (unsigned)(int)SEL_F(sc[sub][0], lo0, inv0) & (unsigned)(SEL_NB - 1), b1 = (unsigned)(int)SEL_F(sc[sub][1], lo1, inv1) & (unsigned)(SEL_NB - 1); \
            __hip_atomic_fetch_add(hrow + b0, 1u, __ATOMIC_RELAXED, __HIP_MEMORY_SCOPE_WORKGROUP); \
            __hip_atomic_fetch_add(hrow + b1, 65536u, __ATOMIC_RELAXED, __HIP_MEMORY_SCOPE_WORKGROUP); }
    { SEL_LOOP_BEGIN() SEL_LOOP(SEL_BODY1) }
#undef SEL_BODY1
    DMA_SYNC();
    for (int qi = 0; qi < 4; ++qi) {
        const int ql = 4 * wid + qi;
        unsigned hw[16];
        { const LAS u32x4* hp = (const LAS u32x4*)(hist + (ql >> 1) * SEL_NB + 16 * lane); const int sh = 16 * (ql & 1);
#pragma unroll
          for (int j = 0; j < 4; ++j) { const u32x4 h4 = hp[j]; hw[4 * j + 0] = (h4.x >> sh) & 0xffffu; hw[4 * j + 1] = (h4.y >> sh) & 0xffffu; hw[4 * j + 2] = (h4.z >> sh) & 0xffffu; hw[4 * j + 3] = (h4.w >> sh) & 0xffffu; } }
        unsigned ls = 0;
#pragma unroll
        for (int j = 0; j < 16; ++j) ls += hw[j];
        unsigned suf = ls;
#pragma unroll
        for (int d = 1; d < 64; d <<= 1) { const unsigned t_ = __shfl_down(suf, d); if (lane + d < 64) suf += t_; }
        const unsigned excl = suf - ls;
        if (excl < 256u && suf >= 256u) {
            unsigned c = excl; int bstar = -1; unsigned cgt = 0;
#pragma unroll
            for (int bb = 15; bb >= 0; --bb) { const unsigned cnt = hw[bb];
                if (bstar < 0) { if (c + cnt >= 256u) { bstar = 16 * lane + bb; cgt = c; } else c += cnt; } }
            qinfo[ql * 8 + 2] = __int_as_float(bstar); qinfo[ql * 8 + 3] = __uint_as_float(cgt);
        }
    }
    DMA_SYNC();
    const int bs0 = __float_as_int(qinfo[ql0 * 8 + 2]), bs1 = __float_as_int(qinfo[ql1 * 8 + 2]);
    LAS unsigned* bm = hist;
    LAS unsigned* tcnt0 = (LAS unsigned*)(qinfo + ql0 * 8 + 4); LAS unsigned* tcnt1 = (LAS unsigned*)(qinfo + ql1 * 8 + 4);
    const float fl0 = (float)bs0, fh0 = (float)(bs0 + 1), fl1 = (float)bs1, fh1 = (float)(bs1 + 1);
#define SEL_BODY2(t) _Pragma("unroll") for (int sub = 0; sub < 2; ++sub) { \
            const float s0 = sc[sub][0], s1 = sc[sub][1]; \
            const float f0 = SEL_F(s0, lo0, inv0), f1 = SEL_F(s1, lo1, inv1); \
            const unsigned long long m0 = __ballot(f0 >= fh0), m1 = __ballot(f1 >= fh1); \
            if (r32 == 0) { bm[(2 * (t) + sub) * 32 + ql0] = hc ? (unsigned)(m0 >> 32) : (unsigned)m0; bm[(2 * (t) + sub) * 32 + ql1] = hc ? (unsigned)(m1 >> 32) : (unsigned)m1; } \
            const unsigned key = (unsigned)((t) * 64 + sub * 32 + r32); \
            const bool t0_ = (f0 >= fl0) && !(f0 >= fh0), t1_ = (f1 >= fl1) && !(f1 >= fh1); \
            if (__ballot(t0_ || t1_) != 0ull) {                  \
                if (t0_) { const unsigned slot = __hip_atomic_fetch_add(tcnt0, 1u, __ATOMIC_RELAXED, __HIP_MEMORY_SCOPE_WORKGROUP); \
                    if (slot < SEL_TIECAP) { tie[(ql0 * SEL_TIECAP + slot) * 2] = __float_as_uint(s0); tie[(ql0 * SEL_TIECAP + slot) * 2 + 1] = key; } \
                    else sel_pool_put(pool, pcnt, s0, key | ((unsigned)ql0 << 16)); } \
                if (t1_) { const unsigned slot = __hip_atomic_fetch_add(tcnt1, 1u, __ATOMIC_RELAXED, __HIP_MEMORY_SCOPE_WORKGROUP); \
                    if (slot < SEL_TIECAP) { tie[(ql1 * SEL_TIECAP + slot) * 2] = __float_as_uint(s1); tie[(ql1 * SEL_TIECAP + slot) * 2 + 1] = key; } \
                    else sel_pool_put(pool, pcnt, s1, key | ((unsigned)ql1 << 16)); } } }
    { SEL_LOOP_BEGIN() SEL_LOOP(SEL_BODY2) }
#undef SEL_BODY2
    DMA_SYNC();
#undef SEL_STEP
#undef SEL_LOOP
#undef SEL_F
#undef SEL_LOOP_BEGIN
#undef SEL_DMA
#undef SEL_FRAG
#undef SEL_REDUCE1
#undef SEL_RELU
#undef SEL_FMAC
    const unsigned pn = min(*pcnt, (unsigned)SEL_POOLCAP);
    LAS unsigned* pl = (LAS unsigned*)(lds + SEL_IK_OFF);
    if (pn) { for (unsigned i = tid; i < 2 * pn; i += NTHREADS) pl[i] = sel_pool_get(pool, i); DMA_SYNC(); }
    for (int qi = 0; qi < 4; ++qi) {
        const int ql = 4 * wid + qi;
        const unsigned tot = *(LAS unsigned*)(qinfo + ql * 8 + 4);
        const unsigned n = min(tot, (unsigned)SEL_TIECAP);
        const unsigned need = 256u - __float_as_uint(qinfo[ql * 8 + 3]);
        const LAS unsigned* tl = tie + ql * SEL_TIECAP * 2;
        if (tot <= (unsigned)SEL_TIECAP) {
            for (unsigned i0 = 0; i0 < n; i0 += 64) {
                const unsigned i = i0 + lane; const bool act = i < n;
                const float si = act ? __uint_as_float(tl[2 * i]) : 0.f; const unsigned ki = act ? tl[2 * i + 1] : 0u;
                unsigned rank = 0;
                for (unsigned j = 0; j < n; ++j) { const float sj = __uint_as_float(tl[2 * j]); const unsigned kj = tl[2 * j + 1]; rank += (sj > si || (sj == si && kj < ki)) ? 1u : 0u; }
                if (act && rank < need) __hip_atomic_fetch_or(bm + (ki >> 5) * 32 + ql, 1u << (ki & 31u), __ATOMIC_RELAXED, __HIP_MEMORY_SCOPE_WORKGROUP);
            }
        } else {
            const unsigned nt = n + pn;
#define SEL_ENT(i, valid, us, kr) do { unsigned sb_, kq_; if ((i) < n) { sb_ = tl[2 * (i)]; kq_ = tl[2 * (i) + 1] | ((unsigned)ql << 16); } else { sb_ = pl[2 * ((i) - n)]; kq_ = pl[2 * ((i) - n) + 1]; } \
            valid = (kq_ >> 16) == (unsigned)ql; sb_ = (sb_ == 0x80000000u) ? 0u : sb_; us = sb_ ^ ((unsigned)((int)sb_ >> 31) | 0x80000000u); kr = 16383u - (kq_ & 0xffffu); } while (0)
            if (nt <= 512u) {
                unsigned eu[8], ek[8]; bool ev[8];
#pragma unroll
                for (int r = 0; r < 8; ++r) { const unsigned i = 64u * r + lane; ev[r] = false; eu[r] = 0u; ek[r] = 0u; if (i < nt) SEL_ENT(i, ev[r], eu[r], ek[r]); }
                unsigned ts = 0u;
                for (int bit = 31; bit >= 0; --bit) { const unsigned cand = ts | (1u << bit); unsigned c = 0u;
#pragma unroll
                    for (int r = 0; r < 8; ++r) c += (unsigned)__popcll(__ballot(ev[r] && eu[r] >= cand));
                    if (c >= need) ts = cand; }
                unsigned cg = 0u;
#pragma unroll
                for (int r = 0; r < 8; ++r) cg += (unsigned)__popcll(__ballot(ev[r] && eu[r] > ts));
                const unsigned need2 = need - cg;
                unsigned kt = 0u;
                for (int bit = 13; bit >= 0; --bit) { const unsigned cand = kt | (1u << bit); unsigned c = 0u;
#pragma unroll
                    for (int r = 0; r < 8; ++r) c += (unsigned)__popcll(__ballot(ev[r] && eu[r] == ts && ek[r] >= cand));
                    if (c >= need2) kt = cand; }
#pragma unroll
                for (int r = 0; r < 8; ++r) if (ev[r] && (eu[r] > ts || (eu[r] == ts && ek[r] >= kt))) { const unsigned ki = 16383u - ek[r];
                    __hip_atomic_fetch_or(bm + (ki >> 5) * 32 + ql, 1u << (ki & 31u), __ATOMIC_RELAXED, __HIP_MEMORY_SCOPE_WORKGROUP); }
            } else {
            unsigned ts = 0u;
            for (int bit = 31; bit >= 0; --bit) { const unsigned cand = ts | (1u << bit); unsigned c = 0u;
                for (unsigned i0 = 0; i0 < nt; i0 += 64) { const unsigned i = i0 + lane; bool v = false; unsigned us = 0u, kr = 0u; if (i < nt) SEL_ENT(i, v, us, kr); c += (unsigned)__popcll(__ballot(v && us >= cand)); }
                if (c >= need) ts = cand; }
            unsigned cg = 0u;
            for (unsigned i0 = 0; i0 < nt; i0 += 64) { const unsigned i = i0 + lane; bool v = false; unsigned us = 0u, kr = 0u; if (i < nt) SEL_ENT(i, v, us, kr); cg += (unsigned)__popcll(__ballot(v && us > ts)); }
            const unsigned need2 = need - cg;
            unsigned kt = 0u;
            for (int bit = 13; bit >= 0; --bit) { const unsigned cand = kt | (1u << bit); unsigned c = 0u;
                for (unsigned i0 = 0; i0 < nt; i0 += 64) { const unsigned i = i0 + lane; bool v = false; unsigned us = 0u, kr = 0u; if (i < nt) SEL_ENT(i, v, us, kr); c += (unsigned)__popcll(__ballot(v && us == ts && kr >= cand)); }
                if (c >= need2) kt = cand; }
            for (unsigned i = lane; i < nt; i += 64) { bool v; unsigned us, kr; SEL_ENT(i, v, us, kr);
                if (v && (us > ts || (us == ts && kr >= kt))) { const unsigned ki = 16383u - kr; __hip_atomic_fetch_or(bm + (ki >> 5) * 32 + ql, 1u << (ki & 31u), __ATOMIC_RELAXED, __HIP_MEMORY_SCOPE_WORKGROUP); } }
            }
#undef SEL_ENT
        }
    }
    DMA_SYNC();
    for (int i = tid; i < 2 * NT * 32; i += NTHREADS) bitmapT[(size_t)(i >> 5) * S + qbase + (i & 31)] = bm[i];
    DMA_SYNC();
}

#define XB_TMO      128
#define XB_XCNT(j)  (256  + 64 * (j))
#define XB_XSUB(j)  (1280 + 64 * (j))
#define XB_XGEN(j)  (2304 + 64 * (j))
#define XB_TOP      3328
#define XB_TOPGEN   3392
#define XCD_BAR_WORDS 3456
#define XB_SPIN_CAP (1u << 22)
__device__ __forceinline__ unsigned xb_ld(unsigned* p)              { return __hip_atomic_load(p, __ATOMIC_RELAXED, __HIP_MEMORY_SCOPE_AGENT); }
__device__ __forceinline__ unsigned xb_add(unsigned* p, unsigned v) { return __hip_atomic_fetch_add(p, v, __ATOMIC_RELAXED, __HIP_MEMORY_SCOPE_AGENT); }
__device__ __forceinline__ unsigned xb_xcc_id() { return (unsigned)__builtin_amdgcn_s_getreg((3 << 11) | 20) & 0xFu; }
#define XB_SPIN(cond, bar) do { unsigned _sp = 0; while (cond) { __builtin_amdgcn_s_sleep(1); \
    if ((++_sp & 255u) == 0u) { if (xb_ld(&(bar)[XB_TMO])) break; if (_sp > XB_SPIN_CAP) { atomicAdd(&(bar)[XB_TMO], 1u); break; } } } } while (0)
struct XcdBarrier { unsigned* bar; unsigned x; volatile LAS unsigned* st; };
__device__ __forceinline__ XcdBarrier xcd_barrier_post(unsigned* bar, volatile LAS unsigned* st) {
    XcdBarrier b; b.bar = bar; b.x = xb_xcc_id(); b.st = st;
    return b;
}
__device__ __forceinline__ void xcd_barrier_complete(unsigned* bar, unsigned x, unsigned& nloc, unsigned& nx) {
    const unsigned G = gridDim.x * gridDim.y * gridDim.z;
    unsigned sum, cnt, mine, sp = 0u;
    for (;;) {
        sum = 0u; cnt = 0u; mine = 0u;
#pragma unroll
        for (unsigned j = 0; j < 16; ++j) { const unsigned c = xb_ld(&bar[XB_XCNT(j)]); sum += c; cnt += (c > 0u) ? 1u : 0u; mine = (j == x) ? c : mine; }
        if (sum == G) break;
        __builtin_amdgcn_s_sleep(1);
        if ((++sp & 255u) == 0u) { if (xb_ld(&bar[XB_TMO])) break; if (sp > XB_SPIN_CAP) { atomicAdd(&bar[XB_TMO], 1u); break; } }
    }
    nloc = mine > 0u ? mine : 1u; nx = cnt > 0u ? cnt : 1u;
}
__device__ __forceinline__ void xcd_barrier(const XcdBarrier& b) {
    asm volatile("s_waitcnt vmcnt(0)" ::: "memory");
    __syncthreads();
    if (threadIdx.x == 0) {
        unsigned* bar = b.bar;
        __builtin_amdgcn_s_waitcnt(0);
        unsigned nloc = b.st[0], nx = b.st[1];
        if (nloc == 0u) { xcd_barrier_complete(bar, b.x, nloc, nx); b.st[0] = nloc; b.st[1] = nx; }
        const unsigned old = xb_add(&bar[XB_XSUB(b.x)], 1u);
        const unsigned gen = old / nloc;
        if (old + 1u == (gen + 1u) * nloc) {
            __builtin_amdgcn_fence(__ATOMIC_RELEASE, "agent");
            asm volatile("s_waitcnt vmcnt(0)" ::: "memory");
            const unsigned og = xb_add(&bar[XB_TOP], 1u);
            const unsigned tg = og / nx;
            if (og + 1u == (tg + 1u) * nx) xb_add(&bar[XB_TOPGEN], 1u);
            else XB_SPIN(xb_ld(&bar[XB_TOPGEN]) == tg, bar);
            __builtin_amdgcn_fence(__ATOMIC_ACQUIRE, "agent");
            xb_add(&bar[XB_XGEN(b.x)], 1u);
            asm volatile("s_waitcnt vmcnt(0)" ::: "memory");
        } else {
            XB_SPIN(xb_ld(&bar[XB_XGEN(b.x)]) == gen, bar);
            __builtin_amdgcn_fence(__ATOMIC_ACQUIRE, "agent");
            asm volatile("s_waitcnt vmcnt(0)" ::: "memory");
        }
    }
    __syncthreads();
}

struct Args { const float* in[52]; float* out; unsigned char* ws; int ph_lo, ph_hi; };
enum { P_CONV = 0, P_KV, P_GU1, P_D1, P_WIN, P_MIXA, P_MIXB, P_MIXC, P_WOUT, P_WQ, P_MATT, P_WO, P_GU2, P_D2, P_PER_LAYER };
constexpr int PH_END = 2 * P_PER_LAYER;
#ifndef DBG_LAST
#define DBG_LAST PH_END
#endif

#define CONV_RUN(src0, src1, gain, dst, Nsrc, K, Nrows, mode) do { const int nitems_ = ((Nrows) / 32) * ((K) / 64); \
    f32x4 va_[8], vb_[8]; int it_ = gw; \
    if (it_ < nitems_) conv_load(src0, src1, gain, Nsrc, Nrows, mode, it_, lane, va_); \
    while (it_ < nitems_) { \
        if (it_ + NGW < nitems_) conv_load(src0, src1, gain, Nsrc, Nrows, mode, it_ + NGW, lane, vb_); \
        conv_store(dst, K, Nrows, it_, scr, lane, va_); it_ += NGW; if (it_ >= nitems_) break; \
        if (it_ + NGW < nitems_) conv_load(src0, src1, gain, Nsrc, Nrows, mode, it_ + NGW, lane, va_); \
        conv_store(dst, K, Nrows, it_, scr, lane, vb_); it_ += NGW; } } while (0)

__device__ __forceinline__ int t5_bucket(int rel) {
    const int off = rel < 0 ? 16 : 0; const int n = rel < 0 ? -rel : rel;
    if (n < 8) return off + n;
    int large = 8 + (int)(logf((float)n / 8.0f) / 2.772588722239781f * 8.0f);
    if (n == 64) large = 13;
    if (large > 15) large = 15;
    return off + large;
}

template <int L>
__device__ __forceinline__ void run_layer(const Args& a, LAS unsigned char* lds, cg::grid_group& grid, const XcdBarrier& xbar, int lo, int hi) {
    const int tid = threadIdx.x, lane = tid & 63, wave = __builtin_amdgcn_readfirstlane(tid >> 6);
    const int G = gridDim.x, bx = blockIdx.x;
    const int gw = bx * 8 + wave, NGW = G * 8;
    const int vcu = (G % 8 == 0) ? (bx % 8) * (G / 8) + bx / 8 : bx;
    unsigned char* ws = a.ws;
    constexpr int IB = (L == 0) ? 3 : 31;
    constexpr int MB = IB + ((L == 0) ? 17 : 10);
    constexpr int PB = L * P_PER_LAYER;
#define IN(k) (lo <= (PB + (k)) && (PB + (k)) < hi)
#define SYNC(k) do { if (IN(k) && (PB + (k) + 1) < hi) { if (PB + (k) == 0) { \
        if (bx == 0) { for (int i_ = threadIdx.x; i_ < XCD_BAR_WORDS; i_ += NTHREADS) __hip_atomic_store(&xbar.bar[i_], 0u, __ATOMIC_RELAXED, __HIP_MEMORY_SCOPE_AGENT); }     \
        grid.sync(); \
        if (threadIdx.x == 0) (void)xb_add(&xbar.bar[XB_XCNT(xbar.x)], 1u); } \
    else xcd_barrier(xbar); } } while (0)
    float* rsp = (float*)(ws + WS_RS); float* rsm = (float*)(ws + WS_RSM);
#define RSP(i) (rsp + (size_t)((i) & 1) * S * 16)
    bf16_t* hb = (bf16_t*)(ws + WS_HB); bf16_t* rb = (bf16_t*)a.out;
    bf16_t* osub = rb + (size_t)S * D;
    bf16_t* ocat = (bf16_t*)(ws + WS_OCAT);
    unsigned char* R = ws + WS_R;
    bf16_t* act = (bf16_t*)(R + R_ACT);
    float* lut5 = (float*)(ws + WS_LUT5); float* lutb = (float*)(ws + WS_LUTB);
    signed char* hq = (signed char*)(ws + WS_OCAT);
    float* qs = (float*)(ws + WS_QS); float* sb1 = (float*)(ws + WS_SB); float* sb2 = sb1 + 2 * FF; float* sbw = sb2 + 2 * FF;

#define CONVQ_RUN(MODE_, wg_, wu_, Nsrc_, Nrows_, gain_, dst_, sb_, first_, stride_) do { LAS float* xch_ = (LAS float*)(lds + 131072); \
        for (int it_ = (first_); it_ < (Nrows_) / 32; it_ += (stride_)) convq_item<MODE_>(wg_, wu_, Nsrc_, gain_, (signed char*)(dst_), sb_, it_, scr, xch_, wave, lane); } while (0)
#define CV_D1(IBx)   CONV_RUN(a.in[(IBx) + 3], a.in[(IBx) + 3], (const float*)nullptr, (bf16_t*)(ws + W_D1), D, FF, D, MAP_P8)
#define CV_WOUT(MBx) CONV_RUN(a.in[(MBx) - 1], a.in[(MBx) - 1], (const float*)nullptr, (bf16_t*)(ws + W_OUT), D, D, D, MAP_P8)
#define CV_WQ(MBx)   CONV_RUN(a.in[(MBx) + 2], a.in[(MBx) + 2], a.in[(MBx) + 0], (bf16_t*)(ws + W_Q), 512, D, 512, MAP_P8)
#define CV_WKV(MBx, slot_)  CONV_RUN(a.in[(MBx) + 3], a.in[(MBx) + 3], a.in[(MBx) + 1], (bf16_t*)(ws + (slot_)), D, D, D, MAP_P8)
#define CV_WO(MBx)   CONV_RUN(a.in[(MBx) + 6], a.in[(MBx) + 6], (const float*)nullptr, (bf16_t*)(ws + W_O), D, 512, D, MAP_P8)
#define CV_D2(MBx)   CONV_RUN(a.in[(MBx) + 10], a.in[(MBx) + 10], (const float*)nullptr, (bf16_t*)(ws + W_D2), D, FF, D, MAP_P8)
#define CV_GU1Q(IBx, f_, s_) CONVQ_RUN(MAP_GU, a.in[(IBx) + 1], a.in[(IBx) + 2], FF, 2 * FF, a.in[(IBx) + 0], ws + W_GU1, sb1, f_, s_)
#define CV_GU2Q(MBx, f_, s_) CONVQ_RUN(MAP_GU, a.in[(MBx) + 8], a.in[(MBx) + 9], FF, 2 * FF, a.in[(MBx) + 7], ws + W_GU2, sb2, f_, s_)
#define CV_WIN0Q(IBx, f_, s_) CONVQ_RUN(MAP_H64Q_L0, a.in[(IBx) + 5], a.in[(IBx) + 5], 3656, NWINQ, a.in[(IBx) + 4], ws + W_IN, sbw, f_, s_)
#define CV_WIN1Q(IBx, f_, s_) CONVQ_RUN(MAP_H64_L1, a.in[(IBx) + 5], a.in[(IBx) + 5], 3072, NWINQ, a.in[(IBx) + 4], ws + W_IN, sbw, f_, s_)
#define CV_WIN0I(IBx) CONV_RUN(a.in[(IBx) + 5], a.in[(IBx) + 5], a.in[(IBx) + 4], (bf16_t*)(ws + W_INI), 3656, D, NWINI, MAP_H64I_L0)
#define SIDE_BEGIN(fb, nb) if (bx >= (fb) && bx < (fb) + (nb)) { const int sf_ = bx - (fb), ss_ = (nb); const int gw = sf_ * 8 + wave, NGW = ss_ * 8; LAS float* scr = (LAS float*)(lds + wave * 16384); (void)gw; (void)NGW; (void)scr;
#define SIDE_END() }
#define KV_GEMM(cb, slot_, raw_) do { if (bx >= (cb) && bx < (cb) + 4) { \
        pg8::Gemm g_{(const bf16_t*)(ws + WS_MEMB), (const bf16_t*)(ws + (slot_)), NMEM, D, D}; pg8::StaticOrder so_; so_.init(NMEM, D, G, bx - (cb)); \
        EpiF32 E_{(float*)(ws + (raw_)), D, rsm}; pg8::gemm_phase(lds, g_, so_, E_); } } while (0)
#define KV_NORM(kgp, cb, raw_) do { if (bx >= (cb) && bx < (cb) + 8) { \
        const float* kv = (const float*)(ws + (raw_)); bf16_t* km = (bf16_t*)(ws + WS_KMEM); bf16_t* vm = (bf16_t*)(ws + WS_VMEM); const float* kg = (kgp); \
        for (int m = (bx - (cb)) * 8 + wave; m < NMEM; m += 64) { \
            const f32x4 k0 = *(const f32x4*)(kv + (size_t)m * D + 8 * lane), k1 = *(const f32x4*)(kv + (size_t)m * D + 8 * lane + 4); \
            float ss = (k0[0] * k0[0] + k0[1] * k0[1]) + (k0[2] * k0[2] + k0[3] * k0[3]) + (k1[0] * k1[0] + k1[1] * k1[1]) + (k1[2] * k1[2] + k1[3] * k1[3]); \
            ss += __shfl_xor(ss, 1); ss += __shfl_xor(ss, 2); ss += __shfl_xor(ss, 4); ss += __shfl_xor(ss, 8); \
            const float inv = 1.0f / sqrtf(ss * (1.0f / 128.0f) + EPS); \
            const int d = (8 * lane) & 127; const f32x4 ga = *(const f32x4*)(kg + d), gb = *(const f32x4*)(kg + d + 4); \
            u32x4 w; w.x = cvt_pk_bf16(k0[0] * inv * ga[0], k0[1] * inv * ga[1]); w.y = cvt_pk_bf16(k0[2] * inv * ga[2], k0[3] * inv * ga[3]); \
            w.z = cvt_pk_bf16(k1[0] * inv * gb[0], k1[1] * inv * gb[1]); w.w = cvt_pk_bf16(k1[2] * inv * gb[2], k1[3] * inv * gb[3]); \
            *(u32x4*)(km + (size_t)m * 512 + 8 * lane) = w; \
            const f32x4 v0 = *(const f32x4*)(kv + (size_t)m * D + 512 + 8 * lane), v1 = *(const f32x4*)(kv + (size_t)m * D + 512 + 8 * lane + 4); \
            u32x4 x; x.x = cvt_pk_bf16(v0[0], v0[1]); x.y = cvt_pk_bf16(v0[2], v0[3]); x.z = cvt_pk_bf16(v1[0], v1[1]); x.w = cvt_pk_bf16(v1[2], v1[3]); \
            *(u32x4*)(vm + (size_t)m * 512 + 8 * lane) = x; } } } while (0)
    const int SLK = G >> 1;

    if (L == 0 && IN(P_CONV)) {
        LAS float* scr = (LAS float*)(lds + wave * 16384);
        CV_GU1Q(3, bx, G); CV_D1(3);
        { f32x4 va[4], vb[4]; int m = gw;
          if (m < S) row_load(a.in[0] + (size_t)m * D, lane, va);
          while (m < S) {
              if (m + NGW < S) row_load(a.in[0] + (size_t)(m + NGW) * D, lane, vb);
              row_to_q8(va, hq + (size_t)m * D, qs + m, RSP(0) + (size_t)m * 16, lane); m += NGW; if (m >= S) break;
              if (m + NGW < S) row_load(a.in[0] + (size_t)(m + NGW) * D, lane, va);
              row_to_q8(vb, hq + (size_t)m * D, qs + m, RSP(0) + (size_t)m * 16, lane); m += NGW; } }
        for (int m = gw; m < NMEM; m += NGW) row_to_bf16(a.in[1] + (size_t)m * D, (bf16_t*)(ws + WS_MEMB) + (size_t)m * D, rsm + (size_t)m * 16, lane);
        for (int i = bx * NTHREADS + tid; i < 12 * 256; i += G * NTHREADS) { const int h = i >> 8, e = i & 255; const int rel = 191 - e;
            lut5[i] = (a.in[2][t5_bucket(rel) * 12 + h] - a.in[2][15 * 12 + h]) * LOG2E; }
        for (int i = bx * NTHREADS + tid; i < 16 * 640; i += G * NTHREADS) { const int h = i / 640, e = i % 640; int rel = 575 - e; rel = rel < -256 ? -256 : (rel > 256 ? 256 : rel);
            lutb[i] = (a.in[39][(rel + 256) * 16 + h] - a.in[39][512 * 16 + h]) * LOG2E; }
    }
    if (L == 0) SYNC(P_CONV);
    if (IN(P_GU1)) {
        pg8::Gemm g{(const bf16_t*)hq, (const bf16_t*)(ws + W_GU1), S, 2 * FF, D / 2}; pg8::StaticOrder so; so.init(S, 2 * FF, G, bx);
        LAS float* tab = (LAS float*)(lds + pg8::STAGE_BYTES); guq_prep<true>(tab, so, RSP(4 * L + 0), qs, sb1);
        EpiGUq E{act, tab};
        pg8::gemm_phase(lds, g, so, E);
        if (L == 0) { SIDE_BEGIN(SLK, G - SLK) CV_WIN0Q(3, sf_, ss_); CV_WIN0I(3); CV_WKV(20, W_KV); SIDE_END() }
        else { SIDE_BEGIN(SLK, G - SLK) CV_WIN1Q(31, sf_, ss_); CV_WOUT(41); CV_WQ(41); CV_WO(41); SIDE_END() }
    }
    SYNC(P_GU1);
    if (IN(P_D1)) {
        pg8::Gemm g{act, (const bf16_t*)(ws + W_D1), S, D, FF}; pg8::StaticOrder so; so.init(S, D, G, bx);
        if (L == 0) { EpiRes<true, true, false, true> E{a.in[0], rb, hq, RSP(4 * L + 1), qs, RSP(4 * L + 0)}; pg8::gemm_phase(lds, g, so, E); }
        else { EpiRes<true, false, false, true> E{rb, rb, hq, RSP(4 * L + 1), qs, RSP(4 * L + 0)}; pg8::gemm_phase(lds, g, so, E); }
    }
    SYNC(P_D1);
    if (IN(P_WIN)) {
        pg8::Gemm g{(const bf16_t*)hq, (const bf16_t*)(ws + W_IN), S, NWINQ, D / 2}; pg8::StaticOrder so; so.init(S, NWINQ, G, bx);
        LAS float* tab = (LAS float*)(lds + pg8::STAGE_BYTES); guq_prep<false>(tab, so, RSP(4 * L + 1), qs, sbw);
        if (L == 0) {
            { EpiWin<0> E{R, nullptr, tab, a.in[IB + 6], a.in[IB + 7], a.in[IB + 9], a.in[IB + 10]}; pg8::gemm_phase(lds, g, so, E); }
            pg8::Gemm gi{rb, (const bf16_t*)(ws + W_INI), S, NWINI, D}; pg8::StaticOrder si; si.init(S, NWINI, G, bx);
            EpiWin<2> Ei{R, RSP(4 * L + 1), nullptr, a.in[IB + 8], nullptr, nullptr, nullptr}; pg8::gemm_phase(lds, gi, si, Ei);
        } else { EpiWin<1> E{R, nullptr, tab, a.in[IB + 6], a.in[IB + 7], nullptr, nullptr}; pg8::gemm_phase(lds, g, so, E); }
        if (L == 0) { KV_GEMM((3 * G) >> 2, W_KV, WS_KVRAW);
            SIDE_BEGIN(((3 * G) >> 2) + 4, G - ((3 * G) >> 2) - 4) CV_WOUT(20); CV_WQ(20); CV_WO(20); CV_D1(31); CV_WKV(41, W_KV2); SIDE_END() }
    }
    SYNC(P_WIN);
    if (L == 0) {
        if (IN(P_MIXA)) {
            for (int pr = vcu; pr < 256; pr += G) {
                dsa_select_unit(lds, 511 - pr, (const bf16_t*)(R + R_IQ), (const bf16_t*)(R + R_IK), (const float*)(R + R_IW), a.in[IB + 8], (unsigned*)hb, (unsigned*)(ws + W_GU1 + 6 * MiB) + (size_t)bx * 2 * SEL_POOLCAP);
                dsa_select_unit(lds, pr, (const bf16_t*)(R + R_IQ), (const bf16_t*)(R + R_IK), (const float*)(R + R_IW), a.in[IB + 8], (unsigned*)hb, (unsigned*)(ws + W_GU1 + 6 * MiB) + (size_t)bx * 2 * SEL_POOLCAP);
            }
            for (int pr = vcu; pr < 256; pr += G) { const int hm = pr >> 5, s = pr & 31;
#pragma unroll 1
                for (int k = 0; k < 2; ++k) { const int qb = k ? s : 63 - s;
                    attn_unit<64, 128, AM_T5>(lds, (const bf16_t*)(R + R_BQ) + hm * 64, 512, (const bf16_t*)(R + R_BK) + hm * 64, 512, (const bf16_t*)(R + R_BV) + (hm >> 1) * 128, 512,
                                              osub + hm * 128, 1024, qb * 256, lut5 + (8 + (hm >> 1)) * 256, nullptr, nullptr); }
            }
        }
        SYNC(P_MIXA);
        if (IN(P_MIXB)) {
            const float lq1 = a.in[IB + 11][lane], lk1 = a.in[IB + 12][lane], lq2 = a.in[IB + 13][lane], lk2 = a.in[IB + 14][lane];
            const float lam = __expf(wave_sum(lq1 * lk1)) - __expf(wave_sum(lq2 * lk2)) + 0.2f;
            const float g0 = a.in[IB + 15][2 * lane], g1 = a.in[IB + 15][2 * lane + 1];
            unsigned wn[8];
            if (gw < S) {
#pragma unroll
                for (int j = 0; j < 8; ++j) wn[j] = *(const unsigned*)(osub + (size_t)gw * 1024 + j * 128 + 2 * lane);
            }
            for (int m = gw; m < S; m += NGW) {
                unsigned w[8];
#pragma unroll
                for (int j = 0; j < 8; ++j) w[j] = wn[j];
                if (m + NGW < S) {
#pragma unroll
                    for (int j = 0; j < 8; ++j) wn[j] = *(const unsigned*)(osub + (size_t)(m + NGW) * 1024 + j * 128 + 2 * lane);
                }
                asm volatile("" ::: "memory");
#pragma unroll
                for (int h = 0; h < 4; ++h) {
                    const float a0 = bf2f((unsigned short)(w[2 * h] & 0xffffu)) - lam * bf2f((unsigned short)(w[2 * h + 1] & 0xffffu));
                    const float a1 = bf2f((unsigned short)(w[2 * h] >> 16)) - lam * bf2f((unsigned short)(w[2 * h + 1] >> 16));
                    const float inv = 0.8f / sqrtf(wave_sum(a0 * a0 + a1 * a1) * (1.0f / 128.0f) + EPS);
                    *(unsigned*)(ocat + (size_t)m * 1024 + 512 + h * 128 + 2 * lane) = cvt_pk_bf16(a0 * inv * g0, a1 * inv * g1);
                }
            }
        }
        if (IN(P_MIXC)) {
            for (int pr = vcu; pr < 256; pr += G) { const int hd = pr >> 5, s = pr & 31;
#pragma unroll 1
                for (int k = 0; k < 2; ++k) { const int qb = k ? s : 63 - s;
                    attn_unit<64, 64, AM_T5_BITMAP>(lds, (const bf16_t*)(R + R_AQ) + hd * 64, 512, (const bf16_t*)(R + R_AK) + hd * 64, 512, (const bf16_t*)(R + R_AV) + hd * 64, 512,
                                                    ocat + hd * 64, 1024, qb * 256, lut5 + hd * 256, (const unsigned*)hb, nullptr); }
            }
        }
        SYNC(P_MIXC);
    } else {
        if (IN(P_MIXA)) {
            for (int u = vcu; u < 1024; u += G) { const int hd = u >> 6, qb = u & 63;
                attn_unit<64, 64, AM_BAND>(lds, (const bf16_t*)(R + R_CQ) + hd * 64, 1024, (const bf16_t*)(R + R_CK) + hd * 64, 1024, (const bf16_t*)(R + R_CV) + hd * 64, 1024,
                                           ocat + hd * 64, 1024, qb * 256, lutb + hd * 640, nullptr, nullptr); }
        }
        SYNC(P_MIXA);
    }
    if (IN(P_WOUT)) {
        pg8::Gemm g{ocat, (const bf16_t*)(ws + W_OUT), S, D, D}; pg8::StaticOrder so; so.init(S, D, G, bx);
        EpiRes<false, false, false, false> E{rb, rb, nullptr, RSP(4 * L + 2), nullptr, nullptr};
        pg8::gemm_phase(lds, g, so, E);
    }
    SYNC(P_WOUT);
    if (IN(P_WQ)) {
        pg8::Gemm g{rb, (const bf16_t*)(ws + W_Q), S, 512, D}; pg8::StaticOrder so; so.init(S, 512, G, bx);
        EpiBf16 E{(bf16_t*)(R + R_QM), 512, RSP(4 * L + 2)};
        pg8::gemm_phase(lds, g, so, E);
        KV_NORM(a.in[MB + 5], G - 8, L == 0 ? WS_KVRAW : WS_KVRAW2);
        if (L == 0) { KV_GEMM(G - 12, W_KV2, WS_KVRAW2);
            SIDE_BEGIN(SLK, G - SLK - 12) CV_GU2Q(20, sf_, ss_); CV_D2(20); SIDE_END() }
        else { SIDE_BEGIN(SLK, G - SLK - 8) CV_GU2Q(41, sf_, ss_); CV_D2(41); SIDE_END() }
    }
    SYNC(P_WQ);
    if (IN(P_MATT)) {
        for (int u = vcu; u < 256; u += G) { const int hd = u >> 6, qb = u & 63;
            attn_unit<128, 128, AM_MEM>(lds, (const bf16_t*)(R + R_QM) + hd * 128, 512, (const bf16_t*)(ws + WS_KMEM) + hd * 128, 512, (const bf16_t*)(ws + WS_VMEM) + hd * 128, 512,
                                        (bf16_t*)(R + R_OM) + hd * 128, 512, qb * 256, nullptr, nullptr, a.in[MB + 4]); }
    }
    SYNC(P_MATT);
    if (IN(P_WO)) {
        pg8::Gemm g{(const bf16_t*)(R + R_OM), (const bf16_t*)(ws + W_O), S, D, 512}; pg8::StaticOrder so; so.init(S, D, G, bx);
        EpiRes<false, false, false, true> E{rb, L == 1 ? hb : rb, hq, RSP(4 * L + 3), qs, RSP(4 * L + 2)};
        pg8::gemm_phase(lds, g, so, E);
    }
    SYNC(P_WO);
    if (IN(P_GU2)) {
        pg8::Gemm g{(const bf16_t*)hq, (const bf16_t*)(ws + W_GU2), S, 2 * FF, D / 2}; pg8::StaticOrder so; so.init(S, 2 * FF, G, bx);
        LAS float* tab = (LAS float*)(lds + pg8::STAGE_BYTES); guq_prep<true>(tab, so, RSP(4 * L + 3), qs, sb2);
        EpiGUq E{act, tab};
        pg8::gemm_phase(lds, g, so, E);
        if (L == 0) { SIDE_BEGIN(SLK, G - SLK) CV_GU1Q(31, sf_, ss_); SIDE_END() }
    }
    SYNC(P_GU2);
    if (IN(P_D2)) {
        pg8::Gemm g{act, (const bf16_t*)(ws + W_D2), S, D, FF}; pg8::StaticOrder so; so.init(S, D, G, bx);
        if (L == 0) { EpiRes<true, false, false, true> E{rb, rb, hq, RSP(4), qs, RSP(3)}; pg8::gemm_phase(lds, g, so, E); }
        else { EpiRes<true, false, true, false> E{hb, a.out, nullptr, nullptr, nullptr, nullptr}; pg8::gemm_phase(lds, g, so, E); }
    }
    SYNC(P_D2);
#undef IN
#undef SYNC
}

__global__ void __launch_bounds__(NTHREADS, 2) mk_fwd(Args a) {
    extern __shared__ __attribute__((aligned(16))) unsigned char lds_raw[];
    LAS unsigned char* lds = (LAS unsigned char*)lds_raw;
    cg::grid_group grid = cg::this_grid();
    const int lo = a.ph_lo, hi = a.ph_hi;
    if (threadIdx.x < 64) ((LAS unsigned*)(lds + MISC_OFF))[threadIdx.x] = 0u;
    __syncthreads();
    const XcdBarrier xbar = xcd_barrier_post((unsigned*)(a.ws + WS_BAR), (volatile LAS unsigned*)(lds + MISC_OFF) + 8);
    run_layer<0>(a, lds, grid, xbar, lo, hi);
    run_layer<1>(a, lds, grid, xbar, lo, hi);
}

extern "C" void kernel_launch(void* const* d_in, const int* in_sizes, int n_in, void* d_out, int out_size, void* d_ws, size_t ws_size, hipStream_t stream) {
    static int grid = 0;
    if (grid == 0) {
        if (n_in != 52 || out_size != S * D || ws_size < WS_END) { fprintf(stderr, "kernel_launch: unexpected shapes n_in %d out %d ws %zu\n", n_in, out_size, ws_size); grid = -1; return; }
        int dev = 0, cus = 0, per_cu = 0;
        (void)hipGetDevice(&dev); (void)hipDeviceGetAttribute(&cus, hipDeviceAttributeMultiprocessorCount, dev);
        (void)hipFuncSetAttribute((const void*)mk_fwd, hipFuncAttributeMaxDynamicSharedMemorySize, LDS_BYTES);
        (void)hipOccupancyMaxActiveBlocksPerMultiprocessor(&per_cu, (const void*)mk_fwd, NTHREADS, LDS_BYTES);
        if (per_cu < 1) { fprintf(stderr, "kernel_launch: occupancy query says %d\n", per_cu); per_cu = 1; }
        grid = cus * 1;
        (void)hipGetLastError();
    }
    if (grid < 0) return;
    Args a{};
    for (int i = 0; i < 52; ++i) a.in[i] = (const float*)d_in[i];
    a.out = (float*)d_out; a.ws = (unsigned char*)d_ws;
    a.ph_lo = 0; a.ph_hi = DBG_LAST;
    void* args[] = {&a};
    hipError_t e = hipLaunchCooperativeKernel((const void*)mk_fwd, dim3(grid), dim3(NTHREADS), args, LDS_BYTES, stream);
    if (e != hipSuccess) fprintf(stderr, "kernel_launch: cooperative launch failed: %s\n", hipGetErrorString(e));
}
```

```cpp
#include <hip/hip_runtime.h>
#include <hip/hip_cooperative_groups.h>
#include <cstdio>
#include <cstdint>
namespace cg = cooperative_groups;

#define LAS __attribute__((address_space(3)))
typedef unsigned short bf16_t;
typedef short bf16x8 __attribute__((ext_vector_type(8)));
typedef short s16x4 __attribute__((ext_vector_type(4)));
typedef float f32x4 __attribute__((ext_vector_type(4)));
typedef float f32x2 __attribute__((ext_vector_type(2)));
typedef float f32x16 __attribute__((ext_vector_type(16)));
typedef unsigned u32x4 __attribute__((ext_vector_type(4)));
typedef unsigned u32x2 __attribute__((ext_vector_type(2)));
typedef int i32x4 __attribute__((ext_vector_type(4)));

constexpr int S = 16384, D = 1024, FF = 2816, NMEM = 256;
constexpr float EPS = 1e-6f;
constexpr float LOG2E = 1.4426950408889634f;
constexpr int NWIN0 = 3840, NWINQ = 3072, NWINI = 768;

constexpr size_t MiB = 1u << 20;
constexpr size_t WS_RS = 4 * MiB;
constexpr size_t WS_RSM = 6 * MiB;
constexpr size_t WS_QS = 6 * MiB + 64 * 1024;
constexpr size_t WS_SB = 6 * MiB + 128 * 1024;
constexpr size_t WS_LUT5 = 640 * 1024;
constexpr size_t WS_LUTB = 656 * 1024;
constexpr size_t WS_MISC = 700 * 1024;
constexpr size_t WS_BAR = 768 * 1024;
constexpr size_t WS_KVRAW = 1 * MiB;
constexpr size_t WS_KVRAW2 = 7 * MiB;
constexpr size_t WS_KMEM = 2 * MiB;
constexpr size_t WS_VMEM = 2 * MiB + 512 * 1024;
constexpr size_t WS_MEMB = 3 * MiB;
constexpr size_t WS_W = 8 * MiB;
constexpr size_t W_GU1 = WS_W, W_D1 = W_GU1 + (size_t)2 * FF * D * 2, W_GU2 = W_D1 + (size_t)D * FF * 2, W_D2 = W_GU2 + (size_t)2 * FF * D * 2;
constexpr size_t W_IN = W_D2 + (size_t)D * FF * 2, W_OUT = W_IN + (size_t)NWIN0 * D * 2, W_Q = W_OUT + (size_t)D * D * 2, W_KV = W_Q + (size_t)512 * D * 2, W_O = W_KV + (size_t)D * D * 2;
constexpr size_t W_END = W_O + (size_t)D * 512 * 2;
constexpr size_t W_KV2 = W_END;
static_assert(W_KV2 + (size_t)D * D * 2 <= 58 * MiB, "w_kv2 slot");
constexpr size_t W_INI = W_IN + 4 * MiB;
constexpr size_t WS_HB = 58 * MiB;
constexpr size_t WS_OCAT = 90 * MiB;
constexpr size_t WS_R = 122 * MiB;
constexpr size_t WS_END = 256 * MiB;
static_assert(W_END <= WS_HB, "weights fit");
constexpr size_t R_ACT = 0;
constexpr size_t R_AQ = 0, R_AK = 16 * MiB, R_AV = 32 * MiB, R_IQ = 48 * MiB, R_BQ = 64 * MiB, R_BK = 80 * MiB, R_BV = 96 * MiB, R_IK = 112 * MiB, R_IW = 114 * MiB;
constexpr size_t R_CQ = 0, R_CK = 32 * MiB, R_CV = 64 * MiB;
constexpr size_t R_QM = 96 * MiB, R_OM = 112 * MiB;
static_assert(WS_R + R_OM + 16 * MiB <= WS_END && WS_R + R_IW + MiB <= WS_END, "region R");

constexpr int LDS_BYTES = 160 * 1024 - 2048;
constexpr int NTHREADS = 512;
constexpr int MISC_OFF = LDS_BYTES - 256;

__device__ __forceinline__ unsigned cvt_pk_bf16(float lo, float hi) { unsigned r; asm("v_cvt_pk_bf16_f32 %0, %1, %2" : "=v"(r) : "v"(lo), "v"(hi)); return r; }
__device__ __forceinline__ unsigned f2bf(float f) { unsigned u = __builtin_bit_cast(unsigned, f); return (u + 0x7fffu + ((u >> 16) & 1u)) >> 16; }
__device__ __forceinline__ float bf2f(unsigned short b) { return __builtin_bit_cast(float, ((unsigned)b) << 16); }
__device__ __forceinline__ float wave_sum(float v) {
#pragma unroll
    for (int o = 1; o < 64; o <<= 1) v += __shfl_xor(v, o);
    return v;
}

__device__ __forceinline__ float sum_xor16(float x) { const unsigned u = __float_as_uint(x); auto r = __builtin_amdgcn_permlane16_swap(u, u, false, false); return __uint_as_float(r[0]) + __uint_as_float(r[1]); }
__device__ __forceinline__ float sum_xor32(float x) { const unsigned u = __float_as_uint(x); auto r = __builtin_amdgcn_permlane32_swap(u, u, false, false); return __uint_as_float(r[0]) + __uint_as_float(r[1]); }

namespace pg8 {
constexpr int BM = 256, BK = 64, HALF = 128, HTB = HALF * BK * 2, STAGE_BYTES = 8 * HTB, NXCD = 8, WGM = 8;
__host__ __device__ __forceinline__ int lds_byte(int r, int c) { const int st = (r >> 4) * 2 + (c >> 5), rr = r & 15, cc = c & 31, ob = rr * 64 + cc * 2; return st * 1024 + (ob ^ (((ob >> 9) & 1) << 5)); }
__host__ __device__ __forceinline__ void stage_rc(int b, int& R, int& C) { const int st = b / 1024, sb = b % 1024, swz = sb ^ (((sb >> 9) & 1) << 5); R = (st >> 1) * 16 + swz / 64; C = (st & 1) * 32 + (swz % 64) / 2; }
struct Unit { int pm, pn, ui; };
struct Gemm { const bf16_t* A; const bf16_t* Bt; int M, N, K; };
struct StaticOrder {
    int nM, nN, nwg, G, c;
    __device__ void init(int M, int N, int G_, int c_) { nM = M / BM; nN = N / BM; nwg = nM * nN; G = G_; c = c_; }
    __device__ bool next(int i, Unit& u) const {
        const long L = (long)i * G + c; if (L >= nwg) return false;
        int wgid = (int)L; { const int q = nwg / NXCD, r = nwg % NXCD, xcd = wgid % NXCD, off = wgid / NXCD; wgid = (xcd < r ? xcd * (q + 1) : r * (q + 1) + (xcd - r) * q) + off; }
        const int nig = WGM * nN, gid = wgid / nig, fm = gid * WGM, gsz = (nM - fm) < WGM ? (nM - fm) : WGM;
        u.pm = fm + ((wgid % nig) % gsz); u.pn = (wgid % nig) / gsz; u.ui = i; return true;
    }
};

template <class Epi>
__device__ __forceinline__ void gemm_phase(LAS unsigned char* lds, const Gemm g, const StaticOrder& S, const Epi& E) {
    int tid = threadIdx.x; asm volatile("" : "+v"(tid));
    const int wid = __builtin_amdgcn_readfirstlane(tid >> 6), lane = tid & 63, wr = wid >> 2, wc = wid & 3, fr = lane & 15, fq = lane >> 4;
    const int K = g.K, nt = K / BK;
    unsigned voffA[2];
#pragma unroll
    for (int i = 0; i < 2; ++i) { int R, C; stage_rc(tid * 16 + i * 8192, R, C); voffA[i] = (unsigned)(R * K + C) * 2u; }
    const size_t kstep = (size_t)(BK * 2);
    const size_t hstep = (size_t)HALF * K * 2;
    const size_t tstep = 2 * hstep;
    const unsigned ldsw = (unsigned)wid * 1024u;
    const int aoff = lds_byte(wr * 64 + fr, fq * 8), boff = lds_byte(wc * 32 + fr, fq * 8);
#define PG8_SA(b, h) (((b) * 2 + (h)) * HTB)
#define PG8_SB(b, h) ((4 + (b) * 2 + (h)) * HTB)
#define PG8_STAGE(bufoff, gbase) do { _Pragma("unroll") for (int _i = 0; _i < 2; ++_i) \
        __builtin_amdgcn_global_load_lds((const unsigned*)((const char*)(gbase) + voffA[_i]), (LAS unsigned*)(lds + (bufoff) + ldsw + _i * 8192), 16, 0, 0); } while (0)
#define PG8_LDA(dst, b, h) do { _Pragma("unroll") for (int m = 0; m < 4; ++m) _Pragma("unroll") for (int k = 0; k < 2; ++k) dst[m][k] = *(const LAS bf16x8*)(lds + PG8_SA(b, h) + aoff + m * 2048 + k * 1024); } while (0)
#define PG8_LDB(dst, b, h) do { _Pragma("unroll") for (int n = 0; n < 2; ++n) _Pragma("unroll") for (int k = 0; k < 2; ++k) dst[n][k] = *(const LAS bf16x8*)(lds + PG8_SB(b, h) + boff + n * 2048 + k * 1024); } while (0)
#define PG8_MMA(ai, bj, At, Bt) do { __builtin_amdgcn_s_setprio(1); _Pragma("unroll") for (int m = 0; m < 4; ++m) _Pragma("unroll") for (int n = 0; n < 2; ++n) _Pragma("unroll") for (int k = 0; k < 2; ++k) { \
        if constexpr (Epi::I8) acc[ai][bj][m][n] = __builtin_amdgcn_mfma_i32_16x16x64_i8(__builtin_bit_cast(i32x4, Bt[n][k]), __builtin_bit_cast(i32x4, At[m][k]), acc[ai][bj][m][n], 0, 0, 0); \
        else acc[ai][bj][m][n] = __builtin_amdgcn_mfma_f32_16x16x32_bf16(Bt[n][k], At[m][k], acc[ai][bj][m][n], 0, 0, 0); } __builtin_amdgcn_s_setprio(0); } while (0)
#define PG8_WAIT_V(n) asm volatile("s_waitcnt vmcnt(" #n ")" ::: "memory")
#define PG8_WAIT_L(n) asm volatile("s_waitcnt lgkmcnt(" #n ")" ::: "memory")
#define PG8_BAR __builtin_amdgcn_s_barrier()
#define PG8_SCHED __builtin_amdgcn_sched_barrier(0)
    Unit cur, nxt; int ui = 0;
    if (!S.next(0, cur)) return;
    using acc_t = typename Epi::acc_t;
    acc_t acc[2][2][4][2];
#pragma unroll
    for (int a = 0; a < 2; ++a)
#pragma unroll
        for (int b = 0; b < 2; ++b)
#pragma unroll
            for (int m = 0; m < 4; ++m)
#pragma unroll
                for (int n = 0; n < 2; ++n) acc[a][b][m][n] = acc_t{};
    bf16x8 At[4][2], B0[2][2], B1[2][2];
    const char* cA = (const char*)g.A + (size_t)cur.pm * tstep; const char* cB = (const char*)g.Bt + (size_t)cur.pn * tstep;
    PG8_STAGE(PG8_SB(0, 0), cB); PG8_STAGE(PG8_SB(0, 1), cB + hstep); PG8_STAGE(PG8_SA(0, 0), cA); PG8_STAGE(PG8_SA(0, 1), cA + hstep);
    if (wr == 1) PG8_BAR;
    PG8_WAIT_V(2); PG8_BAR;
    PG8_STAGE(PG8_SB(1, 0), cB + kstep); PG8_STAGE(PG8_SA(1, 0), cA + kstep); PG8_STAGE(PG8_SB(1, 1), cB + hstep + kstep);
    PG8_WAIT_V(6); PG8_BAR;
    for (;;) {
        const bool has_next = S.next(ui + 1, nxt);
        const char* nA = has_next ? (const char*)g.A + (size_t)nxt.pm * tstep : cA; const char* nB = has_next ? (const char*)g.Bt + (size_t)nxt.pn * tstep : cB;
        for (int t = 0; t < nt; t += 2) {
            const bool last = (t == nt - 2);
            const char* a1 = cA + (size_t)(t + 1) * kstep;
            const char* a2 = last ? nA : cA + (size_t)(t + 2) * kstep; const char* b2 = last ? nB : cB + (size_t)(t + 2) * kstep;
            const char* a3 = a2 + kstep; const char* b3 = b2 + kstep;
            PG8_LDB(B0, 0, 0); PG8_LDB(B1, 0, 1); PG8_SCHED; PG8_LDA(At, 0, 0); PG8_STAGE(PG8_SA(1, 1), a1 + hstep);
            PG8_WAIT_V(8); PG8_WAIT_L(0); PG8_BAR; PG8_MMA(0, 0, At, B0); PG8_MMA(0, 1, At, B1); PG8_BAR; PG8_SCHED;
            PG8_LDA(At, 0, 1); PG8_STAGE(PG8_SB(0, 0), b2); PG8_STAGE(PG8_SB(0, 1), b2 + hstep); PG8_STAGE(PG8_SA(0, 0), a2);
            PG8_WAIT_V(8); PG8_WAIT_L(0); PG8_BAR; PG8_MMA(1, 0, At, B0); PG8_MMA(1, 1, At, B1); PG8_BAR; PG8_SCHED;
            PG8_LDB(B0, 1, 0); PG8_LDB(B1, 1, 1); PG8_SCHED; PG8_LDA(At, 1, 0); PG8_STAGE(PG8_SA(0, 1), a2 + hstep);
            PG8_WAIT_V(8); PG8_WAIT_L(0); PG8_BAR; PG8_MMA(0, 0, At, B0); PG8_MMA(0, 1, At, B1); PG8_BAR; PG8_SCHED;
            PG8_LDA(At, 1, 1); PG8_STAGE(PG8_SB(1, 0), b3); PG8_STAGE(PG8_SB(1, 1), b3 + hstep); PG8_STAGE(PG8_SA(1, 0), a3);
            PG8_WAIT_V(8); PG8_WAIT_L(0); PG8_BAR; PG8_MMA(1, 0, At, B0); PG8_MMA(1, 1, At, B1); PG8_BAR; PG8_SCHED;
        }
        if (wr == 0) PG8_BAR;
        E(acc, cur, wr, wc, fr, fq);
        if (!has_next) break;
#pragma unroll
        for (int a = 0; a < 2; ++a)
#pragma unroll
            for (int b = 0; b < 2; ++b)
#pragma unroll
                for (int m = 0; m < 4; ++m)
#pragma unroll
                    for (int n = 0; n < 2; ++n) acc[a][b][m][n] = acc_t{};
        cur = nxt; cA = nA; cB = nB; ++ui;
        if (wr == 1) PG8_BAR;
    }
    PG8_WAIT_V(0);
    PG8_BAR;
#undef PG8_SA
#undef PG8_SB
#undef PG8_STAGE
#undef PG8_LDA
#undef PG8_LDB
#undef PG8_MMA
#undef PG8_WAIT_V
#undef PG8_WAIT_L
#undef PG8_BAR
#undef PG8_SCHED
}
}
using pg8::Unit;

__device__ __forceinline__ void load_rstd(const float* parts, int row0, int fq, float (&rs)[2][4]) {
    float s[2][4];
#pragma unroll
    for (int ai = 0; ai < 2; ++ai)
#pragma unroll
        for (int m = 0; m < 4; ++m) { const f32x4 a = *(const f32x4*)(parts + (size_t)(row0 + ai * 128 + m * 16) * 16 + 4 * fq);
            s[ai][m] = (a[0] + a[1]) + (a[2] + a[3]); }
#pragma unroll
    for (int ai = 0; ai < 2; ++ai)
#pragma unroll
        for (int m = 0; m < 4; ++m) { float t = sum_xor32(sum_xor16(s[ai][m])); rs[ai][m] = __builtin_amdgcn_rsqf(t * (1.0f / D) + EPS); }
}
struct EpiGU {
    using acc_t = f32x4; static constexpr bool I8 = false;
    bf16_t* act; const float* rowss;
    __device__ __forceinline__ void operator()(const f32x4 (&acc)[2][2][4][2], const Unit& u, int wr, int wc, int fr, int fq) const {
        const int row0 = u.pm * 256 + wr * 64 + fr, col0 = u.pn * 128 + wc * 32 + fq * 8;
        float rs[2][4]; load_rstd(rowss, row0, fq, rs);
#pragma unroll
        for (int ai = 0; ai < 2; ++ai)
#pragma unroll
            for (int m = 0; m < 4; ++m) {
                const float r = rs[ai][m]; float o[8];
#pragma unroll
                for (int bj = 0; bj < 2; ++bj)
#pragma unroll
                    for (int j = 0; j < 4; ++j) { const float gt = acc[ai][bj][m][0][j] * r, up = acc[ai][bj][m][1][j] * r;
                        o[bj * 4 + j] = gt * up * __builtin_amdgcn_rcpf(1.0f + __builtin_amdgcn_exp2f(-gt * LOG2E)); }
                u32x4 w; w.x = cvt_pk_bf16(o[0], o[1]); w.y = cvt_pk_bf16(o[2], o[3]); w.z = cvt_pk_bf16(o[4], o[5]); w.w = cvt_pk_bf16(o[6], o[7]);
                *(u32x4*)(act + (size_t)(row0 + ai * 128 + m * 16) * FF + col0) = w;
            }
    }
};
struct EpiGUq {
    using acc_t = i32x4; static constexpr bool I8 = true;
    bf16_t* act; const LAS float* tab;
    __device__ __forceinline__ void operator()(const i32x4 (&acc)[2][2][4][2], const Unit& u, int wr, int wc, int fr, int fq) const {
        const int row0 = u.pm * 256 + wr * 64 + fr, col0 = u.pn * 128 + wc * 32 + fq * 8;
        const LAS float* R = tab + u.ui * 512;
        f32x2 c1[2][2], c2[2][2];
#pragma unroll
        for (int bj = 0; bj < 2; ++bj) {
            const f32x4 x1 = *(const LAS f32x4*)(R + 256 + bj * 128 + wc * 32 + 4 * fq), x2 = *(const LAS f32x4*)(R + 256 + bj * 128 + wc * 32 + 16 + 4 * fq);
#pragma unroll
            for (int jp = 0; jp < 2; ++jp) { c1[bj][jp] = f32x2{x1[2 * jp], x1[2 * jp + 1]}; c2[bj][jp] = f32x2{x2[2 * jp], x2[2 * jp + 1]}; }
        }
#pragma unroll
        for (int ai = 0; ai < 2; ++ai)
#pragma unroll
            for (int m = 0; m < 4; ++m) {
                const int row = row0 + ai * 128 + m * 16; const float r = R[wr * 64 + fr + ai * 128 + m * 16]; const f32x2 r1{r, r}, r2{r * r, r * r}; u32x4 w;
#pragma unroll
                for (int bj = 0; bj < 2; ++bj)
#pragma unroll
                    for (int jp = 0; jp < 2; ++jp) {
                        const f32x2 ag{(float)acc[ai][bj][m][0][2 * jp], (float)acc[ai][bj][m][0][2 * jp + 1]}, au{(float)acc[ai][bj][m][1][2 * jp], (float)acc[ai][bj][m][1][2 * jp + 1]};
                        const f32x2 x = (ag * c1[bj][jp]) * r1, p = (ag * au) * c2[bj][jp];
                        f32x2 d{__builtin_amdgcn_exp2f(x[0]), __builtin_amdgcn_exp2f(x[1])}; d = d + f32x2{1.0f, 1.0f};
                        const f32x2 o = p * (f32x2{__builtin_amdgcn_rcpf(d[0]), __builtin_amdgcn_rcpf(d[1])} * r2);
                        w[bj * 2 + jp] = cvt_pk_bf16(o[0], o[1]);
                    }
                *(u32x4*)(act + (size_t)row * FF + col0) = w;
            }
    }
};
template <bool GU, class SO>
__device__ __forceinline__ void guq_prep(LAS float* tab, const SO& so, const float* rowss, const float* qs, const float* sb) {
    int tid = threadIdx.x; asm volatile("" : "+v"(tid));
    pg8::Unit u;
    for (int i = 0; so.next(i, u); ++i) {
        LAS float* R = tab + i * 512;
        if (tid < 256) {
            const int row = u.pm * 256 + tid; const f32x4* p = (const f32x4*)(rowss + (size_t)row * 16);
            const f32x4 s = (p[0] + p[1]) + (p[2] + p[3]);
            R[tid] = __builtin_amdgcn_rsqf(((s[0] + s[1]) + (s[2] + s[3])) * (1.0f / D) + EPS) * qs[row];
        } else {
            const int c = tid - 256;
            if constexpr (GU) { if (!(c & 16)) { const float sg = sb[u.pn * 256 + c], su = sb[u.pn * 256 + c + 16]; R[256 + c] = sg * -LOG2E; R[256 + c + 16] = sg * su; } }
            else R[256 + c] = sb[u.pn * 256 + c];
        }
    }
    __syncthreads();
}
constexpr float QRANGE = 4.5f;
__device__ __forceinline__ unsigned q8_pack4(f32x4 v, float q) {
    int a0 = (int)__builtin_rintf(v[0] * q), a1 = (int)__builtin_rintf(v[1] * q), a2 = (int)__builtin_rintf(v[2] * q), a3 = (int)__builtin_rintf(v[3] * q);
    a0 = min(max(a0, -127), 127); a1 = min(max(a1, -127), 127); a2 = min(max(a2, -127), 127); a3 = min(max(a3, -127), 127);
    return (unsigned)(a0 & 0xff) | ((unsigned)(a1 & 0xff) << 8) | ((unsigned)(a2 & 0xff) << 16) | ((unsigned)a3 << 24);
}
__device__ __forceinline__ f32x4 bf2_lo4(unsigned a, unsigned b) { return f32x4{__uint_as_float(a << 16), __uint_as_float(a & 0xffff0000u), __uint_as_float(b << 16), __uint_as_float(b & 0xffff0000u)}; }
template <bool HALF, bool BF, bool OF, bool Q> struct EpiRes {
    using acc_t = f32x4; static constexpr bool I8 = false;
    static constexpr float scale = HALF ? 0.5f : 1.0f;
    const void* base; void* out; signed char* hq; float* rowss_out; float* qs; const float* prev_parts;
    __device__ __forceinline__ void operator()(const f32x4 (&acc)[2][2][4][2], const Unit& u, int wr, int wc, int fr, int fq) const {
        const int row0 = u.pm * 256 + wr * 64 + fr, col0 = u.pn * 256 + wc * 32 + fq * 8;
        float rp[2][4];
#pragma unroll
        for (int ai = 0; ai < 2; ++ai) {
            u32x4 bw[2][4][2];
            if constexpr (!BF) {
#pragma unroll
                for (int m = 0; m < 4; ++m)
#pragma unroll
                    for (int bj = 0; bj < 2; ++bj) bw[ai][m][bj] = *(const u32x4*)((const bf16_t*)base + (size_t)(row0 + ai * 128 + m * 16) * D + col0 + bj * 128);
            }
            if constexpr (Q) { if (ai == 0) load_rstd(prev_parts, row0, fq, rp); }
#pragma unroll
            for (int m = 0; m < 4; ++m) {
                const int row = row0 + ai * 128 + m * 16; float ss = 0.f;
                float q = 0.f; if constexpr (Q) q = (127.0f / QRANGE) * rp[ai][m];
#pragma unroll
                for (int bj = 0; bj < 2; ++bj) {
                    const size_t off = (size_t)row * D + col0 + bj * 128;
                    f32x4 b0, b1;
                    if constexpr (BF) { b0 = *(const f32x4*)((const float*)base + off); b1 = *(const f32x4*)((const float*)base + off + 4); }
                    else { b0 = bf2_lo4(bw[ai][m][bj].x, bw[ai][m][bj].y); b1 = bf2_lo4(bw[ai][m][bj].z, bw[ai][m][bj].w); }
                    const f32x4 h0 = b0 + acc[ai][bj][m][0] * scale, h1 = b1 + acc[ai][bj][m][1] * scale;
                    if constexpr (OF) { *(f32x4*)((float*)out + off) = h0; *(f32x4*)((float*)out + off + 4) = h1; }
                    else { u32x4 w; w.x = cvt_pk_bf16(h0[0], h0[1]); w.y = cvt_pk_bf16(h0[2], h0[3]); w.z = cvt_pk_bf16(h1[0], h1[1]); w.w = cvt_pk_bf16(h1[2], h1[3]); *(u32x4*)((bf16_t*)out + off) = w; }
                    if constexpr (Q) { u32x2 w; w.x = q8_pack4(h0, q); w.y = q8_pack4(h1, q); *(u32x2*)(hq + off) = w; }
                    ss += (h0[0] * h0[0] + h0[1] * h0[1]) + (h0[2] * h0[2] + h0[3] * h0[3]) + (h1[0] * h1[0] + h1[1] * h1[1]) + (h1[2] * h1[2] + h1[3] * h1[3]);
                }
                if constexpr (Q) { if (u.pn == 0 && wc == 0 && fq == 0) qs[row] = 1.0f / q; }
                if (rowss_out) { ss = sum_xor32(sum_xor16(ss)); if (fq == 0) rowss_out[(size_t)row * 16 + u.pn * 4 + wc] = ss; }
            }
        }
    }
};

struct EpiBf16 {
    using acc_t = f32x4; static constexpr bool I8 = false;
    bf16_t* out; int ldc; const float* rowss;
    __device__ __forceinline__ void operator()(const f32x4 (&acc)[2][2][4][2], const Unit& u, int wr, int wc, int fr, int fq) const {
        const int row0 = u.pm * 256 + wr * 64 + fr, col0 = u.pn * 256 + wc * 32 + fq * 8;
        float rs[2][4]; load_rstd(rowss, row0, fq, rs);
#pragma unroll
        for (int ai = 0; ai < 2; ++ai)
#pragma unroll
            for (int m = 0; m < 4; ++m)
#pragma unroll
                for (int bj = 0; bj < 2; ++bj) { const f32x4 v0 = acc[ai][bj][m][0] * rs[ai][m], v1 = acc[ai][bj][m][1] * rs[ai][m];
                    u32x4 w; w.x = cvt_pk_bf16(v0[0], v0[1]); w.y = cvt_pk_bf16(v0[2], v0[3]); w.z = cvt_pk_bf16(v1[0], v1[1]); w.w = cvt_pk_bf16(v1[2], v1[3]);
                    *(u32x4*)(out + (size_t)(row0 + ai * 128 + m * 16) * ldc + col0 + bj * 128) = w; }
    }
};
struct EpiF32 {
    using acc_t = f32x4; static constexpr bool I8 = false;
    float* out; int ldc; const float* rowss;
    __device__ __forceinline__ void operator()(const f32x4 (&acc)[2][2][4][2], const Unit& u, int wr, int wc, int fr, int fq) const {
        const int row0 = u.pm * 256 + wr * 64 + fr, col0 = u.pn * 256 + wc * 32 + fq * 8;
        float rs[2][4]; load_rstd(rowss, row0, fq, rs);
#pragma unroll
        for (int ai = 0; ai < 2; ++ai)
#pragma unroll
            for (int m = 0; m < 4; ++m)
#pragma unroll
                for (int bj = 0; bj < 2; ++bj) { float* p = out + (size_t)(row0 + ai * 128 + m * 16) * ldc + col0 + bj * 128;
                    *(f32x4*)p = acc[ai][bj][m][0] * rs[ai][m]; *(f32x4*)(p + 4) = acc[ai][bj][m][1] * rs[ai][m]; }
    }
};
constexpr float C2 = 0.125f * LOG2E;
template <bool Q> struct WinAcc { using t = f32x4; }; template <> struct WinAcc<true> { using t = i32x4; };
template <int V> struct EpiWin {
    static constexpr bool I8 = (V != 2); using acc_t = typename WinAcc<I8>::t;
    unsigned char* R; const float* rowss; const LAS float* tab; const float* g0; const float* g1; const float* g2; const float* g3;
    template <bool NORM>
    __device__ __forceinline__ void emit(const acc_t (&acc)[2][2][4][2], int row0, int fq, const float (&rs)[2][4], const f32x4 (&cs)[2][2], bf16_t* out, int pitch, const float* gain, float post) const {
        f32x4 gv[2][2];
#pragma unroll
        for (int bj = 0; bj < 2; ++bj)
#pragma unroll
            for (int n = 0; n < 2; ++n) gv[bj][n] = NORM ? *(const f32x4*)(gain + 32 * bj + 8 * fq + 4 * n) * post : (f32x4){1.f, 1.f, 1.f, 1.f};
#pragma unroll
        for (int ai = 0; ai < 2; ++ai)
#pragma unroll
            for (int m = 0; m < 4; ++m) {
                f32x4 v[2][2]; float ss = 0.f;
#pragma unroll
                for (int bj = 0; bj < 2; ++bj)
#pragma unroll
                    for (int n = 0; n < 2; ++n) {
                        if constexpr (I8) v[bj][n] = __builtin_convertvector(acc[ai][bj][m][n], f32x4) * (cs[bj][n] * rs[ai][m]); else v[bj][n] = acc[ai][bj][m][n] * rs[ai][m];
                        const f32x4 t = v[bj][n]; ss += (t[0] * t[0] + t[1] * t[1]) + (t[2] * t[2] + t[3] * t[3]); }
                float inv = 1.f;
                if (NORM) { ss = sum_xor32(sum_xor16(ss)); inv = __builtin_amdgcn_rsqf(ss * (1.0f / 64.0f) + EPS); }
#pragma unroll
                for (int bj = 0; bj < 2; ++bj) { const f32x4 a = v[bj][0] * gv[bj][0] * inv, b = v[bj][1] * gv[bj][1] * inv;
                    u32x4 w; w.x = cvt_pk_bf16(a[0], a[1]); w.y = cvt_pk_bf16(a[2], a[3]); w.z = cvt_pk_bf16(b[0], b[1]); w.w = cvt_pk_bf16(b[2], b[3]);
                    *(u32x4*)(out + (size_t)(row0 + ai * 128 + m * 16) * pitch + 32 * bj + 8 * fq) = w; }
            }
    }
    __device__ __forceinline__ void operator()(const acc_t (&acc)[2][2][4][2], const Unit& u, int wr, int wc, int fr, int fq) const {
        const int row0 = u.pm * 256 + wr * 64 + fr; const int g = 4 * u.pn + wc;
        float rs[2][4]; f32x4 cs[2][2];
        if constexpr (I8) {
            const LAS float* T = tab + u.ui * 512;
#pragma unroll
            for (int ai = 0; ai < 2; ++ai)
#pragma unroll
                for (int m = 0; m < 4; ++m) rs[ai][m] = T[wr * 64 + fr + ai * 128 + m * 16];
#pragma unroll
            for (int bj = 0; bj < 2; ++bj)
#pragma unroll
                for (int n = 0; n < 2; ++n) cs[bj][n] = *(const LAS f32x4*)(T + 256 + bj * 128 + wc * 32 + n * 16 + 4 * fq);
        } else {
            load_rstd(rowss, row0, fq, rs);
#pragma unroll
            for (int bj = 0; bj < 2; ++bj)
#pragma unroll
                for (int n = 0; n < 2; ++n) cs[bj][n] = (f32x4){1.f, 1.f, 1.f, 1.f};
        }
        if constexpr (V == 1) {
            if (g < 16) emit<true>(acc, row0, fq, rs, cs, (bf16_t*)(R + R_CQ) + 64 * g, 1024, g0, C2);
            else if (g < 32) emit<true>(acc, row0, fq, rs, cs, (bf16_t*)(R + R_CK) + 64 * (g - 16), 1024, g1, 1.0f);
            else emit<false>(acc, row0, fq, rs, cs, (bf16_t*)(R + R_CV) + 64 * (g - 32), 1024, nullptr, 1.0f);
        } else if constexpr (V == 0) {
            if (g < 8) emit<true>(acc, row0, fq, rs, cs, (bf16_t*)(R + R_AQ) + 64 * g, 512, g0, C2);
            else if (g < 16) emit<true>(acc, row0, fq, rs, cs, (bf16_t*)(R + R_AK) + 64 * (g - 8), 512, g1, 1.0f);
            else if (g < 24) emit<false>(acc, row0, fq, rs, cs, (bf16_t*)(R + R_AV) + 64 * (g - 16), 512, nullptr, 1.0f);
            else if (g < 32) emit<true>(acc, row0, fq, rs, cs, (bf16_t*)(R + R_BQ) + 64 * (g - 24), 512, g2, C2);
            else if (g < 40) emit<true>(acc, row0, fq, rs, cs, (bf16_t*)(R + R_BK) + 64 * (g - 32), 512, g3, 1.0f);
            else emit<false>(acc, row0, fq, rs, cs, (bf16_t*)(R + R_BV) + 64 * (g - 40), 512, nullptr, 1.0f);
        } else {
            if (g < 8) emit<false>(acc, row0, fq, rs, cs, (bf16_t*)(R + R_IQ) + 64 * g, 512, nullptr, 1.0f);
            else if (g == 8) emit<true>(acc, row0, fq, rs, cs, (bf16_t*)(R + R_IK), 64, g0, 1.0f);
            else if (g == 9) {
                if (fq == 0) {
                    float* iw = (float*)(R + R_IW);
#pragma unroll
                    for (int ai = 0; ai < 2; ++ai)
#pragma unroll
                        for (int m = 0; m < 4; ++m) { float* p = iw + (size_t)(row0 + ai * 128 + m * 16) * 8;
                            *(f32x4*)p = acc[ai][0][m][0] * rs[ai][m]; *(f32x4*)(p + 4) = acc[ai][0][m][1] * rs[ai][m]; }
                }
            }
        }
    }
};

enum { MAP_P8 = 0, MAP_GU = 1, MAP_H64_L0 = 2, MAP_H64_L1 = 3, MAP_H64Q_L0 = 4, MAP_H64I_L0 = 5 };
__device__ __forceinline__ int conv_src(int mode, int Tg, int& which) {
    const int pn = Tg >> 8, T = Tg & 255, bj = T >> 7, wc = (T >> 5) & 3, n = (T >> 4) & 1, fq = (T >> 2) & 3, j = T & 3;
    which = 0;
    if (mode == MAP_P8) return 256 * pn + 128 * bj + 32 * wc + 8 * fq + 4 * n + j;
    if (mode == MAP_GU) { which = n; return 128 * pn + 32 * wc + 8 * fq + 4 * bj + j; }
    const int Lu = 64 * wc + 32 * bj + 8 * fq + 4 * n + j;
    if (mode == MAP_H64_L1) return 256 * pn + Lu;
    const int g = 4 * pn + (Lu >> 6), d = Lu & 63;
    if (mode == MAP_H64Q_L0) return g < 24 ? g * 64 + d : 2120 + (g - 24) * 64 + d;
    if (mode == MAP_H64I_L0) { if (g < 8) return 1536 + g * 64 + d; if (g == 8) return 2048 + d; if (g == 9) return d < 8 ? 2112 + d : -1; return -1; }
    if (g < 32) return g * 64 + d;
    if (g == 32) return 2048 + d;
    if (g == 33) return d < 8 ? 2112 + d : -1;
    if (g < 58) return 2120 + (g - 34) * 64 + d;
    return -1;
}
__device__ __forceinline__ void conv_load(const float* src0, const float* src1, const float* gain, int Nsrc, int Nrows, int mode, int item, int lane, f32x4 (&v)[8]) {
    const int nT = Nrows / 32, kb = item / nT, tb = item % nT, k0 = 64 * kb, T0 = 32 * tb;
    int which; const int col = conv_src(mode, T0 + 4 * (lane & 7), which);
    const size_t sel = which ? (size_t)(src1 - src0) : (size_t)0;
    const float* src = src0 + sel; const int kr = lane >> 3;
#pragma unroll
    for (int i = 0; i < 8; ++i) { const int kk = 8 * i + kr;
        f32x4 t = (f32x4){0.f, 0.f, 0.f, 0.f}; if (col >= 0) { t = *(const f32x4*)(src + (size_t)(k0 + kk) * Nsrc + col); if (gain) t = t * gain[k0 + kk]; }
        v[i] = t; }
}
__device__ __forceinline__ void conv_store(bf16_t* dst, int K, int Nrows, int item, LAS float* scr, int lane, const f32x4 (&v)[8]) {
    const int nT = Nrows / 32, kb = item / nT, tb = item % nT, k0 = 64 * kb, T0 = 32 * tb;
    const int tq = lane & 7, kr = lane >> 3;
#pragma unroll
    for (int i = 0; i < 8; ++i) { LAS float* p = scr + (8 * i + kr) * 33 + 4 * tq; p[0] = v[i][0]; p[1] = v[i][1]; p[2] = v[i][2]; p[3] = v[i][3]; }
    asm volatile("s_waitcnt lgkmcnt(0)" ::: "memory");
    const int c = lane & 7;
#pragma unroll
    for (int j = 0; j < 4; ++j) { const int n = (lane >> 3) + 8 * j; const LAS float* s = scr + (8 * c) * 33 + n;
        u32x4 o; o.x = cvt_pk_bf16(s[0 * 33], s[1 * 33]); o.y = cvt_pk_bf16(s[2 * 33], s[3 * 33]); o.z = cvt_pk_bf16(s[4 * 33], s[5 * 33]); o.w = cvt_pk_bf16(s[6 * 33], s[7 * 33]);
        *(u32x4*)(dst + (size_t)(T0 + n) * K + k0 + 8 * c) = o; }
    asm volatile("s_waitcnt lgkmcnt(0)" ::: "memory");
}
template <int MODE>
__device__ __forceinline__ void convq_item(const float* wg, const float* wu, int Nsrc, const float* gain, signed char* dst, float* sb, int item, LAS float* scr, LAS float* xch, int wave, int lane) {
    const int T0 = 32 * item, tq = lane & 7, kr = lane >> 3;
    int which; const int col = conv_src(MODE, T0 + 4 * tq, which);
    const size_t sel = which ? (size_t)(wu - wg) : (size_t)0; const float* src = wg + sel;
    f32x4 v[2][8]; f32x4 mx = (f32x4){0.f, 0.f, 0.f, 0.f};
#pragma unroll
    for (int kbi = 0; kbi < 2; ++kbi)
#pragma unroll
        for (int i = 0; i < 8; ++i) { const int k = 64 * (2 * wave + kbi) + 8 * i + kr; const f32x4 t = *(const f32x4*)(src + (size_t)k * Nsrc + col) * gain[k]; v[kbi][i] = t;
            mx[0] = fmaxf(mx[0], fabsf(t[0])); mx[1] = fmaxf(mx[1], fabsf(t[1])); mx[2] = fmaxf(mx[2], fabsf(t[2])); mx[3] = fmaxf(mx[3], fabsf(t[3])); }
#pragma unroll
    for (int j = 0; j < 4; ++j) { float m_ = mx[j]; m_ = fmaxf(m_, __shfl_xor(m_, 8)); m_ = fmaxf(m_, __shfl_xor(m_, 16)); m_ = fmaxf(m_, __shfl_xor(m_, 32)); mx[j] = m_; }
    if (kr == 0) { LAS float* p = xch + wave * 32 + 4 * tq; p[0] = mx[0]; p[1] = mx[1]; p[2] = mx[2]; p[3] = mx[3]; }
    asm volatile("s_waitcnt lgkmcnt(0)" ::: "memory"); __syncthreads();
    f32x4 inv;
#pragma unroll
    for (int j = 0; j < 4; ++j) { float c = 0.f;
#pragma unroll
        for (int w = 0; w < 8; ++w) c = fmaxf(c, xch[w * 32 + 4 * tq + j]);
        inv[j] = c > 0.f ? 127.0f / c : 0.f; if (wave == 0 && kr == 0) sb[T0 + 4 * tq + j] = c > 0.f ? c * (1.0f / 127.0f) : 1.0f; }
    const int c8 = lane & 7;
#pragma unroll
    for (int kbi = 0; kbi < 2; ++kbi) {
#pragma unroll
        for (int i = 0; i < 8; ++i) { LAS float* p = scr + (8 * i + kr) * 33 + 4 * tq; const f32x4 t = v[kbi][i] * inv; p[0] = __builtin_rintf(t[0]); p[1] = __builtin_rintf(t[1]); p[2] = __builtin_rintf(t[2]); p[3] = __builtin_rintf(t[3]); }
        asm volatile("s_waitcnt lgkmcnt(0)" ::: "memory");
#pragma unroll
        for (int jj = 0; jj < 4; ++jj) { const int n = (lane >> 3) + 8 * jj; const LAS float* s = scr + (8 * c8) * 33 + n;
            const unsigned lo = (unsigned)((int)s[0 * 33] & 0xff) | ((unsigned)((int)s[1 * 33] & 0xff) << 8) | ((unsigned)((int)s[2 * 33] & 0xff) << 16) | ((unsigned)(int)s[3 * 33] << 24);
            const unsigned hi = (unsigned)((int)s[4 * 33] & 0xff) | ((unsigned)((int)s[5 * 33] & 0xff) << 8) | ((unsigned)((int)s[6 * 33] & 0xff) << 16) | ((unsigned)(int)s[7 * 33] << 24);
            *(u32x2*)(dst + (size_t)(T0 + n) * D + 64 * (2 * wave + kbi) + 8 * c8) = (u32x2){lo, hi}; }
        asm volatile("s_waitcnt lgkmcnt(0)" ::: "memory");
    }
    __syncthreads();
}
__device__ __forceinline__ void row_load(const float* xrow, int lane, f32x4 (&v)[4]) {
    const f32x4* xr = (const f32x4*)xrow + lane;
#pragma unroll
    for (int j = 0; j < 4; ++j) v[j] = xr[64 * j];
}
__device__ __forceinline__ void row_to_q8(const f32x4 (&v)[4], signed char* qrow, float* dq, float* ssp, int lane) {
    float s = 0.f;
#pragma unroll
    for (int j = 0; j < 4; ++j) s += (v[j].x * v[j].x + v[j].y * v[j].y) + (v[j].z * v[j].z + v[j].w * v[j].w);
    s = wave_sum(s);
    const float q = (127.0f / QRANGE) * __builtin_amdgcn_rsqf(s * (1.0f / D) + EPS);
    unsigned* o4 = (unsigned*)qrow + lane;
#pragma unroll
    for (int j = 0; j < 4; ++j) o4[64 * j] = q8_pack4(v[j], q);
    if (lane < 16) ssp[lane] = lane == 0 ? s : 0.f;
    if (lane == 0) *dq = 1.0f / q;
}
__device__ __forceinline__ void row_to_bf16(const float* xrow, bf16_t* orow, float* ssp, int lane) {
    const f32x4* xr = (const f32x4*)xrow + lane; f32x4 v[4]; float s = 0.f;
#pragma unroll
    for (int j = 0; j < 4; ++j) { v[j] = xr[64 * j]; s += (v[j].x * v[j].x + v[j].y * v[j].y) + (v[j].z * v[j].z + v[j].w * v[j].w); }
    s = wave_sum(s);
    u32x2* o8 = (u32x2*)orow + lane;
#pragma unroll
    for (int j = 0; j < 4; ++j) { u32x2 w; w.x = cvt_pk_bf16(v[j].x, v[j].y); w.y = cvt_pk_bf16(v[j].z, v[j].w); o8[64 * j] = w; }
    if (lane < 16) ssp[lane] = lane == 0 ? s : 0.f;
}

__device__ __forceinline__ void glds16(const void* gsrc, unsigned lds_dst) { unsigned keep;
    asm volatile("s_mov_b32 %0, m0\n\ts_mov_b32 m0, %2\n\ts_nop 0\n\tglobal_load_lds_dwordx4 %1, off\n\ts_mov_b32 m0, %0" : "=&s"(keep) : "v"(gsrc), "s"(lds_dst) : "memory"); }
#define WAITV_BAR(N) do { asm volatile("s_waitcnt vmcnt(" #N ") lgkmcnt(0)" ::: "memory"); __builtin_amdgcn_s_barrier(); asm volatile("" ::: "memory"); } while (0)
#define DMA_SYNC() do { asm volatile("s_waitcnt vmcnt(0) lgkmcnt(0)" ::: "memory"); __syncthreads(); } while (0)
__device__ __forceinline__ int crow(int r, int hi) { return (r & 3) + 8 * (r >> 2) + 4 * hi; }
enum { AM_T5 = 0, AM_T5_BITMAP = 1, AM_BAND = 2, AM_MEM = 3 };
constexpr int ATT_NS = 4;
constexpr int ATT_LUT_OFF = 135168, ATT_WSF_OFF = ATT_LUT_OFF + 2560;
typedef short v4i16_t __attribute__((ext_vector_type(4)));
__device__ __forceinline__ s16x4 vtr(const LAS unsigned char* p) { return __builtin_bit_cast(s16x4, __builtin_amdgcn_ds_read_tr16_b64_v4i16((LAS v4i16_t*)p)); }
__device__ __forceinline__ void glds16x2(const void* g0, unsigned d0, const void* g1, unsigned d1) { unsigned keep;
    asm volatile("s_mov_b32 %0, m0\n\ts_mov_b32 m0, %3\n\ts_nop 0\n\tglobal_load_lds_dwordx4 %1, off\n\ts_mov_b32 m0, %4\n\ts_nop 0\n\tglobal_load_lds_dwordx4 %2, off\n\ts_mov_b32 m0, %0"
                 : "=&s"(keep) : "v"(g0), "v"(g1), "s"(d0), "s"(d1) : "memory"); }
__device__ __forceinline__ void glds16x3(const void* g0, unsigned d0, const void* g1, unsigned d1, const void* g2, unsigned d2) { unsigned keep;
    asm volatile("s_mov_b32 %0, m0\n\ts_mov_b32 m0, %4\n\ts_nop 0\n\tglobal_load_lds_dwordx4 %1, off\n\ts_mov_b32 m0, %5\n\ts_nop 0\n\tglobal_load_lds_dwordx4 %2, off\n\t"
                 "s_mov_b32 m0, %6\n\ts_nop 0\n\tglobal_load_lds_dwordx4 %3, off\n\ts_mov_b32 m0, %0"
                 : "=&s"(keep) : "v"(g0), "v"(g1), "v"(g2), "s"(d0), "s"(d1), "s"(d2) : "memory"); }
__device__ __forceinline__ void glds16x2_4(const void* g0, unsigned d0, const void* g1, unsigned d1, const void* g2, unsigned d2) { unsigned keep;
    asm volatile("s_mov_b32 %0, m0\n\ts_mov_b32 m0, %4\n\ts_nop 0\n\tglobal_load_lds_dwordx4 %1, off\n\ts_mov_b32 m0, %5\n\ts_nop 0\n\tglobal_load_lds_dwordx4 %2, off\n\t"
                 "s_mov_b32 m0, %6\n\ts_nop 0\n\tglobal_load_lds_dword %3, off\n\ts_mov_b32 m0, %0"
                 : "=&s"(keep) : "v"(g0), "v"(g1), "v"(g2), "s"(d0), "s"(d1), "s"(d2) : "memory"); }
__device__ __forceinline__ void glds4(const void* gsrc, unsigned lds_dst) { unsigned keep;
    asm volatile("s_mov_b32 %0, m0\n\ts_mov_b32 m0, %2\n\ts_nop 0\n\tglobal_load_lds_dword %1, off\n\ts_mov_b32 m0, %0" : "=&s"(keep) : "v"(gsrc), "s"(lds_dst) : "memory"); }
template <int N> __device__ __forceinline__ void waitv_bar() { asm volatile("s_waitcnt vmcnt(%0) lgkmcnt(0)" :: "n"(N) : "memory"); __builtin_amdgcn_s_barrier(); asm volatile("" ::: "memory"); }

template <int DQK, int DV, int MODE>
__device__ __forceinline__ void attn_unit(LAS unsigned char* lds, const bf16_t* __restrict__ Q, int qpitch, const bf16_t* __restrict__ K, int kpitch, const bf16_t* __restrict__ V, int vpitch,
                                          bf16_t* O, int opitch, int q0, const float* lut, const unsigned* bitmapT, const float* qgain) {
    constexpr int KB = 64 * DQK * 2, VB = 64 * DV * 2, NKP = DQK / 64, NVP = DV / 64;
    constexpr int BMB = (MODE == AM_T5_BITMAP) ? 2048 : 0, SLOT = KB + VB + BMB;
    constexpr int ND = (NKP + NVP) + (MODE == AM_T5_BITMAP ? 1 : 0);
    constexpr int NKS = DQK / 16, NDB = DV / 32;
    constexpr int EOFF = (MODE == AM_BAND) ? 575 : 191, LUTN = (MODE == AM_BAND) ? 640 : 256;
    static_assert(ATT_NS * SLOT <= ATT_LUT_OFF && 8 * 32 * DV * 2 <= ATT_LUT_OFF, "attention LDS map");
    int tid = threadIdx.x; asm volatile("" : "+v"(tid));
    const int lane = tid & 63, r32 = lane & 31, hi = lane >> 5; const int wid = __builtin_amdgcn_readfirstlane(tid >> 6);
    const int qrow = q0 + 32 * wid + r32;
    const int cqw = (q0 + 32 * wid) >> 6;
    int tlo, thi, wlo, whi;
    if (MODE == AM_MEM) { tlo = 0; thi = 3; wlo = 0; whi = 3; }
    else if (MODE == AM_BAND) { tlo = (q0 >> 6) - 8; if (tlo < 0) tlo = 0; thi = (q0 + 255) >> 6; wlo = cqw - 8; if (wlo < 0) wlo = 0; whi = cqw; }
    else { tlo = 0; thi = (q0 + 255) >> 6; wlo = 0; whi = cqw; }
    LAS float* lutl = (LAS float*)(lds + ATT_LUT_OFF);
    LAS float* wsf = (LAS float*)(lds + ATT_WSF_OFF) + wid * 64;
    const unsigned ldsb = (unsigned)(uintptr_t)lds;
#define ATT_KSRC(t, p_) (K + (size_t)((t) * 64 + lane) * kpitch + (wid + 8 * (p_)) * 8)
#define ATT_KDST(p_) ((unsigned)__builtin_amdgcn_readfirstlane((int)(sb_ + (wid + 8 * (p_)) * 1024)))
#define ATT_VSRC(t, p_) (V + (size_t)((t) * 64 + 16 * ((wid + 8 * (p_)) & 3) + (lane >> 2)) * vpitch + 32 * ((wid + 8 * (p_)) >> 2) + (lane & 3) * 8)
#define ATT_VDST(p_) ((unsigned)__builtin_amdgcn_readfirstlane((int)(sb_ + KB + (wid + 8 * (p_)) * 1024)))
#define ATT_DMA(t) do { const unsigned sb_ = (unsigned)__builtin_amdgcn_readfirstlane((int)(ldsb + (((t) - tlo) & 3) * SLOT)); \
        if (MODE == AM_T5_BITMAP && NKP == 1 && NVP == 1) glds16x2_4(ATT_KSRC(t, 0), ATT_KDST(0), ATT_VSRC(t, 0), ATT_VDST(0), bitmapT + (size_t)(2 * (t) + hi) * S + qrow, (unsigned)__builtin_amdgcn_readfirstlane((int)(sb_ + KB + VB + wid * 256))); \
        else if (MODE != AM_T5_BITMAP && NKP == 1 && NVP == 1) glds16x2(ATT_KSRC(t, 0), ATT_KDST(0), ATT_VSRC(t, 0), ATT_VDST(0)); \
        else if (MODE != AM_T5_BITMAP && NKP == 1 && NVP == 2) glds16x3(ATT_KSRC(t, 0), ATT_KDST(0), ATT_VSRC(t, 0), ATT_VDST(0), ATT_VSRC(t, 1), ATT_VDST(1)); \
        else { \
        _Pragma("unroll") for (int p_ = 0; p_ < NKP; ++p_) glds16(ATT_KSRC(t, p_), ATT_KDST(p_)); \
        _Pragma("unroll") for (int p_ = 0; p_ < NVP; ++p_) glds16(ATT_VSRC(t, p_), ATT_VDST(p_)); \
        if (MODE == AM_T5_BITMAP) glds4(bitmapT + (size_t)(2 * (t) + hi) * S + qrow, (unsigned)__builtin_amdgcn_readfirstlane((int)(sb_ + KB + VB + wid * 256))); } \
    } while (0)
    ATT_DMA(tlo); if (tlo + 1 <= thi) ATT_DMA(tlo + 1); if (tlo + 2 <= thi) ATT_DMA(tlo + 2);
    bf16x8 qr[NKS];
    if (MODE == AM_MEM) {
        float qf[NKS][8]; float ss = 0.f;
#pragma unroll
        for (int d0 = 0; d0 < NKS; ++d0) { const bf16x8 t = *(const bf16x8*)(Q + (size_t)qrow * qpitch + d0 * 16 + hi * 8);
#pragma unroll
            for (int j = 0; j < 8; ++j) { qf[d0][j] = bf2f((unsigned short)t[j]); ss += qf[d0][j] * qf[d0][j]; } }
        ss += __shfl_xor(ss, 32);
        const float inv = (1.0f / sqrtf(ss * (1.0f / DQK) + EPS)) * (LOG2E / sqrtf((float)DQK));
#pragma unroll
        for (int d0 = 0; d0 < NKS; ++d0) { const f32x4 ga = *(const f32x4*)(qgain + d0 * 16 + hi * 8), gb = *(const f32x4*)(qgain + d0 * 16 + hi * 8 + 4);
            u32x4 w; w.x = cvt_pk_bf16(qf[d0][0] * inv * ga[0], qf[d0][1] * inv * ga[1]); w.y = cvt_pk_bf16(qf[d0][2] * inv * ga[2], qf[d0][3] * inv * ga[3]);
            w.z = cvt_pk_bf16(qf[d0][4] * inv * gb[0], qf[d0][5] * inv * gb[1]); w.w = cvt_pk_bf16(qf[d0][6] * inv * gb[2], qf[d0][7] * inv * gb[3]);
            qr[d0] = __builtin_bit_cast(bf16x8, w); }
    } else {
#pragma unroll
        for (int d0 = 0; d0 < NKS; ++d0) qr[d0] = *(const bf16x8*)(Q + (size_t)qrow * qpitch + d0 * 16 + hi * 8);
    }
    if (MODE != AM_MEM) { for (int i = tid; i < LUTN; i += NTHREADS) lutl[i] = lut[i]; }
#pragma unroll
    for (int d0 = 0; d0 < NKS; ++d0) asm volatile("" : "+v"(qr[d0]));
    asm volatile("s_waitcnt vmcnt(0)" ::: "memory");
    f32x16 o[NDB];
#pragma unroll
    for (int d = 0; d < NDB; ++d) o[d] = f32x16{};
    float l_reg = 0.f;
    const int qoff = (32 * wid + r32 + q0) & 63;
    const int vb0 = ((lane >> 4) & 1) * 32 + (lane & 3) * 8 + (4 * hi + ((lane & 15) >> 2)) * 64;
    constexpr int NQK = 2 * NKS, CH = 32 / NQK;
    constexpr bool PIPE = (MODE != AM_MEM);
    f32x16 c0 = f32x16{}, c1 = f32x16{};
#define ATT_KFRAG(kb_, i) (*(const LAS bf16x8*)((kb_) + (2 * ((i) >> 1) + hi) * 1024 + (32 * ((i) & 1) + r32) * 16))
#define ATT_QK1(kb_, i, n0, n1) do { if ((i) == 0) n0 = __builtin_amdgcn_mfma_f32_32x32x16_bf16(ATT_KFRAG(kb_, i), qr[0], f32x16{}, 0, 0, 0); \
                                     else if ((i) == 1) n1 = __builtin_amdgcn_mfma_f32_32x32x16_bf16(ATT_KFRAG(kb_, i), qr[0], f32x16{}, 0, 0, 0); \
                                     else if (((i) & 1) == 0) n0 = __builtin_amdgcn_mfma_f32_32x32x16_bf16(ATT_KFRAG(kb_, i), qr[(i) >> 1], n0, 0, 0, 0); \
                                     else n1 = __builtin_amdgcn_mfma_f32_32x32x16_bf16(ATT_KFRAG(kb_, i), qr[(i) >> 1], n1, 0, 0, 0); } while (0)
#define ATT_SMB4(cv, b, bwv, P) asm volatile( \
        "v_exp_f32 %0, %7\n\tv_exp_f32 %1, %8\n\tv_exp_f32 %2, %9\n\tv_exp_f32 %3, %10\n\t" \
        "v_bfe_i32 %5, %11, %12, 1\n\tv_bfe_i32 %6, %11, %13, 1\n\tv_and_b32 %0, %0, %5\n\tv_and_b32 %1, %1, %6\n\t" \
        "v_bfe_i32 %5, %11, %14, 1\n\tv_bfe_i32 %6, %11, %15, 1\n\tv_and_b32 %2, %2, %5\n\tv_and_b32 %3, %3, %6\n\t" \
        "v_add_f32 %4, %4, %0\n\tv_add_f32 %4, %4, %1\n\tv_add_f32 %4, %4, %2\n\tv_add_f32 %4, %4, %3" \
        : "=&v"(pe[P]), "=&v"(pe[(P) + 1]), "=&v"(pe[(P) + 2]), "=&v"(pe[(P) + 3]), "+v"(sacc), "=&v"(tm0_), "=&v"(tm1_) \
        : "v"(cv[b]), "v"(cv[(b) + 1]), "v"(cv[(b) + 2]), "v"(cv[(b) + 3]), "v"(bwv), "n"(2 * (b)), "n"(2 * (b) + 1), "n"(2 * (b) + 2), "n"(2 * (b) + 3))
#define ATT_SMX4(cv, b, P) asm volatile( \
        "v_exp_f32 %0, %5\n\tv_exp_f32 %1, %6\n\tv_exp_f32 %2, %7\n\tv_exp_f32 %3, %8\n\t" \
        "v_add_f32 %4, %4, %0\n\tv_add_f32 %4, %4, %1\n\tv_add_f32 %4, %4, %2\n\tv_add_f32 %4, %4, %3" \
        : "=&v"(pe[P]), "=&v"(pe[(P) + 1]), "=&v"(pe[(P) + 2]), "=&v"(pe[(P) + 3]), "+v"(sacc) \
        : "v"(cv[b]), "v"(cv[(b) + 1]), "v"(cv[(b) + 2]), "v"(cv[(b) + 3]))
#define ATT_SM1(i) do { if (MODE == AM_T5_BITMAP) { float tm0_, tm1_; if ((i) < 4) ATT_SMB4(c0, 4 * (i), bw0, 4 * (i)); else ATT_SMB4(c1, 4 * ((i) - 4), bw1, 16 + 4 * ((i) - 4)); } \
    else if (MODE != AM_MEM) { if ((i) < 4) ATT_SMX4(c0, 4 * (i), 4 * (i)); else ATT_SMX4(c1, 4 * ((i) - 4), 16 + 4 * ((i) - 4)); } else \
    _Pragma("unroll") for (int v_ = CH * (i); v_ < CH * (i) + CH; ++v_) { \
        if (v_ < 16) { float e_ = __builtin_amdgcn_exp2f(c0[v_]); if (MODE == AM_T5_BITMAP) e_ = __uint_as_float(__float_as_uint(e_) & (unsigned)__builtin_amdgcn_sbfe((int)bw0, (v_ & 3) + 8 * (v_ >> 2), 1)); asm volatile("" : "+v"(e_)); c0[v_] = e_; sacc += e_; } \
        else { const int u_ = v_ - 16; float e_ = __builtin_amdgcn_exp2f(c1[u_]); if (MODE == AM_T5_BITMAP) e_ = __uint_as_float(__float_as_uint(e_) & (unsigned)__builtin_amdgcn_sbfe((int)bw1, (u_ & 3) + 8 * (u_ >> 2), 1)); asm volatile("" : "+v"(e_)); c1[u_] = e_; sacc += e_; } } \
        asm volatile("" : "+v"(sacc)); } while (0)
    if (tlo + 2 <= thi) waitv_bar<2 * ND>(); else if (tlo + 1 <= thi) waitv_bar<ND>(); else waitv_bar<0>();
    if (PIPE) {   const LAS unsigned char* kb = lds;
#pragma unroll
        for (int i = 0; i < NQK; ++i) ATT_QK1(kb, i, c0, c1);
        asm volatile("s_nop 7\n\ts_nop 7\n\ts_nop 3" : "+v"(c0), "+v"(c1));
    }
    for (int t = tlo; t <= thi; ++t) {
        const bool has_next = PIPE && (t + 1 <= thi);
        const bool nxt_act = has_next && (t + 1 >= wlo) && (t + 1 <= whi);
        if (!PIPE) { if (t > tlo) { if (t + 2 <= thi) waitv_bar<2 * ND>(); else if (t + 1 <= thi) waitv_bar<ND>(); else waitv_bar<0>(); } }
        else if (has_next) { if (t + 2 <= thi) waitv_bar<ND>(); else waitv_bar<0>(); }
        if (!PIPE && t + 3 <= thi) ATT_DMA(t + 3);
        const LAS unsigned char* kcur = lds + ((t - tlo) & 3) * SLOT; const LAS unsigned char* vbuf = kcur + KB;
        const LAS unsigned char* knxt = lds + ((t + 1 - tlo) & 3) * SLOT;
        f32x16 n0, n1;
        if (!PIPE) {
            bf16x8 kq[4];
#pragma unroll
            for (int i = 0; i < 4; ++i) kq[i] = ATT_KFRAG(kcur, i);
#pragma unroll
            for (int i = 0; i < NQK; ++i) {
                if (i == 0) c0 = __builtin_amdgcn_mfma_f32_32x32x16_bf16(kq[0], qr[0], f32x16{}, 0, 0, 0);
                else if (i == 1) c1 = __builtin_amdgcn_mfma_f32_32x32x16_bf16(kq[1], qr[0], f32x16{}, 0, 0, 0);
                else if ((i & 1) == 0) c0 = __builtin_amdgcn_mfma_f32_32x32x16_bf16(kq[i & 3], qr[i >> 1], c0, 0, 0, 0);
                else c1 = __builtin_amdgcn_mfma_f32_32x32x16_bf16(kq[i & 3], qr[i >> 1], c1, 0, 0, 0);
                if (i + 4 < NQK) kq[i & 3] = ATT_KFRAG(kcur, i + 4);
            }
        }
        const bool act = (t >= wlo && t <= whi);
        constexpr int NPV = NDB * 4;
        float pe[32]; s16x4 vlo[4], vhi[4];
#define ATT_VLD(j) do { vlo[(j) & 3] = vtr(vbuf + vb0 + ((j) >> 2) * 4096 + ((j) & 3) * 1024); vhi[(j) & 3] = vtr(vbuf + vb0 + ((j) >> 2) * 4096 + ((j) & 3) * 1024 + 512); } while (0)
        if (act) {
            unsigned bw0 = 0, bw1 = 0;
            if (MODE == AM_T5_BITMAP) { const LAS unsigned* bw = (const LAS unsigned*)(vbuf + VB + wid * 256); bw0 = bw[r32] >> (4 * hi); bw1 = bw[32 + r32] >> (4 * hi); }
            if (MODE != AM_MEM) {
                const int dt = cqw - t;
                if (dt <= (MODE == AM_BAND ? 4 : 2)) {
                    const LAS float* lp = lutl + (EOFF - 64 * dt - qoff + 4 * hi);
#pragma unroll
                    for (int r = 0; r < 16; ++r) { c0[r] += lp[(r & 3) + 8 * (r >> 2)]; c1[r] += lp[32 + (r & 3) + 8 * (r >> 2)]; }
                }
            }
            float sacc = 0.f;
            bf16x8 kf[4];
            if (nxt_act) {
#pragma unroll
                for (int i = 0; i < 4; ++i) kf[i] = ATT_KFRAG(knxt, i);
                __builtin_amdgcn_sched_barrier(0);
#pragma unroll
                for (int i = 0; i < NQK; ++i) {
                    ATT_SM1(i);
                    __builtin_amdgcn_sched_barrier(0);
                    if (i == 0) n0 = __builtin_amdgcn_mfma_f32_32x32x16_bf16(kf[0], qr[0], f32x16{}, 0, 0, 0);
                    else if (i == 1) n1 = __builtin_amdgcn_mfma_f32_32x32x16_bf16(kf[1], qr[0], f32x16{}, 0, 0, 0);
                    else if ((i & 1) == 0) n0 = __builtin_amdgcn_mfma_f32_32x32x16_bf16(kf[i & 3], qr[i >> 1], n0, 0, 0, 0);
                    else n1 = __builtin_amdgcn_mfma_f32_32x32x16_bf16(kf[i & 3], qr[i >> 1], n1, 0, 0, 0);
                    if (i + 4 < NQK) kf[i & 3] = ATT_KFRAG(knxt, i + 4);
                    else ATT_VLD(i + 4 - NQK);
                    __builtin_amdgcn_sched_barrier(0);
                }
            } else {
#pragma unroll
                for (int j = 0; j < 4; ++j) ATT_VLD(j);
#pragma unroll
                for (int i = 0; i < NQK; ++i) ATT_SM1(i);
            }
            l_reg += sacc;
        } else if (nxt_act) {
#pragma unroll
            for (int i = 0; i < NQK; ++i) ATT_QK1(knxt, i, n0, n1);
        }
        if (PIPE && t + 3 <= thi) ATT_DMA(t + 3);
        if (act) {
            bf16x8 pw[4];
#pragma unroll
            for (int ks = 0; ks < 2; ++ks) {
                u32x4 a, c;
#define ATT_P0(v) (MODE != AM_MEM ? pe[v] : c0[v])
#define ATT_P1(v) (MODE != AM_MEM ? pe[16 + (v)] : c1[v])
                a.x = cvt_pk_bf16(ATT_P0(8 * ks + 0), ATT_P0(8 * ks + 1)); a.y = cvt_pk_bf16(ATT_P0(8 * ks + 2), ATT_P0(8 * ks + 3)); a.z = cvt_pk_bf16(ATT_P0(8 * ks + 4), ATT_P0(8 * ks + 5)); a.w = cvt_pk_bf16(ATT_P0(8 * ks + 6), ATT_P0(8 * ks + 7));
                c.x = cvt_pk_bf16(ATT_P1(8 * ks + 0), ATT_P1(8 * ks + 1)); c.y = cvt_pk_bf16(ATT_P1(8 * ks + 2), ATT_P1(8 * ks + 3)); c.z = cvt_pk_bf16(ATT_P1(8 * ks + 4), ATT_P1(8 * ks + 5)); c.w = cvt_pk_bf16(ATT_P1(8 * ks + 6), ATT_P1(8 * ks + 7));
#undef ATT_P0
#undef ATT_P1
                pw[ks] = __builtin_bit_cast(bf16x8, a); pw[2 + ks] = __builtin_bit_cast(bf16x8, c);
            }
            __builtin_amdgcn_sched_barrier(0);
#pragma unroll
            for (int j = 0; j < NPV; ++j) {
                const bf16x8 vf = (bf16x8){vlo[j & 3][0], vlo[j & 3][1], vlo[j & 3][2], vlo[j & 3][3], vhi[j & 3][0], vhi[j & 3][1], vhi[j & 3][2], vhi[j & 3][3]};
                o[j >> 2] = __builtin_amdgcn_mfma_f32_32x32x16_bf16(pw[j & 3], vf, o[j >> 2], 0, 0, 0);
                if (j + 4 < NPV) ATT_VLD(j + 4);
                __builtin_amdgcn_sched_barrier(0);
            }
        }
#undef ATT_VLD
        if (PIPE) { c0 = n0; c1 = n1; }
    }
#undef ATT_KFRAG
#undef ATT_QK1
#undef ATT_SM1
#undef ATT_SMB4
#undef ATT_SMX4
#undef ATT_DMA
#undef ATT_KSRC
#undef ATT_KDST
#undef ATT_VSRC
#undef ATT_VDST
    waitv_bar<0>();
    l_reg += __shfl_xor(l_reg, 32);
    if (hi == 0) wsf[r32] = l_reg;
    asm volatile("s_waitcnt lgkmcnt(0)" ::: "memory");
    float rli[16];
#pragma unroll
    for (int r = 0; r < 16; ++r) rli[r] = 1.0f / wsf[crow(r, hi)];
    LAS bf16_t* stg = (LAS bf16_t*)lds + wid * (32 * DV);
#pragma unroll
    for (int r = 0; r < 16; ++r) { const int orow = crow(r, hi);
#pragma unroll
        for (int db = 0; db < NDB; ++db) stg[orow * DV + db * 32 + r32] = (bf16_t)f2bf(o[db][r] * rli[r]); }
    asm volatile("s_waitcnt lgkmcnt(0)" ::: "memory");
    constexpr int LPR = DV / 8, RPI = 64 / LPR;
#pragma unroll
    for (int i = 0; i < 32 / RPI; ++i) { const int row = i * RPI + lane / LPR, ch = lane % LPR;
        const u32x4 v = *(const LAS u32x4*)(stg + row * DV + ch * 8);
        *(u32x4*)(O + (size_t)(q0 + 32 * wid + row) * opitch + ch * 8) = v; }
    DMA_SYNC();
}

constexpr int SEL_NB = 1024, SEL_TIECAP = 128, SEL_POOLCAP = 2048;
__device__ __forceinline__ void sel_pool_put(unsigned* pool, LAS unsigned* pcnt, float s, unsigned kq) {
    const unsigned g = __hip_atomic_fetch_add(pcnt, 1u, __ATOMIC_RELAXED, __HIP_MEMORY_SCOPE_WORKGROUP);
    if (g < (unsigned)SEL_POOLCAP) { __hip_atomic_store(pool + 2 * g, __float_as_uint(s), __ATOMIC_RELAXED, __HIP_MEMORY_SCOPE_AGENT); __hip_atomic_store(pool + 2 * g + 1, kq, __ATOMIC_RELAXED, __HIP_MEMORY_SCOPE_AGENT); }
}
__device__ __forceinline__ unsigned sel_pool_get(unsigned* pool, unsigned i) { return __hip_atomic_load(pool + i, __ATOMIC_RELAXED, __HIP_MEMORY_SCOPE_AGENT); }
constexpr int SEL_HIST_OFF = 0, SEL_TIE_OFF = 65536, SEL_IK_OFF = 98304, SEL_QI_OFF = 131072;
__device__ __forceinline__ void dsa_select_unit(LAS unsigned char* lds, int u, const bf16_t* __restrict__ iq, const bf16_t* __restrict__ ik, const float* __restrict__ iw, const float* __restrict__ ikgain, unsigned* bitmapT, unsigned* pool) {
    int tid = threadIdx.x; asm volatile("" : "+v"(tid));
    const int lane = tid & 63, r32 = lane & 31, hc = lane >> 5; const int wid = __builtin_amdgcn_readfirstlane(tid >> 6);
    const int cq = u >> 1, NT = cq + 1, qbase = 32 * u;
    if (cq <= 3) {
        for (int i = tid; i < 2 * NT * 32; i += NTHREADS) bitmapT[(size_t)(i >> 5) * S + qbase + (i & 31)] = 0xffffffffu;
        return;
    }
    LAS unsigned* hist = (LAS unsigned*)(lds + SEL_HIST_OFF);
    LAS unsigned* tie = (LAS unsigned*)(lds + SEL_TIE_OFF);
    LAS float* qinfo = (LAS float*)(lds + SEL_QI_OFF);
    const int rr = r32, half_r = (rr >> 2) & 1, reggrp = rr >> 4, head_r = ((rr >> 3) & 1) * 4 + (rr & 3), qi_r = 2 * half_r + reggrp;
    const int qrow_r = qbase + 4 * wid + qi_r;
    bf16x8 af[4]; float nrm = 0.f; float afv[4][8];
#pragma unroll
    for (int ks = 0; ks < 4; ++ks) { const bf16x8 t = *(const bf16x8*)(iq + (size_t)qrow_r * 512 + head_r * 64 + ks * 16 + hc * 8);
#pragma unroll
        for (int j = 0; j < 8; ++j) { afv[ks][j] = bf2f((unsigned short)t[j]); nrm += afv[ks][j] * afv[ks][j]; } }
    nrm += __shfl_xor(nrm, 32); nrm = sqrtf(nrm);
    float kmax = fabsf(ikgain[lane]);
#pragma unroll
    for (int o_ = 1; o_ < 64; o_ <<= 1) kmax = fmaxf(kmax, __shfl_xor(kmax, o_));
    kmax *= 8.0f * 1.02f;
    const float bound = nrm * kmax, rs_ = bound > 0.f ? 1.0f / bound : 0.f;
#pragma unroll
    for (int ks = 0; ks < 4; ++ks) { u32x4 w; w.x = cvt_pk_bf16(afv[ks][0] * rs_, afv[ks][1] * rs_); w.y = cvt_pk_bf16(afv[ks][2] * rs_, afv[ks][3] * rs_);
        w.z = cvt_pk_bf16(afv[ks][4] * rs_, afv[ks][5] * rs_); w.w = cvt_pk_bf16(afv[ks][6] * rs_, afv[ks][7] * rs_);
        af[ks] = __builtin_bit_cast(bf16x8, w); }
    LAS float* wtab = qinfo + 256;
    { const float wp = iw[(size_t)qrow_r * 8 + head_r] * bound;
      float cp = fmaxf(wp, 0.f), cm = fmaxf(-wp, 0.f);
      cp += __shfl_xor(cp, 1); cp += __shfl_xor(cp, 2); cp += __shfl_xor(cp, 8);
      cm += __shfl_xor(cm, 1); cm += __shfl_xor(cm, 2); cm += __shfl_xor(cm, 8);
      if (hc == 0) { const int ql = 4 * wid + qi_r; wtab[ql * 8 + head_r] = wp;
          if (head_r == 0) { const float lo_ = -cm, rng_ = fmaxf(cp + cm, 1e-20f); qinfo[ql * 8 + 0] = lo_; qinfo[ql * 8 + 1] = ((float)SEL_NB * (1.0f - 4e-6f)) / rng_; qinfo[ql * 8 + 4] = 0.f; } } }
    for (int i = tid; i < 32 * 512 / 4; i += NTHREADS) ((LAS u32x4*)hist)[i] = (u32x4){0u, 0u, 0u, 0u};
    LAS unsigned* pcnt = (LAS unsigned*)(qinfo + 512);
    if (tid == 0) *pcnt = 0u;
    DMA_SYNC();
    const int ql0 = 4 * wid + 2 * hc, ql1 = ql0 + 1;
    float wv[16];
#pragma unroll
    for (int i = 0; i < 16; ++i) wv[i] = wtab[(ql0 + (i >> 3)) * 8 + (i & 7)];
    float lo0 = qinfo[ql0 * 8 + 0], inv0 = qinfo[ql0 * 8 + 1], lo1 = qinfo[ql1 * 8 + 0], inv1 = qinfo[ql1 * 8 + 1];
#pragma unroll
    for (int i = 0; i < 16; ++i) asm volatile("" : "+v"(wv[i]));
#pragma unroll
    for (int ks = 0; ks < 4; ++ks) asm volatile("" : "+v"(af[ks]));
    lo0 = -lo0 * inv0 + 1e-3f; lo1 = -lo1 * inv1 + 1e-3f;
    asm volatile("" : "+v"(lo0), "+v"(inv0), "+v"(lo1), "+v"(inv1));
    const unsigned ikdst = (unsigned)__builtin_amdgcn_readfirstlane((int)((unsigned)(uintptr_t)lds + SEL_IK_OFF + wid * 1024));
#define SEL_DMA(t) glds16(ik + (size_t)((t) * 64 + lane) * 64 + wid * 8, (unsigned)__builtin_amdgcn_readfirstlane((int)(ikdst + (((t) & 3) * 8192))))
#define SEL_RELU(x) __builtin_amdgcn_fmed3f((x), 0.f, 1.0f)
#define SEL_FMAC(acc, a, b) do { float b_ = (b); asm volatile("v_fmac_f32 %0, %1, %2" : "+v"(acc) : "v"(a), "v"(b_)); } while (0)
#define SEL_FRAG(kb_, i) (*(const LAS bf16x8*)((kb_) + (2 * ((i) >> 1) + hc) * 1024 + (32 * ((i) & 1) + r32) * 16))
#define SEL_REDUCE1(A0, A1, i) do { float t0_, t1_; asm volatile( \
        "v_max_f32_e64 %4, %7, %7 clamp\n\tv_max_f32_e64 %5, %8, %8 clamp\n\tv_fmac_f32 %0, %6, %4\n\tv_fmac_f32 %1, %11, %5\n\t" \
        "v_max_f32_e64 %4, %9, %9 clamp\n\tv_max_f32_e64 %5, %10, %10 clamp\n\tv_fmac_f32 %2, %6, %4\n\tv_fmac_f32 %3, %11, %5" \
        : "+v"(sc[0][0]), "+v"(sc[0][1]), "+v"(sc[1][0]), "+v"(sc[1][1]), "=&v"(t0_), "=&v"(t1_) \
        : "v"(wv[i]), "v"(A0[i]), "v"(A0[8 + (i)]), "v"(A1[i]), "v"(A1[8 + (i)]), "v"(wv[8 + (i)])); } while (0)
#define SEL_LOOP_BEGIN() SEL_DMA(0); if (NT > 1) SEL_DMA(1); if (NT > 2) SEL_DMA(2); \
    WAITV_BAR(0); \
    f32x16 a0 = f32x16{}, a1 = f32x16{}, n0 = f32x16{}, n1 = f32x16{}; \
    { const LAS unsigned char* kb0_ = lds + SEL_IK_OFF; bf16x8 bfr_[8]; \
      _Pragma("unroll") for (int i = 0; i < 8; ++i) bfr_[i] = SEL_FRAG(kb0_, i); \
      _Pragma("unroll") for (int i = 0; i < 8; ++i) { if ((i & 1) == 0) a0 = __builtin_amdgcn_mfma_f32_32x32x16_bf16(af[i >> 1], bfr_[i], a0, 0, 0, 0); else a1 = __builtin_amdgcn_mfma_f32_32x32x16_bf16(af[i >> 1], bfr_[i], a1, 0, 0, 0); } } \
    asm volatile("s_nop 7\n\ts_nop 7\n\ts_nop 3" : "+v"(a0), "+v"(a1));
#define SEL_STEP(A0, A1, N0, N1, t, BODY, FIRST) do { \
        const bool has_next = (t) + 1 < NT; \
        if (FIRST) WAITV_BAR(0);                                      \
        float sc[2][2] = {{0.f, 0.f}, {0.f, 0.f}}; \
        if (has_next) { const LAS unsigned char* kbn_ = lds + SEL_IK_OFF + (((t) + 1) & 3) * 8192; bf16x8 bfr_[8]; \
            _Pragma("unroll") for (int i = 0; i < 8; ++i) bfr_[i] = SEL_FRAG(kbn_, i); \
            __builtin_amdgcn_sched_barrier(0); \
            _Pragma("unroll") for (int i = 0; i < 8; ++i) { \
                if (i == 0) N0 = __builtin_amdgcn_mfma_f32_32x32x16_bf16(af[0], bfr_[0], f32x16{}, 0, 0, 0); \
                else if (i == 1) N1 = __builtin_amdgcn_mfma_f32_32x32x16_bf16(af[0], bfr_[1], f32x16{}, 0, 0, 0); \
                else if ((i & 1) == 0) N0 = __builtin_amdgcn_mfma_f32_32x32x16_bf16(af[i >> 1], bfr_[i], N0, 0, 0, 0); else N1 = __builtin_amdgcn_mfma_f32_32x32x16_bf16(af[i >> 1], bfr_[i], N1, 0, 0, 0); \
                SEL_REDUCE1(A0, A1, i); __builtin_amdgcn_sched_barrier(0); } \
        } else { _Pragma("unroll") for (int i = 0; i < 8; ++i) SEL_REDUCE1(A0, A1, i); } \
        if (FIRST) { if ((t) + 3 < NT) SEL_DMA((t) + 3); if ((t) + 4 < NT) SEL_DMA((t) + 4); }     \
        BODY(t) } while (0)
#define SEL_LOOP(BODY) for (int t = 0; t < NT; t += 2) { SEL_STEP(a0, a1, n0, n1, t, BODY, true); if (t + 1 < NT) SEL_STEP(n0, n1, a0, a1, t + 1, BODY, false); }
#define SEL_F(s, nlo_, inv_) ({ float f_; asm("v_fma_f32 %0, %1, %2, %3" : "=v"(f_) : "v"(s), "v"(inv_), "v"(nlo_)); f_; })
    LAS unsigned* hrow = hist + (ql0 >> 1) * SEL_NB;
#define SEL_BODY1(t) _Pragma("unroll") for (int sub = 0; sub < 2; ++sub) { \
            const unsigned b0 = (unsigned)(int)SEL_F(sc[sub][0], lo0, inv0) & (unsigned)(SEL_NB - 1), b1 = (unsigned)(int)SEL_F(sc[sub][1], lo1, inv1) & (unsigned)(SEL_NB - 1); \
            __hip_atomic_fetch_add(hrow + b0, 1u, __ATOMIC_RELAXED, __HIP_MEMORY_SCOPE_WORKGROUP); \
            __hip_atomic_fetch_add(hrow + b1, 65536u, __ATOMIC_RELAXED, __HIP_MEMORY_SCOPE_WORKGROUP); }
    { SEL_LOOP_BEGIN() SEL_LOOP(SEL_BODY1) }
#undef SEL_BODY1
    DMA_SYNC();
    for (int qi = 0; qi < 4; ++qi) {
        const int ql = 4 * wid + qi;
        unsigned hw[16];
        { const LAS u32x4* hp = (const LAS u32x4*)(hist + (ql >> 1) * SEL_NB + 16 * lane); const int sh = 16 * (ql & 1);
#pragma unroll
          for (int j = 0; j < 4; ++j) { const u32x4 h4 = hp[j]; hw[4 * j + 0] = (h4.x >> sh) & 0xffffu; hw[4 * j + 1] = (h4.y >> sh) & 0xffffu; hw[4 * j + 2] = (h4.z >> sh) & 0xffffu; hw[4 * j + 3] = (h4.w >> sh) & 0xffffu; } }
        unsigned ls = 0;
#pragma unroll
        for (int j = 0; j < 16; ++j) ls += hw[j];
        unsigned suf = ls;
#pragma unroll
        for (int d = 1; d < 64; d <<= 1) { const unsigned t_ = __shfl_down(suf, d); if (lane + d < 64) suf += t_; }
        const unsigned excl = suf - ls;
        if (excl < 256u && suf >= 256u) {
            unsigned c = excl; int bstar = -1; unsigned cgt = 0;
#pragma unroll
            for (int bb = 15; bb >= 0; --bb) { const unsigned cnt = hw[bb];
                if (bstar < 0) { if (c + cnt >= 256u) { bstar = 16 * lane + bb; cgt = c; } else c += cnt; } }
            qinfo[ql * 8 + 2] = __int_as_float(bstar); qinfo[ql * 8 + 3] = __uint_as_float(cgt);
        }
    }
    DMA_SYNC();
    const int bs0 = __float_as_int(qinfo[ql0 * 8 + 2]), bs1 = __float_as_int(qinfo[ql1 * 8 + 2]);
    LAS unsigned* bm = hist;
    LAS unsigned* tcnt0 = (LAS unsigned*)(qinfo + ql0 * 8 + 4); LAS unsigned* tcnt1 = (LAS unsigned*)(qinfo + ql1 * 8 + 4);
    const float fl0 = (float)bs0, fh0 = (float)(bs0 + 1), fl1 = (float)bs1, fh1 = (float)(bs1 + 1);
#define SEL_BODY2(t) _Pragma("unroll") for (int sub = 0; sub < 2; ++sub) { \
            const float s0 = sc[sub][0], s1 = sc[sub][1]; \
            const float f0 = SEL_F(s0, lo0, inv0), f1 = SEL_F(s1, lo1, inv1); \
            const unsigned long long m0 = __ballot(f0 >= fh0), m1 = __ballot(f1 >= fh1); \
            if (r32 == 0) { bm[(2 * (t) + sub) * 32 + ql0] = hc ? (unsigned)(m0 >> 32) : (unsigned)m0; bm[(2 * (t) + sub) * 32 + ql1] = hc ? (unsigned)(m1 >> 32) : (unsigned)m1; } \
            const unsigned key = (unsigned)((t) * 64 + sub * 32 + r32); \
            const bool t0_ = (f0 >= fl0) && !(f0 >= fh0), t1_ = (f1 >= fl1) && !(f1 >= fh1); \
            if (__ballot(t0_ || t1_) != 0ull) {                  \
                if (t0_) { const unsigned slot = __hip_atomic_fetch_add(tcnt0, 1u, __ATOMIC_RELAXED, __HIP_MEMORY_SCOPE_WORKGROUP); \
                    if (slot < SEL_TIECAP) { tie[(ql0 * SEL_TIECAP + slot) * 2] = __float_as_uint(s0); tie[(ql0 * SEL_TIECAP + slot) * 2 + 1] = key; } \
                    else sel_pool_put(pool, pcnt, s0, key | ((unsigned)ql0 << 16)); } \
                if (t1_) { const unsigned slot = __hip_atomic_fetch_add(tcnt1, 1u, __ATOMIC_RELAXED, __HIP_MEMORY_SCOPE_WORKGROUP); \
                    if (slot < SEL_TIECAP) { tie[(ql1 * SEL_TIECAP + slot) * 2] = __float_as_uint(s1); tie[(ql1 * SEL_TIECAP + slot) * 2 + 1] = key; } \
                    else sel_pool_put(pool, pcnt, s1, key | ((unsigned)ql1 << 16)); } } }
    { SEL_LOOP_BEGIN() SEL_LOOP(SEL_BODY2) }
#undef SEL_BODY2
    DMA_SYNC();
#undef SEL_STEP
#undef SEL_LOOP
#undef SEL_F
#undef SEL_LOOP_BEGIN
#undef SEL_DMA
#undef SEL_FRAG
#undef SEL_REDUCE1
#undef SEL_RELU
#undef SEL_FMAC
    const unsigned pn = min(*pcnt, (unsigned)SEL_POOLCAP);
    LAS unsigned* pl = (LAS unsigned*)(lds + SEL_IK_OFF);
    if (pn) { for (unsigned i = tid; i < 2 * pn; i += NTHREADS) pl[i] = sel_pool_get(pool, i); DMA_SYNC(); }
    for (int qi = 0; qi < 4; ++qi) {
        const int ql = 4 * wid + qi;
        const unsigned tot = *(LAS unsigned*)(qinfo + ql * 8 + 4);
        const unsigned n = min(tot, (unsigned)SEL_TIECAP);
        const unsigned need = 256u - __float_as_uint(qinfo[ql * 8 + 3]);
        const LAS unsigned* tl = tie + ql * SEL_TIECAP * 2;
        if (tot <= (unsigned)SEL_TIECAP) {
            for (unsigned i0 = 0; i0 < n; i0 += 64) {
                const unsigned i = i0 + lane; const bool act = i < n;
                const float si = act ? __uint_as_float(tl[2 * i]) : 0.f; const unsigned ki = act ? tl[2 * i + 1] : 0u;
                unsigned rank = 0;
                for (unsigned j = 0; j < n; ++j) { const float sj = __uint_as_float(tl[2 * j]); const unsigned kj = tl[2 * j + 1]; rank += (sj > si || (sj == si && kj < ki)) ? 1u : 0u; }
                if (act && rank < need) __hip_atomic_fetch_or(bm + (ki >> 5) * 32 + ql, 1u << (ki & 31u), __ATOMIC_RELAXED, __HIP_MEMORY_SCOPE_WORKGROUP);
            }
        } else {
            const unsigned nt = n + pn;
#define SEL_ENT(i, valid, us, kr) do { unsigned sb_, kq_; if ((i) < n) { sb_ = tl[2 * (i)]; kq_ = tl[2 * (i) + 1] | ((unsigned)ql << 16); } else { sb_ = pl[2 * ((i) - n)]; kq_ = pl[2 * ((i) - n) + 1]; } \
            valid = (kq_ >> 16) == (unsigned)ql; sb_ = (sb_ == 0x80000000u) ? 0u : sb_; us = sb_ ^ ((unsigned)((int)sb_ >> 31) | 0x80000000u); kr = 16383u - (kq_ & 0xffffu); } while (0)
            if (nt <= 512u) {
                unsigned eu[8], ek[8]; bool ev[8];
#pragma unroll
                for (int r = 0; r < 8; ++r) { const unsigned i = 64u * r + lane; ev[r] = false; eu[r] = 0u; ek[r] = 0u; if (i < nt) SEL_ENT(i, ev[r], eu[r], ek[r]); }
                unsigned ts = 0u;
                for (int bit = 31; bit >= 0; --bit) { const unsigned cand = ts | (1u << bit); unsigned c = 0u;
#pragma unroll
                    for (int r = 0; r < 8; ++r) c += (unsigned)__popcll(__ballot(ev[r] && eu[r] >= cand));
                    if (c >= need) ts = cand; }
                unsigned cg = 0u;
#pragma unroll
                for (int r = 0; r < 8; ++r) cg += (unsigned)__popcll(__ballot(ev[r] && eu[r] > ts));
                const unsigned need2 = need - cg;
                unsigned kt = 0u;
                for (int bit = 13; bit >= 0; --bit) { const unsigned cand = kt | (1u << bit); unsigned c = 0u;
#pragma unroll
                    for (int r = 0; r < 8; ++r) c += (unsigned)__popcll(__ballot(ev[r] && eu[r] == ts && ek[r] >= cand));
                    if (c >= need2) kt = cand; }
#pragma unroll
                for (int r = 0; r < 8; ++r) if (ev[r] && (eu[r] > ts || (eu[r] == ts && ek[r] >= kt))) { const unsigned ki = 16383u - ek[r];
                    __hip_atomic_fetch_or(bm + (ki >> 5) * 32 + ql, 1u << (ki & 31u), __ATOMIC_RELAXED, __HIP_MEMORY_SCOPE_WORKGROUP); }
            } else {
            unsigned ts = 0u;
            for (int bit = 31; bit >= 0; --bit) { const unsigned cand = ts | (1u << bit); unsigned c = 0u;
                for (unsigned i0 = 0; i0 < nt; i0 += 64) { const unsigned i = i0 + lane; bool v = false; unsigned us = 0u, kr = 0u; if (i < nt) SEL_ENT(i, v, us, kr); c += (unsigned)__popcll(__ballot(v && us >= cand)); }
                if (c >= need) ts = cand; }
            unsigned cg = 0u;
            for (unsigned i0 = 0; i0 < nt; i0 += 64) { const unsigned i = i0 + lane; bool v = false; unsigned us = 0u, kr = 0u; if (i < nt) SEL_ENT(i, v, us, kr); cg += (unsigned)__popcll(__ballot(v && us > ts)); }
            const unsigned need2 = need - cg;
            unsigned kt = 0u;
            for (int bit = 13; bit >= 0; --bit) { const unsigned cand = kt | (1u << bit); unsigned c = 0u;
                for (unsigned i0 = 0; i0 < nt; i0 += 64) { const unsigned i = i0 + lane; bool v = false; unsigned us = 0u, kr = 0u; if (i < nt) SEL_ENT(i, v, us, kr); c += (unsigned)__popcll(__ballot(v && us == ts && kr >= cand)); }
                if (c >= need2) kt = cand; }
            for (unsigned i = lane; i < nt; i += 64) { bool v; unsigned us, kr; SEL_ENT(i, v, us, kr);
                if (v && (us > ts || (us == ts && kr >= kt))) { const unsigned ki = 16383u - kr; __hip_atomic_fetch_or(bm + (ki >> 5) * 32 + ql, 1u << (ki & 31u), __ATOMIC_RELAXED, __HIP_MEMORY_SCOPE_WORKGROUP); } }
            }
#undef SEL_ENT
        }
    }
    DMA_SYNC();
    for (int i = tid; i < 2 * NT * 32; i += NTHREADS) bitmapT[(size_t)(i >> 5) * S + qbase + (i & 31)] = bm[i];
    DMA_SYNC();
}

#define XB_TMO      128
#define XB_XCNT(j)  (256  + 64 * (j))
#define XB_XSUB(j)  (1280 + 64 * (j))
#define XB_XGEN(j)  (2304 + 64 * (j))
#define XB_TOP      3328
#define XB_TOPGEN   3392
#define XCD_BAR_WORDS 3456
#define XB_SPIN_CAP (1u << 22)
__device__ __forceinline__ unsigned xb_ld(unsigned* p)              { return __hip_atomic_load(p, __ATOMIC_RELAXED, __HIP_MEMORY_SCOPE_AGENT); }
__device__ __forceinline__ unsigned xb_add(unsigned* p, unsigned v) { return __hip_atomic_fetch_add(p, v, __ATOMIC_RELAXED, __HIP_MEMORY_SCOPE_AGENT); }
__device__ __forceinline__ unsigned xb_xcc_id() { return (unsigned)__builtin_amdgcn_s_getreg((3 << 11) | 20) & 0xFu; }
#define XB_SPIN(cond, bar) do { unsigned _sp = 0; while (cond) { __builtin_amdgcn_s_sleep(1); \
    if ((++_sp & 255u) == 0u) { if (xb_ld(&(bar)[XB_TMO])) break; if (_sp > XB_SPIN_CAP) { atomicAdd(&(bar)[XB_TMO], 1u); break; } } } } while (0)
struct XcdBarrier { unsigned* bar; unsigned x; volatile LAS unsigned* st; };
__device__ __forceinline__ XcdBarrier xcd_barrier_post(unsigned* bar, volatile LAS unsigned* st) {
    XcdBarrier b; b.bar = bar; b.x = xb_xcc_id(); b.st = st;
    return b;
}
__device__ __forceinline__ void xcd_barrier_complete(unsigned* bar, unsigned x, unsigned& nloc, unsigned& nx) {
    const unsigned G = gridDim.x * gridDim.y * gridDim.z;
    unsigned sum, cnt, mine, sp = 0u;
    for (;;) {
        sum = 0u; cnt = 0u; mine = 0u;
#pragma unroll
        for (unsigned j = 0; j < 16; ++j) { const unsigned c = xb_ld(&bar[XB_XCNT(j)]); sum += c; cnt += (c > 0u) ? 1u : 0u; mine = (j == x) ? c : mine; }
        if (sum == G) break;
        __builtin_amdgcn_s_sleep(1);
        if ((++sp & 255u) == 0u) { if (xb_ld(&bar[XB_TMO])) break; if (sp > XB_SPIN_CAP) { atomicAdd(&bar[XB_TMO], 1u); break; } }
    }
    nloc = mine > 0u ? mine : 1u; nx = cnt > 0u ? cnt : 1u;
}
__device__ __forceinline__ void xcd_barrier(const XcdBarrier& b) {
    asm volatile("s_waitcnt vmcnt(0)" ::: "memory");
    __syncthreads();
    if (threadIdx.x == 0) {
        unsigned* bar = b.bar;
        __builtin_amdgcn_s_waitcnt(0);
        unsigned nloc = b.st[0], nx = b.st[1];
        if (nloc == 0u) { xcd_barrier_complete(bar, b.x, nloc, nx); b.st[0] = nloc; b.st[1] = nx; }
        const unsigned old = xb_add(&bar[XB_XSUB(b.x)], 1u);
        const unsigned gen = old / nloc;
        if (old + 1u == (gen + 1u) * nloc) {
            __builtin_amdgcn_fence(__ATOMIC_RELEASE, "agent");
            asm volatile("s_waitcnt vmcnt(0)" ::: "memory");
            const unsigned og = xb_add(&bar[XB_TOP], 1u);
            const unsigned tg = og / nx;
            if (og + 1u == (tg + 1u) * nx) xb_add(&bar[XB_TOPGEN], 1u);
            else XB_SPIN(xb_ld(&bar[XB_TOPGEN]) == tg, bar);
            __builtin_amdgcn_fence(__ATOMIC_ACQUIRE, "agent");
            xb_add(&bar[XB_XGEN(b.x)], 1u);
            asm volatile("s_waitcnt vmcnt(0)" ::: "memory");
        } else {
            XB_SPIN(xb_ld(&bar[XB_XGEN(b.x)]) == gen, bar);
            __builtin_amdgcn_fence(__ATOMIC_ACQUIRE, "agent");
            asm volatile("s_waitcnt vmcnt(0)" ::: "memory");
        }
    }
    __syncthreads();
}

struct Args { const float* in[52]; float* out; unsigned char* ws; int ph_lo, ph_hi; };
enum { P_CONV = 0, P_KV, P_GU1, P_D1, P_WIN, P_MIXA, P_MIXB, P_MIXC, P_WOUT, P_WQ, P_MATT, P_WO, P_GU2, P_D2, P_PER_LAYER };
constexpr int PH_END = 2 * P_PER_LAYER;
#ifndef DBG_LAST
#define DBG_LAST PH_END
#endif

#define CONV_RUN(src0, src1, gain, dst, Nsrc, K, Nrows, mode) do { const int nitems_ = ((Nrows) / 32) * ((K) / 64); \
    f32x4 va_[8], vb_[8]; int it_ = gw; \
    if (it_ < nitems_) conv_load(src0, src1, gain, Nsrc, Nrows, mode, it_, lane, va_); \
    while (it_ < nitems_) { \
        if (it_ + NGW < nitems_) conv_load(src0, src1, gain, Nsrc, Nrows, mode, it_ + NGW, lane, vb_); \
        conv_store(dst, K, Nrows, it_, scr, lane, va_); it_ += NGW; if (it_ >= nitems_) break; \
        if (it_ + NGW < nitems_) conv_load(src0, src1, gain, Nsrc, Nrows, mode, it_ + NGW, lane, va_); \
        conv_store(dst, K, Nrows, it_, scr, lane, vb_); it_ += NGW; } } while (0)

__device__ __forceinline__ int t5_bucket(int rel) {
    const int off = rel < 0 ? 16 : 0; const int n = rel < 0 ? -rel : rel;
    if (n < 8) return off + n;
    int large = 8 + (int)(logf((float)n / 8.0f) / 2.772588722239781f * 8.0f);
    if (n == 64) large = 13;
    if (large > 15) large = 15;
    return off + large;
}

template <int L>
__device__ __forceinline__ void run_layer(const Args& a, LAS unsigned char* lds, cg::grid_group& grid, const XcdBarrier& xbar, int lo, int hi) {
    const int tid = threadIdx.x, lane = tid & 63, wave = __builtin_amdgcn_readfirstlane(tid >> 6);
    const int G = gridDim.x, bx = blockIdx.x;
    const int gw = bx * 8 + wave, NGW = G * 8;
    const int vcu = (G % 8 == 0) ? (bx % 8) * (G / 8) + bx / 8 : bx;
    unsigned char* ws = a.ws;
    constexpr int IB = (L == 0) ? 3 : 31;
    constexpr int MB = IB + ((L == 0) ? 17 : 10);
    constexpr int PB = L * P_PER_LAYER;
#define IN(k) (lo <= (PB + (k)) && (PB + (k)) < hi)
#define SYNC(k) do { if (IN(k) && (PB + (k) + 1) < hi) { if (PB + (k) == 0) { \
        if (bx == 0) { for (int i_ = threadIdx.x; i_ < XCD_BAR_WORDS; i_ += NTHREADS) __hip_atomic_store(&xbar.bar[i_], 0u, __ATOMIC_RELAXED, __HIP_MEMORY_SCOPE_AGENT); }     \
        grid.sync(); \
        if (threadIdx.x == 0) (void)xb_add(&xbar.bar[XB_XCNT(xbar.x)], 1u); } \
    else xcd_barrier(xbar); } } while (0)
    float* rsp = (float*)(ws + WS_RS); float* rsm = (float*)(ws + WS_RSM);
#define RSP(i) (rsp + (size_t)((i) & 1) * S * 16)
    bf16_t* hb = (bf16_t*)(ws + WS_HB); bf16_t* rb = (bf16_t*)a.out;
    bf16_t* osub = rb + (size_t)S * D;
    bf16_t* ocat = (bf16_t*)(ws + WS_OCAT);
    unsigned char* R = ws + WS_R;
    bf16_t* act = (bf16_t*)(R + R_ACT);
    float* lut5 = (float*)(ws + WS_LUT5); float* lutb = (float*)(ws + WS_LUTB);
    signed char* hq = (signed char*)(ws + WS_OCAT);
    float* qs = (float*)(ws + WS_QS); float* sb1 = (float*)(ws + WS_SB); float* sb2 = sb1 + 2 * FF; float* sbw = sb2 + 2 * FF;

#define CONVQ_RUN(MODE_, wg_, wu_, Nsrc_, Nrows_, gain_, dst_, sb_, first_, stride_) do { LAS float* xch_ = (LAS float*)(lds + 131072); \
        for (int it_ = (first_); it_ < (Nrows_) / 32; it_ += (stride_)) convq_item<MODE_>(wg_, wu_, Nsrc_, gain_, (signed char*)(dst_), sb_, it_, scr, xch_, wave, lane); } while (0)
#define CV_D1(IBx)   CONV_RUN(a.in[(IBx) + 3], a.in[(IBx) + 3], (const float*)nullptr, (bf16_t*)(ws + W_D1), D, FF, D, MAP_P8)
#define CV_WOUT(MBx) CONV_RUN(a.in[(MBx) - 1], a.in[(MBx) - 1], (const float*)nullptr, (bf16_t*)(ws + W_OUT), D, D, D, MAP_P8)
#define CV_WQ(MBx)   CONV_RUN(a.in[(MBx) + 2], a.in[(MBx) + 2], a.in[(MBx) + 0], (bf16_t*)(ws + W_Q), 512, D, 512, MAP_P8)
#define CV_WKV(MBx, slot_)  CONV_RUN(a.in[(MBx) + 3], a.in[(MBx) + 3], a.in[(MBx) + 1], (bf16_t*)(ws + (slot_)), D, D, D, MAP_P8)
#define CV_WO(MBx)   CONV_RUN(a.in[(MBx) + 6], a.in[(MBx) + 6], (const float*)nullptr, (bf16_t*)(ws + W_O), D, 512, D, MAP_P8)
#define CV_D2(MBx)   CONV_RUN(a.in[(MBx) + 10], a.in[(MBx) + 10], (const float*)nullptr, (bf16_t*)(ws + W_D2), D, FF, D, MAP_P8)
#define CV_GU1Q(IBx, f_, s_) CONVQ_RUN(MAP_GU, a.in[(IBx) + 1], a.in[(IBx) + 2], FF, 2 * FF, a.in[(IBx) + 0], ws + W_GU1, sb1, f_, s_)
#define CV_GU2Q(MBx, f_, s_) CONVQ_RUN(MAP_GU, a.in[(MBx) + 8], a.in[(MBx) + 9], FF, 2 * FF, a.in[(MBx) + 7], ws + W_GU2, sb2, f_, s_)
#define CV_WIN0Q(IBx, f_, s_) CONVQ_RUN(MAP_H64Q_L0, a.in[(IBx) + 5], a.in[(IBx) + 5], 3656, NWINQ, a.in[(IBx) + 4], ws + W_IN, sbw, f_, s_)
#define CV_WIN1Q(IBx, f_, s_) CONVQ_RUN(MAP_H64_L1, a.in[(IBx) + 5], a.in[(IBx) + 5], 3072, NWINQ, a.in[(IBx) + 4], ws + W_IN, sbw, f_, s_)
#define CV_WIN0I(IBx) CONV_RUN(a.in[(IBx) + 5], a.in[(IBx) + 5], a.in[(IBx) + 4], (bf16_t*)(ws + W_INI), 3656, D, NWINI, MAP_H64I_L0)
#define SIDE_BEGIN(fb, nb) if (bx >= (fb) && bx < (fb) + (nb)) { const int sf_ = bx - (fb), ss_ = (nb); const int gw = sf_ * 8 + wave, NGW = ss_ * 8; LAS float* scr = (LAS float*)(lds + wave * 16384); (void)gw; (void)NGW; (void)scr;
#define SIDE_END() }
#define KV_GEMM(cb, slot_, raw_) do { if (bx >= (cb) && bx < (cb) + 4) { \
        pg8::Gemm g_{(const bf16_t*)(ws + WS_MEMB), (const bf16_t*)(ws + (slot_)), NMEM, D, D}; pg8::StaticOrder so_; so_.init(NMEM, D, G, bx - (cb)); \
        EpiF32 E_{(float*)(ws + (raw_)), D, rsm}; pg8::gemm_phase(lds, g_, so_, E_); } } while (0)
#define KV_NORM(kgp, cb, raw_) do { if (bx >= (cb) && bx < (cb) + 8) { \
        const float* kv = (const float*)(ws + (raw_)); bf16_t* km = (bf16_t*)(ws + WS_KMEM); bf16_t* vm = (bf16_t*)(ws + WS_VMEM); const float* kg = (kgp); \
        for (int m = (bx - (cb)) * 8 + wave; m < NMEM; m += 64) { \
            const f32x4 k0 = *(const f32x4*)(kv + (size_t)m * D + 8 * lane), k1 = *(const f32x4*)(kv + (size_t)m * D + 8 * lane + 4); \
            float ss = (k0[0] * k0[0] + k0[1] * k0[1]) + (k0[2] * k0[2] + k0[3] * k0[3]) + (k1[0] * k1[0] + k1[1] * k1[1]) + (k1[2] * k1[2] + k1[3] * k1[3]); \
            ss += __shfl_xor(ss, 1); ss += __shfl_xor(ss, 2); ss += __shfl_xor(ss, 4); ss += __shfl_xor(ss, 8); \
            const float inv = 1.0f / sqrtf(ss * (1.0f / 128.0f) + EPS); \
            const int d = (8 * lane) & 127; const f32x4 ga = *(const f32x4*)(kg + d), gb = *(const f32x4*)(kg + d + 4); \
            u32x4 w; w.x = cvt_pk_bf16(k0[0] * inv * ga[0], k0[1] * inv * ga[1]); w.y = cvt_pk_bf16(k0[2] * inv * ga[2], k0[3] * inv * ga[3]); \
            w.z = cvt_pk_bf16(k1[0] * inv * gb[0], k1[1] * inv * gb[1]); w.w = cvt_pk_bf16(k1[2] * inv * gb[2], k1[3] * inv * gb[3]); \
            *(u32x4*)(km + (size_t)m * 512 + 8 * lane) = w; \
            const f32x4 v0 = *(const f32x4*)(kv + (size_t)m * D + 512 + 8 * lane), v1 = *(const f32x4*)(kv + (size_t)m * D + 512 + 8 * lane + 4); \
            u32x4 x; x.x = cvt_pk_bf16(v0[0], v0[1]); x.y = cvt_pk_bf16(v0[2], v0[3]); x.z = cvt_pk_bf16(v1[0], v1[1]); x.w = cvt_pk_bf16(v1[2], v1[3]); \
            *(u32x4*)(vm + (size_t)m * 512 + 8 * lane) = x; } } } while (0)
    const int SLK = G >> 1;

    if (L == 0 && IN(P_CONV)) {
        LAS float* scr = (LAS float*)(lds + wave * 16384);
        CV_GU1Q(3, bx, G); CV_D1(3);
        { f32x4 va[4], vb[4]; int m = gw;
          if (m < S) row_load(a.in[0] + (size_t)m * D, lane, va);
          while (m < S) {
              if (m + NGW < S) row_load(a.in[0] + (size_t)(m + NGW) * D, lane, vb);
              row_to_q8(va, hq + (size_t)m * D, qs + m, RSP(0) + (size_t)m * 16, lane); m += NGW; if (m >= S) break;
              if (m + NGW < S) row_load(a.in[0] + (size_t)(m + NGW) * D, lane, va);
              row_to_q8(vb, hq + (size_t)m * D, qs + m, RSP(0) + (size_t)m * 16, lane); m += NGW; } }
        for (int m = gw; m < NMEM; m += NGW) row_to_bf16(a.in[1] + (size_t)m * D, (bf16_t*)(ws + WS_MEMB) + (size_t)m * D, rsm + (size_t)m * 16, lane);
        for (int i = bx * NTHREADS + tid; i < 12 * 256; i += G * NTHREADS) { const int h = i >> 8, e = i & 255; const int rel = 191 - e;
            lut5[i] = (a.in[2][t5_bucket(rel) * 12 + h] - a.in[2][15 * 12 + h]) * LOG2E; }
        for (int i = bx * NTHREADS + tid; i < 16 * 640; i += G * NTHREADS) { const int h = i / 640, e = i % 640; int rel = 575 - e; rel = rel < -256 ? -256 : (rel > 256 ? 256 : rel);
            lutb[i] = (a.in[39][(rel + 256) * 16 + h] - a.in[39][512 * 16 + h]) * LOG2E; }
    }
    if (L == 0) SYNC(P_CONV);
    if (IN(P_GU1)) {
        pg8::Gemm g{(const bf16_t*)hq, (const bf16_t*)(ws + W_GU1), S, 2 * FF, D / 2}; pg8::StaticOrder so; so.init(S, 2 * FF, G, bx);
        LAS float* tab = (LAS float*)(lds + pg8::STAGE_BYTES); guq_prep<true>(tab, so, RSP(4 * L + 0), qs, sb1);
        EpiGUq E{act, tab};
        pg8::gemm_phase(lds, g, so, E);
        if (L == 0) { SIDE_BEGIN(SLK, G - SLK) CV_WIN0Q(3, sf_, ss_); CV_WIN0I(3); CV_WKV(20, W_KV); SIDE_END() }
        else { SIDE_BEGIN(SLK, G - SLK) CV_WIN1Q(31, sf_, ss_); CV_WOUT(41); CV_WQ(41); CV_WO(41); SIDE_END() }
    }
    SYNC(P_GU1);
    if (IN(P_D1)) {
        pg8::Gemm g{act, (const bf16_t*)(ws + W_D1), S, D, FF}; pg8::StaticOrder so; so.init(S, D, G, bx);
        if (L == 0) { EpiRes<true, true, false, true> E{a.in[0], rb, hq, RSP(4 * L + 1), qs, RSP(4 * L + 0)}; pg8::gemm_phase(lds, g, so, E); }
        else { EpiRes<true, false, false, true> E{rb, rb, hq, RSP(4 * L + 1), qs, RSP(4 * L + 0)}; pg8::gemm_phase(lds, g, so, E); }
    }
    SYNC(P_D1);
    if (IN(P_WIN)) {
        pg8::Gemm g{(const bf16_t*)hq, (const bf16_t*)(ws + W_IN), S, NWINQ, D / 2}; pg8::StaticOrder so; so.init(S, NWINQ, G, bx);
        LAS float* tab = (LAS float*)(lds + pg8::STAGE_BYTES); guq_prep<false>(tab, so, RSP(4 * L + 1), qs, sbw);
        if (L == 0) {
            { EpiWin<0> E{R, nullptr, tab, a.in[IB + 6], a.in[IB + 7], a.in[IB + 9], a.in[IB + 10]}; pg8::gemm_phase(lds, g, so, E); }
            pg8::Gemm gi{rb, (const bf16_t*)(ws + W_INI), S, NWINI, D}; pg8::StaticOrder si; si.init(S, NWINI, G, bx);
            EpiWin<2> Ei{R, RSP(4 * L + 1), nullptr, a.in[IB + 8], nullptr, nullptr, nullptr}; pg8::gemm_phase(lds, gi, si, Ei);
        } else { EpiWin<1> E{R, nullptr, tab, a.in[IB + 6], a.in[IB + 7], nullptr, nullptr}; pg8::gemm_phase(lds, g, so, E); }
        if (L == 0) { KV_GEMM((3 * G) >> 2, W_KV, WS_KVRAW);
            SIDE_BEGIN(((3 * G) >> 2) + 4, G - ((3 * G) >> 2) - 4) CV_WOUT(20); CV_WQ(20); CV_WO(20); CV_D1(31); CV_WKV(41, W_KV2); SIDE_END() }
    }
    SYNC(P_WIN);
    if (L == 0) {
        if (IN(P_MIXA)) {
            for (int pr = vcu; pr < 256; pr += G) {
                dsa_select_unit(lds, 511 - pr, (const bf16_t*)(R + R_IQ), (const bf16_t*)(R + R_IK), (const float*)(R + R_IW), a.in[IB + 8], (unsigned*)hb, (unsigned*)(ws + W_GU1 + 6 * MiB) + (size_t)bx * 2 * SEL_POOLCAP);
                dsa_select_unit(lds, pr, (const bf16_t*)(R + R_IQ), (const bf16_t*)(R + R_IK), (const float*)(R + R_IW), a.in[IB + 8], (unsigned*)hb, (unsigned*)(ws + W_GU1 + 6 * MiB) + (size_t)bx * 2 * SEL_POOLCAP);
            }
            for (int pr = vcu; pr < 256; pr += G) { const int hm = pr >> 5, s = pr & 31;
#pragma unroll 1
                for (int k = 0; k < 2; ++k) { const int qb = k ? s : 63 - s;
                    attn_unit<64, 128, AM_T5>(lds, (const bf16_t*)(R + R_BQ) + hm * 64, 512, (const bf16_t*)(R + R_BK) + hm * 64, 512, (const bf16_t*)(R + R_BV) + (hm >> 1) * 128, 512,
                                              osub + hm * 128, 1024, qb * 256, lut5 + (8 + (hm >> 1)) * 256, nullptr, nullptr); }
            }
        }
        SYNC(P_MIXA);
        if (IN(P_MIXB)) {
            const float lq1 = a.in[IB + 11][lane], lk1 = a.in[IB + 12][lane], lq2 = a.in[IB + 13][lane], lk2 = a.in[IB + 14][lane];
            const float lam = __expf(wave_sum(lq1 * lk1)) - __expf(wave_sum(lq2 * lk2)) + 0.2f;
            const float g0 = a.in[IB + 15][2 * lane], g1 = a.in[IB + 15][2 * lane + 1];
            unsigned wn[8];
            if (gw < S) {
#pragma unroll
                for (int j = 0; j < 8; ++j) wn[j] = *(const unsigned*)(osub + (size_t)gw * 1024 + j * 128 + 2 * lane);
            }
            for (int m = gw; m < S; m += NGW) {
                unsigned w[8];
#pragma unroll
                for (int j = 0; j < 8; ++j) w[j] = wn[j];
                if (m + NGW < S) {
#pragma unroll
                    for (int j = 0; j < 8; ++j) wn[j] = *(const unsigned*)(osub + (size_t)(m + NGW) * 1024 + j * 128 + 2 * lane);
                }
                asm volatile("" ::: "memory");
#pragma unroll
                for (int h = 0; h < 4; ++h) {
                    const float a0 = bf2f((unsigned short)(w[2 * h] & 0xffffu)) - lam * bf2f((unsigned short)(w[2 * h + 1] & 0xffffu));
                    const float a1 = bf2f((unsigned short)(w[2 * h] >> 16)) - lam * bf2f((unsigned short)(w[2 * h + 1] >> 16));
                    const float inv = 0.8f / sqrtf(wave_sum(a0 * a0 + a1 * a1) * (1.0f / 128.0f) + EPS);
                    *(unsigned*)(ocat + (size_t)m * 1024 + 512 + h * 128 + 2 * lane) = cvt_pk_bf16(a0 * inv * g0, a1 * inv * g1);
                }
            }
        }
        if (IN(P_MIXC)) {
            for (int pr = vcu; pr < 256; pr += G) { const int hd = pr >> 5, s = pr & 31;
#pragma unroll 1
                for (int k = 0; k < 2; ++k) { const int qb = k ? s : 63 - s;
                    attn_unit<64, 64, AM_T5_BITMAP>(lds, (const bf16_t*)(R + R_AQ) + hd * 64, 512, (const bf16_t*)(R + R_AK) + hd * 64, 512, (const bf16_t*)(R + R_AV) + hd * 64, 512,
                                                    ocat + hd * 64, 1024, qb * 256, lut5 + hd * 256, (const unsigned*)hb, nullptr); }
            }
        }
        SYNC(P_MIXC);
    } else {
        if (IN(P_MIXA)) {
            for (int u = vcu; u < 1024; u += G) { const int hd = u >> 6, qb = u & 63;
                attn_unit<64, 64, AM_BAND>(lds, (const bf16_t*)(R + R_CQ) + hd * 64, 1024, (const bf16_t*)(R + R_CK) + hd * 64, 1024, (const bf16_t*)(R + R_CV) + hd * 64, 1024,
                                           ocat + hd * 64, 1024, qb * 256, lutb + hd * 640, nullptr, nullptr); }
        }
        SYNC(P_MIXA);
    }
    if (IN(P_WOUT)) {
        pg8::Gemm g{ocat, (const bf16_t*)(ws + W_OUT), S, D, D}; pg8::StaticOrder so; so.init(S, D, G, bx);
        EpiRes<false, false, false, false> E{rb, rb, nullptr, RSP(4 * L + 2), nullptr, nullptr};
        pg8::gemm_phase(lds, g, so, E);
    }
    SYNC(P_WOUT);
    if (IN(P_WQ)) {
        pg8::Gemm g{rb, (const bf16_t*)(ws + W_Q), S, 512, D}; pg8::StaticOrder so; so.init(S, 512, G, bx);
        EpiBf16 E{(bf16_t*)(R + R_QM), 512, RSP(4 * L + 2)};
        pg8::gemm_phase(lds, g, so, E);
        KV_NORM(a.in[MB + 5], G - 8, L == 0 ? WS_KVRAW : WS_KVRAW2);
        if (L == 0) { KV_GEMM(G - 12, W_KV2, WS_KVRAW2);
            SIDE_BEGIN(SLK, G - SLK - 12) CV_GU2Q(20, sf_, ss_); CV_D2(20); SIDE_END() }
        else { SIDE_BEGIN(SLK, G - SLK - 8) CV_GU2Q(41, sf_, ss_); CV_D2(41); SIDE_END() }
    }
    SYNC(P_WQ);
    if (IN(P_MATT)) {
        for (int u = vcu; u < 256; u += G) { const int hd = u >> 6, qb = u & 63;
            attn_unit<128, 128, AM_MEM>(lds, (const bf16_t*)(R + R_QM) + hd * 128, 512, (const bf16_t*)(ws + WS_KMEM) + hd * 128, 512, (const bf16_t*)(ws + WS_VMEM) + hd * 128, 512,
                                        (bf16_t*)(R + R_OM) + hd * 128, 512, qb * 256, nullptr, nullptr, a.in[MB + 4]); }
    }
    SYNC(P_MATT);
    if (IN(P_WO)) {
        pg8::Gemm g{(const bf16_t*)(R + R_OM), (const bf16_t*)(ws + W_O), S, D, 512}; pg8::StaticOrder so; so.init(S, D, G, bx);
        EpiRes<false, false, false, true> E{rb, L == 1 ? hb : rb, hq, RSP(4 * L + 3), qs, RSP(4 * L + 2)};
        pg8::gemm_phase(lds, g, so, E);
    }
    SYNC(P_WO);
    if (IN(P_GU2)) {
        pg8::Gemm g{(const bf16_t*)hq, (const bf16_t*)(ws + W_GU2), S, 2 * FF, D / 2}; pg8::StaticOrder so; so.init(S, 2 * FF, G, bx);
        LAS float* tab = (LAS float*)(lds + pg8::STAGE_BYTES); guq_prep<true>(tab, so, RSP(4 * L + 3), qs, sb2);
        EpiGUq E{act, tab};
        pg8::gemm_phase(lds, g, so, E);
        if (L == 0) { SIDE_BEGIN(SLK, G - SLK) CV_GU1Q(31, sf_, ss_); SIDE_END() }
    }
    SYNC(P_GU2);
    if (IN(P_D2)) {
        pg8::Gemm g{act, (const bf16_t*)(ws + W_D2), S, D, FF}; pg8::StaticOrder so; so.init(S, D, G, bx);
        if (L == 0) { EpiRes<true, false, false, true> E{rb, rb, hq, RSP(4), qs, RSP(3)}; pg8::gemm_phase(lds, g, so, E); }
        else { EpiRes<true, false, true, false> E{hb, a.out, nullptr, nullptr, nullptr, nullptr}; pg8::gemm_phase(lds, g, so, E); }
    }
    SYNC(P_D2);
#undef IN
#undef SYNC
}

__global__ void __launch_bounds__(NTHREADS, 2) mk_fwd(Args a) {
    extern __shared__ __attribute__((aligned(16))) unsigned char lds_raw[];
    LAS unsigned char* lds = (LAS unsigned char*)lds_raw;
    cg::grid_group grid = cg::this_grid();
    const int lo = a.ph_lo, hi = a.ph_hi;
    if (threadIdx.x < 64) ((LAS unsigned*)(lds + MISC_OFF))[threadIdx.x] = 0u;
    __syncthreads();
    const XcdBarrier xbar = xcd_barrier_post((unsigned*)(a.ws + WS_BAR), (volatile LAS unsigned*)(lds + MISC_OFF) + 8);
    run_layer<0>(a, lds, grid, xbar, lo, hi);
    run_layer<1>(a, lds, grid, xbar, lo, hi);
}

extern "C" void kernel_launch(void* const* d_in, const int* in_sizes, int n_in, void* d_out, int out_size, void* d_ws, size_t ws_size, hipStream_t stream) {
    static int grid = 0;
    if (grid == 0) {
        if (n_in != 52 || out_size != S * D || ws_size < WS_END) { fprintf(stderr, "kernel_launch: unexpected shapes n_in %d out %d ws %zu\n", n_in, out_size, ws_size); grid = -1; return; }
        int dev = 0, cus = 0, per_cu = 0;
        (void)hipGetDevice(&dev); (void)hipDeviceGetAttribute(&cus, hipDeviceAttributeMultiprocessorCount, dev);
        (void)hipFuncSetAttribute((const void*)mk_fwd, hipFuncAttributeMaxDynamicSharedMemorySize, LDS_BYTES);
        (void)hipOccupancyMaxActiveBlocksPerMultiprocessor(&per_cu, (const void*)mk_fwd, NTHREADS, LDS_BYTES);
        if (per_cu < 1) { fprintf(stderr, "kernel_launch: occupancy query says %d\n", per_cu); per_cu = 1; }
        grid = cus * 1;
        (void)hipGetLastError();
    }
    if (grid < 0) return;
    Args a{};
    for (int i = 0; i < 52; ++i) a.in[i] = (const float*)d_in[i];
    a.out = (float*)d_out; a.ws = (unsigned char*)d_ws;
    a.ph_lo = 0; a.ph_hi = DBG_LAST;
    void* args[] = {&a};
    hipError_t e = hipLaunchCooperativeKernel((const void*)mk_fwd, dim3(grid), dim3(NTHREADS), args, LDS_BYTES, stream);
    if (e != hipSuccess) fprintf(stderr, "kernel_launch: cooperative launch failed: %s\n", hipGetErrorString(e));
}
```

```cpp
#include <hip/hip_runtime.h>
#include <hip/hip_cooperative_groups.h>
#include <cstdio>
#include <cstdint>
namespace cg = cooperative_groups;

#define LAS __attribute__((address_space(3)))
typedef unsigned short bf16_t;
typedef short bf16x8 __attribute__((ext_vector_type(8)));
typedef short s16x4 __attribute__((ext_vector_type(4)));
typedef float f32x4 __attribute__((ext_vector_type(4)));
typedef float f32x2 __attribute__((ext_vector_type(2)));
typedef float f32x16 __attribute__((ext_vector_type(16)));
typedef unsigned u32x4 __attribute__((ext_vector_type(4)));
typedef unsigned u32x2 __attribute__((ext_vector_type(2)));
typedef int i32x4 __attribute__((ext_vector_type(4)));

constexpr int S = 16384, D = 1024, FF = 2816, NMEM = 256;
constexpr float EPS = 1e-6f;
constexpr float LOG2E = 1.4426950408889634f;
constexpr int NWIN0 = 3840, NWINQ = 3072, NWINI = 768;

constexpr size_t MiB = 1u << 20;
constexpr size_t WS_RS = 4 * MiB;
constexpr size_t WS_RSM = 6 * MiB;
constexpr size_t WS_QS = 6 * MiB + 64 * 1024;
constexpr size_t WS_SB = 6 * MiB + 128 * 1024;
constexpr size_t WS_LUT5 = 640 * 1024;
constexpr size_t WS_LUTB = 656 * 1024;
constexpr size_t WS_MISC = 700 * 1024;
constexpr size_t WS_BAR = 768 * 1024;
constexpr size_t WS_KVRAW = 1 * MiB;
constexpr size_t WS_KVRAW2 = 7 * MiB;
constexpr size_t WS_KMEM = 2 * MiB;
constexpr size_t WS_VMEM = 2 * MiB + 512 * 1024;
constexpr size_t WS_MEMB = 3 * MiB;
constexpr size_t WS_W = 8 * MiB;
constexpr size_t W_GU1 = WS_W, W_D1 = W_GU1 + (size_t)2 * FF * D * 2, W_GU2 = W_D1 + (size_t)D * FF * 2, W_D2 = W_GU2 + (size_t)2 * FF * D * 2;
constexpr size_t W_IN = W_D2 + (size_t)D * FF * 2, W_OUT = W_IN + (size_t)NWIN0 * D * 2, W_Q = W_OUT + (size_t)D * D * 2, W_KV = W_Q + (size_t)512 * D * 2, W_O = W_KV + (size_t)D * D * 2;
constexpr size_t W_END = W_O + (size_t)D * 512 * 2;
constexpr size_t W_KV2 = W_END;
static_assert(W_KV2 + (size_t)D * D * 2 <= 58 * MiB, "w_kv2 slot");
constexpr size_t W_INI = W_IN + 4 * MiB;
constexpr size_t WS_HB = 58 * MiB;
constexpr size_t WS_OCAT = 90 * MiB;
constexpr size_t WS_R = 122 * MiB;
constexpr size_t WS_END = 256 * MiB;
static_assert(W_END <= WS_HB, "weights fit");
constexpr size_t R_ACT = 0;
constexpr size_t R_AQ = 0, R_AK = 16 * MiB, R_AV = 32 * MiB, R_IQ = 48 * MiB, R_BQ = 64 * MiB, R_BK = 80 * MiB, R_BV = 96 * MiB, R_IK = 112 * MiB, R_IW = 114 * MiB;
constexpr size_t R_CQ = 0, R_CK = 32 * MiB, R_CV = 64 * MiB;
constexpr size_t R_QM = 96 * MiB, R_OM = 112 * MiB;
static_assert(WS_R + R_OM + 16 * MiB <= WS_END && WS_R + R_IW + MiB <= WS_END, "region R");

constexpr int LDS_BYTES = 160 * 1024 - 2048;
constexpr int NTHREADS = 512;
constexpr int MISC_OFF = LDS_BYTES - 256;

__device__ __forceinline__ unsigned cvt_pk_bf16(float lo, float hi) { unsigned r; asm("v_cvt_pk_bf16_f32 %0, %1, %2" : "=v"(r) : "v"(lo), "v"(hi)); return r; }
__device__ __forceinline__ unsigned f2bf(float f) { unsigned u = __builtin_bit_cast(unsigned, f); return (u + 0x7fffu + ((u >> 16) & 1u)) >> 16; }
__device__ __forceinline__ float bf2f(unsigned short b) { return __builtin_bit_cast(float, ((unsigned)b) << 16); }
__device__ __forceinline__ float wave_sum(float v) {
#pragma unroll
    for (int o = 1; o < 64; o <<= 1) v += __shfl_xor(v, o);
    return v;
}

__device__ __forceinline__ float sum_xor16(float x) { const unsigned u = __float_as_uint(x); auto r = __builtin_amdgcn_permlane16_swap(u, u, false, false); return __uint_as_float(r[0]) + __uint_as_float(r[1]); }
__device__ __forceinline__ float sum_xor32(float x) { const unsigned u = __float_as_uint(x); auto r = __builtin_amdgcn_permlane32_swap(u, u, false, false); return __uint_as_float(r[0]) + __uint_as_float(r[1]); }

namespace pg8 {
constexpr int BM = 256, BK = 64, HALF = 128, HTB = HALF * BK * 2, STAGE_BYTES = 8 * HTB, NXCD = 8, WGM = 8;
__host__ __device__ __forceinline__ int lds_byte(int r, int c) { const int st = (r >> 4) * 2 + (c >> 5), rr = r & 15, cc = c & 31, ob = rr * 64 + cc * 2; return st * 1024 + (ob ^ (((ob >> 9) & 1) << 5)); }
__host__ __device__ __forceinline__ void stage_rc(int b, int& R, int& C) { const int st = b / 1024, sb = b % 1024, swz = sb ^ (((sb >> 9) & 1) << 5); R = (st >> 1) * 16 + swz / 64; C = (st & 1) * 32 + (swz % 64) / 2; }
struct Unit { int pm, pn, ui; };
struct Gemm { const bf16_t* A; const bf16_t* Bt; int M, N, K; };
struct StaticOrder {
    int nM, nN, nwg, G, c;
    __device__ void init(int M, int N, int G_, int c_) { nM = M / BM; nN = N / BM; nwg = nM * nN; G = G_; c = c_; }
    __device__ bool next(int i, Unit& u) const {
        const long L = (long)i * G + c; if (L >= nwg) return false;
        int wgid = (int)L; { const int q = nwg / NXCD, r = nwg % NXCD, xcd = wgid % NXCD, off = wgid / NXCD; wgid = (xcd < r ? xcd * (q + 1) : r * (q + 1) + (xcd - r) * q) + off; }
        const int nig = WGM * nN, gid = wgid / nig, fm = gid * WGM, gsz = (nM - fm) < WGM ? (nM - fm) : WGM;
        u.pm = fm + ((wgid % nig) % gsz); u.pn = (wgid % nig) / gsz; u.ui = i; return true;
    }
};

template <class Epi>
__device__ __forceinline__ void gemm_phase(LAS unsigned char* lds, const Gemm g, const StaticOrder& S, const Epi& E) {
    int tid = threadIdx.x; asm volatile("" : "+v"(tid));
    const int wid = __builtin_amdgcn_readfirstlane(tid >> 6), lane = tid & 63, wr = wid >> 2, wc = wid & 3, fr = lane & 15, fq = lane >> 4;
    const int K = g.K, nt = K / BK;
    unsigned voffA[2];
#pragma unroll
    for (int i = 0; i < 2; ++i) { int R, C; stage_rc(tid * 16 + i * 8192, R, C); voffA[i] = (unsigned)(R * K + C) * 2u; }
    const size_t kstep = (size_t)(BK * 2);
    const size_t hstep = (size_t)HALF * K * 2;
    const size_t tstep = 2 * hstep;
    const unsigned ldsw = (unsigned)wid * 1024u;
    const int aoff = lds_byte(wr * 64 + fr, fq * 8), boff = lds_byte(wc * 32 + fr, fq * 8);
#define PG8_SA(b, h) (((b) * 2 + (h)) * HTB)
#define PG8_SB(b, h) ((4 + (b) * 2 + (h)) * HTB)
#define PG8_STAGE(bufoff, gbase) do { _Pragma("unroll") for (int _i = 0; _i < 2; ++_i) \
        __builtin_amdgcn_global_load_lds((const unsigned*)((const char*)(gbase) + voffA[_i]), (LAS unsigned*)(lds + (bufoff) + ldsw + _i * 8192), 16, 0, 0); } while (0)
#define PG8_LDA(dst, b, h) do { _Pragma("unroll") for (int m = 0; m < 4; ++m) _Pragma("unroll") for (int k = 0; k < 2; ++k) dst[m][k] = *(const LAS bf16x8*)(lds + PG8_SA(b, h) + aoff + m * 2048 + k * 1024); } while (0)
#define PG8_LDB(dst, b, h) do { _Pragma("unroll") for (int n = 0; n < 2; ++n) _Pragma("unroll") for (int k = 0; k < 2; ++k) dst[n][k] = *(const LAS bf16x8*)(lds + PG8_SB(b, h) + boff + n * 2048 + k * 1024); } while (0)
#define PG8_MMA(ai, bj, At, Bt) do { __builtin_amdgcn_s_setprio(1); _Pragma("unroll") for (int m = 0; m < 4; ++m) _Pragma("unroll") for (int n = 0; n < 2; ++n) _Pragma("unroll") for (int k = 0; k < 2; ++k) { \
        if constexpr (Epi::I8) acc[ai][bj][m][n] = __builtin_amdgcn_mfma_i32_16x16x64_i8(__builtin_bit_cast(i32x4, Bt[n][k]), __builtin_bit_cast(i32x4, At[m][k]), acc[ai][bj][m][n], 0, 0, 0); \
        else acc[ai][bj][m][n] = __builtin_amdgcn_mfma_f32_16x16x32_bf16(Bt[n][k], At[m][k], acc[ai][bj][m][n], 0, 0, 0); } __builtin_amdgcn_s_setprio(0); } while (0)
#define PG8_WAIT_V(n) asm volatile("s_waitcnt vmcnt(" #n ")" ::: "memory")
#define PG8_WAIT_L(n) asm volatile("s_waitcnt lgkmcnt(" #n ")" ::: "memory")
#define PG8_BAR __builtin_amdgcn_s_barrier()
#define PG8_SCHED __builtin_amdgcn_sched_barrier(0)
    Unit cur, nxt; int ui = 0;
    if (!S.next(0, cur)) return;
    using acc_t = typename Epi::acc_t;
    acc_t acc[2][2][4][2];
#pragma unroll
    for (int a = 0; a < 2; ++a)
#pragma unroll
        for (int b = 0; b < 2; ++b)
#pragma unroll
            for (int m = 0; m < 4; ++m)
#pragma unroll
                for (int n = 0; n < 2; ++n) acc[a][b][m][n] = acc_t{};
    bf16x8 At[4][2], B0[2][2], B1[2][2];
    const char* cA = (const char*)g.A + (size_t)cur.pm * tstep; const char* cB = (const char*)g.Bt + (size_t)cur.pn * tstep;
    PG8_STAGE(PG8_SB(0, 0), cB); PG8_STAGE(PG8_SB(0, 1), cB + hstep); PG8_STAGE(PG8_SA(0, 0), cA); PG8_STAGE(PG8_SA(0, 1), cA + hstep);
    if (wr == 1) PG8_BAR;
    PG8_WAIT_V(2); PG8_BAR;
    PG8_STAGE(PG8_SB(1, 0), cB + kstep); PG8_STAGE(PG8_SA(1, 0), cA + kstep); PG8_STAGE(PG8_SB(1, 1), cB + hstep + kstep);
    PG8_WAIT_V(6); PG8_BAR;
    for (;;) {
        const bool has_next = S.next(ui + 1, nxt);
        const char* nA = has_next ? (const char*)g.A + (size_t)nxt.pm * tstep : cA; const char* nB = has_next ? (const char*)g.Bt + (size_t)nxt.pn * tstep : cB;
        for (int t = 0; t < nt; t += 2) {
            const bool last = (t == nt - 2);
            const char* a1 = cA + (size_t)(t + 1) * kstep;
            const char* a2 = last ? nA : cA + (size_t)(t + 2) * kstep; const char* b2 = last ? nB : cB + (size_t)(t + 2) * kstep;
            const char* a3 = a2 + kstep; const char* b3 = b2 + kstep;
            PG8_LDB(B0, 0, 0); PG8_LDB(B1, 0, 1); PG8_SCHED; PG8_LDA(At, 0, 0); PG8_STAGE(PG8_SA(1, 1), a1 + hstep);
            PG8_WAIT_V(8); PG8_WAIT_L(0); PG8_BAR; PG8_MMA(0, 0, At, B0); PG8_MMA(0, 1, At, B1); PG8_BAR; PG8_SCHED;
            PG8_LDA(At, 0, 1); PG8_STAGE(PG8_SB(0, 0), b2); PG8_STAGE(PG8_SB(0, 1), b2 + hstep); PG8_STAGE(PG8_SA(0, 0), a2);
            PG8_WAIT_V(8); PG8_WAIT_L(0); PG8_BAR; PG8_MMA(1, 0, At, B0); PG8_MMA(1, 1, At, B1); PG8_BAR; PG8_SCHED;
            PG8_LDB(B0, 1, 0); PG8_LDB(B1, 1, 1); PG8_SCHED; PG8_LDA(At, 1, 0); PG8_STAGE(PG8_SA(0, 1), a2 + hstep);
            PG8_WAIT_V(8); PG8_WAIT_L(0); PG8_BAR; PG8_MMA(0, 0, At, B0); PG8_MMA(0, 1, At, B1); PG8_BAR; PG8_SCHED;
            PG8_LDA(At, 1, 1); PG8_STAGE(PG8_SB(1, 0), b3); PG8_STAGE(PG8_SB(1, 1), b3 + hstep); PG8_STAGE(PG8_SA(1, 0), a3);
            PG8_WAIT_V(8); PG8_WAIT_L(0); PG8_BAR; PG8_MMA(1, 0, At, B0); PG8_MMA(1, 1, At, B1); PG8_BAR; PG8_SCHED;
        }
        if (wr == 0) PG8_BAR;
        E(acc, cur, wr, wc, fr, fq);
        if (!has_next) break;
#pragma unroll
        for (int a = 0; a < 2; ++a)
#pragma unroll
            for (int b = 0; b < 2; ++b)
#pragma unroll
                for (int m = 0; m < 4; ++m)
#pragma unroll
                    for (int n = 0; n < 2; ++n) acc[a][b][m][n] = acc_t{};
        cur = nxt; cA = nA; cB = nB; ++ui;
        if (wr == 1) PG8_BAR;
    }
    PG8_WAIT_V(0);
    PG8_BAR;
#undef PG8_SA
#undef PG8_SB
#undef PG8_STAGE
#undef PG8_LDA
#undef PG8_LDB
#undef PG8_MMA
#undef PG8_WAIT_V
#undef PG8_WAIT_L
#undef PG8_BAR
#undef PG8_SCHED
}
}
using pg8::Unit;

__device__ __forceinline__ void load_rstd(const float* parts, int row0, int fq, float (&rs)[2][4]) {
    float s[2][4];
#pragma unroll
    for (int ai = 0; ai < 2; ++ai)
#pragma unroll
        for (int m = 0; m < 4; ++m) { const f32x4 a = *(const f32x4*)(parts + (size_t)(row0 + ai * 128 + m * 16) * 16 + 4 * fq);
            s[ai][m] = (a[0] + a[1]) + (a[2] + a[3]); }
#pragma unroll
    for (int ai = 0; ai < 2; ++ai)
#pragma unroll
        for (int m = 0; m < 4; ++m) { float t = sum_xor32(sum_xor16(s[ai][m])); rs[ai][m] = __builtin_amdgcn_rsqf(t * (1.0f / D) + EPS); }
}
struct EpiGU {
    using acc_t = f32x4; static constexpr bool I8 = false;
    bf16_t* act; const float* rowss;
    __device__ __forceinline__ void operator()(const f32x4 (&acc)[2][2][4][2], const Unit& u, int wr, int wc, int fr, int fq) const {
        const int row0 = u.pm * 256 + wr * 64 + fr, col0 = u.pn * 128 + wc * 32 + fq * 8;
        float rs[2][4]; load_rstd(rowss, row0, fq, rs);
#pragma unroll
        for (int ai = 0; ai < 2; ++ai)
#pragma unroll
            for (int m = 0; m < 4; ++m) {
                const float r = rs[ai][m]; float o[8];
#pragma unroll
                for (int bj = 0; bj < 2; ++bj)
#pragma unroll
                    for (int j = 0; j < 4; ++j) { const float gt = acc[ai][bj][m][0][j] * r, up = acc[ai][bj][m][1][j] * r;
                        o[bj * 4 + j] = gt * up * __builtin_amdgcn_rcpf(1.0f + __builtin_amdgcn_exp2f(-gt * LOG2E)); }
                u32x4 w; w.x = cvt_pk_bf16(o[0], o[1]); w.y = cvt_pk_bf16(o[2], o[3]); w.z = cvt_pk_bf16(o[4], o[5]); w.w = cvt_pk_bf16(o[6], o[7]);
                *(u32x4*)(act + (size_t)(row0 + ai * 128 + m * 16) * FF + col0) = w;
            }
    }
};
struct EpiGUq {
    using acc_t = i32x4; static constexpr bool I8 = true;
    bf16_t* act; const LAS float* tab;
    __device__ __forceinline__ void operator()(const i32x4 (&acc)[2][2][4][2], const Unit& u, int wr, int wc, int fr, int fq) const {
        const int row0 = u.pm * 256 + wr * 64 + fr, col0 = u.pn * 128 + wc * 32 + fq * 8;
        const LAS float* R = tab + u.ui * 512;
        f32x2 c1[2][2], c2[2][2];
#pragma unroll
        for (int bj = 0; bj < 2; ++bj) {
            const f32x4 x1 = *(const LAS f32x4*)(R + 256 + bj * 128 + wc * 32 + 4 * fq), x2 = *(const LAS f32x4*)(R + 256 + bj * 128 + wc * 32 + 16 + 4 * fq);
#pragma unroll
            for (int jp = 0; jp < 2; ++jp) { c1[bj][jp] = f32x2{x1[2 * jp], x1[2 * jp + 1]}; c2[bj][jp] = f32x2{x2[2 * jp], x2[2 * jp + 1]}; }
        }
#pragma unroll
        for (int ai = 0; ai < 2; ++ai)
#pragma unroll
            for (int m = 0; m < 4; ++m) {
                const int row = row0 + ai * 128 + m * 16; const float r = R[wr * 64 + fr + ai * 128 + m * 16]; const f32x2 r1{r, r}, r2{r * r, r * r}; u32x4 w;
#pragma unroll
                for (int bj = 0; bj < 2; ++bj)
#pragma unroll
                    for (int jp = 0; jp < 2; ++jp) {
                        const f32x2 ag{(float)acc[ai][bj][m][0][2 * jp], (float)acc[ai][bj][m][0][2 * jp + 1]}, au{(float)acc[ai][bj][m][1][2 * jp], (float)acc[ai][bj][m][1][2 * jp + 1]};
                        const f32x2 x = (ag * c1[bj][jp]) * r1, p = (ag * au) * c2[bj][jp];
                        f32x2 d{__builtin_amdgcn_exp2f(x[0]), __builtin_amdgcn_exp2f(x[1])}; d = d + f32x2{1.0f, 1.0f};
                        const f32x2 o = p * (f32x2{__builtin_amdgcn_rcpf(d[0]), __builtin_amdgcn_rcpf(d[1])} * r2);
                        w[bj * 2 + jp] = cvt_pk_bf16(o[0], o[1]);
                    }
                *(u32x4*)(act + (size_t)row * FF + col0) = w;
            }
    }
};
template <bool GU, class SO>
__device__ __forceinline__ void guq_prep(LAS float* tab, const SO& so, const float* rowss, const float* qs, const float* sb) {
    int tid = threadIdx.x; asm volatile("" : "+v"(tid));
    pg8::Unit u;
    for (int i = 0; so.next(i, u); ++i) {
        LAS float* R = tab + i * 512;
        if (tid < 256) {
            const int row = u.pm * 256 + tid; const f32x4* p = (const f32x4*)(rowss + (size_t)row * 16);
            const f32x4 s = (p[0] + p[1]) + (p[2] + p[3]);
            R[tid] = __builtin_amdgcn_rsqf(((s[0] + s[1]) + (s[2] + s[3])) * (1.0f / D) + EPS) * qs[row];
        } else {
            const int c = tid - 256;
            if constexpr (GU) { if (!(c & 16)) { const float sg = sb[u.pn * 256 + c], su = sb[u.pn * 256 + c + 16]; R[256 + c] = sg * -LOG2E; R[256 + c + 16] = sg * su; } }
            else R[256 + c] = sb[u.pn * 256 + c];
        }
    }
    __syncthreads();
}
constexpr float QRANGE = 4.5f;
__device__ __forceinline__ unsigned q8_pack4(f32x4 v, float q) {
    int a0 = (int)__builtin_rintf(v[0] * q), a1 = (int)__builtin_rintf(v[1] * q), a2 = (int)__builtin_rintf(v[2] * q), a3 = (int)__builtin_rintf(v[3] * q);
    a0 = min(max(a0, -127), 127); a1 = min(max(a1, -127), 127); a2 = min(max(a2, -127), 127); a3 = min(max(a3, -127), 127);
    return (unsigned)(a0 & 0xff) | ((unsigned)(a1 & 0xff) << 8) | ((unsigned)(a2 & 0xff) << 16) | ((unsigned)a3 << 24);
}
__device__ __forceinline__ f32x4 bf2_lo4(unsigned a, unsigned b) { return f32x4{__uint_as_float(a << 16), __uint_as_float(a & 0xffff0000u), __uint_as_float(b << 16), __uint_as_float(b & 0xffff0000u)}; }
template <bool HALF, bool BF, bool OF, bool Q> struct EpiRes {
    using acc_t = f32x4; static constexpr bool I8 = false;
    static constexpr float scale = HALF ? 0.5f : 1.0f;
    const void* base; void* out; signed char* hq; float* rowss_out; float* qs; const float* prev_parts;
    __device__ __forceinline__ void operator()(const f32x4 (&acc)[2][2][4][2], const Unit& u, int wr, int wc, int fr, int fq) const {
        const int row0 = u.pm * 256 + wr * 64 + fr, col0 = u.pn * 256 + wc * 32 + fq * 8;
        float rp[2][4];
#pragma unroll
        for (int ai = 0; ai < 2; ++ai) {
            u32x4 bw[2][4][2];
            if constexpr (!BF) {
#pragma unroll
                for (int m = 0; m < 4; ++m)
#pragma unroll
                    for (int bj = 0; bj < 2; ++bj) bw[ai][m][bj] = *(const u32x4*)((const bf16_t*)base + (size_t)(row0 + ai * 128 + m * 16) * D + col0 + bj * 128);
            }
            if constexpr (Q) { if (ai == 0) load_rstd(prev_parts, row0, fq, rp); }
#pragma unroll
            for (int m = 0; m < 4; ++m) {
                const int row = row0 + ai * 128 + m * 16; float ss = 0.f;
                float q = 0.f; if constexpr (Q) q = (127.0f / QRANGE) * rp[ai][m];
#pragma unroll
                for (int bj = 0; bj < 2; ++bj) {
                    const size_t off = (size_t)row * D + col0 + bj * 128;
                    f32x4 b0, b1;
                    if constexpr (BF) { b0 = *(const f32x4*)((const float*)base + off); b1 = *(const f32x4*)((const float*)base + off + 4); }
                    else { b0 = bf2_lo4(bw[ai][m][bj].x, bw[ai][m][bj].y); b1 = bf2_lo4(bw[ai][m][bj].z, bw[ai][m][bj].w); }
                    const f32x4 h0 = b0 + acc[ai][bj][m][0] * scale, h1 = b1 + acc[ai][bj][m][1] * scale;
                    if constexpr (OF) { *(f32x4*)((float*)out + off) = h0; *(f32x4*)((float*)out + off + 4) = h1; }
                    else { u32x4 w; w.x = cvt_pk_bf16(h0[0], h0[1]); w.y = cvt_pk_bf16(h0[2], h0[3]); w.z = cvt_pk_bf16(h1[0], h1[1]); w.w = cvt_pk_bf16(h1[2], h1[3]); *(u32x4*)((bf16_t*)out + off) = w; }
                    if constexpr (Q) { u32x2 w; w.x = q8_pack4(h0, q); w.y = q8_pack4(h1, q); *(u32x2*)(hq + off) = w; }
                    ss += (h0[0] * h0[0] + h0[1] * h0[1]) + (h0[2] * h0[2] + h0[3] * h0[3]) + (h1[0] * h1[0] + h1[1] * h1[1]) + (h1[2] * h1[2] + h1[3] * h1[3]);
                }
                if constexpr (Q) { if (u.pn == 0 && wc == 0 && fq == 0) qs[row] = 1.0f / q; }
                if (rowss_out) { ss = sum_xor32(sum_xor16(ss)); if (fq == 0) rowss_out[(size_t)row * 16 + u.pn * 4 + wc] = ss; }
            }
        }
    }
};

struct EpiBf16 {
    using acc_t = f32x4; static constexpr bool I8 = false;
    bf16_t* out; int ldc; const float* rowss;
    __device__ __forceinline__ void operator()(const f32x4 (&acc)[2][2][4][2], const Unit& u, int wr, int wc, int fr, int fq) const {
        const int row0 = u.pm * 256 + wr * 64 + fr, col0 = u.pn * 256 + wc * 32 + fq * 8;
        float rs[2][4]; load_rstd(rowss, row0, fq, rs);
#pragma unroll
        for (int ai = 0; ai < 2; ++ai)
#pragma unroll
            for (int m = 0; m < 4; ++m)
#pragma unroll
                for (int bj = 0; bj < 2; ++bj) { const f32x4 v0 = acc[ai][bj][m][0] * rs[ai][m], v1 = acc[ai][bj][m][1] * rs[ai][m];
                    u32x4 w; w.x = cvt_pk_bf16(v0[0], v0[1]); w.y = cvt_pk_bf16(v0[2], v0[3]); w.z = cvt_pk_bf16(v1[0], v1[1]); w.w = cvt_pk_bf16(v1[2], v1[3]);
                    *(u32x4*)(out + (size_t)(row0 + ai * 128 + m * 16) * ldc + col0 + bj * 128) = w; }
    }
};
struct EpiF32 {
    using acc_t = f32x4; static constexpr bool I8 = false;
    float* out; int ldc; const float* rowss;
    __device__ __forceinline__ void operator()(const f32x4 (&acc)[2][2][4][2], const Unit& u, int wr, int wc, int fr, int fq) const {
        const int row0 = u.pm * 256 + wr * 64 + fr, col0 = u.pn * 256 + wc * 32 + fq * 8;
        float rs[2][4]; load_rstd(rowss, row0, fq, rs);
#pragma unroll
        for (int ai = 0; ai < 2; ++ai)
#pragma unroll
            for (int m = 0; m < 4; ++m)
#pragma unroll
                for (int bj = 0; bj < 2; ++bj) { float* p = out + (size_t)(row0 + ai * 128 + m * 16) * ldc + col0 + bj * 128;
                    *(f32x4*)p = acc[ai][bj][m][0] * rs[ai][m]; *(f32x4*)(p + 4) = acc[ai][bj][m][1] * rs[ai][m]; }
    }
};
constexpr float C2 = 0.125f * LOG2E;
template <bool Q> struct WinAcc { using t = f32x4; }; template <> struct WinAcc<true> { using t = i32x4; };
template <int V> struct EpiWin {
    static constexpr bool I8 = (V != 2); using acc_t = typename WinAcc<I8>::t;
    unsigned char* R; const float* rowss; const LAS float* tab; const float* g0; const float* g1; const float* g2; const float* g3;
    template <bool NORM>
    __device__ __forceinline__ void emit(const acc_t (&acc)[2][2][4][2], int row0, int fq, const float (&rs)[2][4], const f32x4 (&cs)[2][2], bf16_t* out, int pitch, const float* gain, float post) const {
        f32x4 gv[2][2];
#pragma unroll
        for (int bj = 0; bj < 2; ++bj)
#pragma unroll
            for (int n = 0; n < 2; ++n) gv[bj][n] = NORM ? *(const f32x4*)(gain + 32 * bj + 8 * fq + 4 * n) * post : (f32x4){1.f, 1.f, 1.f, 1.f};
#pragma unroll
        for (int ai = 0; ai < 2; ++ai)
#pragma unroll
            for (int m = 0; m < 4; ++m) {
                f32x4 v[2][2]; float ss = 0.f;
#pragma unroll
                for (int bj = 0; bj < 2; ++bj)
#pragma unroll
                    for (int n = 0; n < 2; ++n) {
                        if constexpr (I8) v[bj][n] = __builtin_convertvector(acc[ai][bj][m][n], f32x4) * (cs[bj][n] * rs[ai][m]); else v[bj][n] = acc[ai][bj][m][n] * rs[ai][m];
                        const f32x4 t = v[bj][n]; ss += (t[0] * t[0] + t[1] * t[1]) + (t[2] * t[2] + t[3] * t[3]); }
                float inv = 1.f;
                if (NORM) { ss = sum_xor32(sum_xor16(ss)); inv = __builtin_amdgcn_rsqf(ss * (1.0f / 64.0f) + EPS); }
#pragma unroll
                for (int bj = 0; bj < 2; ++bj) { const f32x4 a = v[bj][0] * gv[bj][0] * inv, b = v[bj][1] * gv[bj][1] * inv;
                    u32x4 w; w.x = cvt_pk_bf16(a[0], a[1]); w.y = cvt_pk_bf16(a[2], a[3]); w.z = cvt_pk_bf16(b[0], b[1]); w.w = cvt_pk_bf16(b[2], b[3]);
                    *(u32x4*)(out + (size_t)(row0 + ai * 128 + m * 16) * pitch + 32 * bj + 8 * fq) = w; }
            }
    }
    __device__ __forceinline__ void operator()(const acc_t (&acc)[2][2][4][2], const Unit& u, int wr, int wc, int fr, int fq) const {
        const int row0 = u.pm * 256 + wr * 64 + fr; const int g = 4 * u.pn + wc;
        float rs[2][4]; f32x4 cs[2][2];
        if constexpr (I8) {
            const LAS float* T = tab + u.ui * 512;
#pragma unroll
            for (int ai = 0; ai < 2; ++ai)
#pragma unroll
                for (int m = 0; m < 4; ++m) rs[ai][m] = T[wr * 64 + fr + ai * 128 + m * 16];
#pragma unroll
            for (int bj = 0; bj < 2; ++bj)
#pragma unroll
                for (int n = 0; n < 2; ++n) cs[bj][n] = *(const LAS f32x4*)(T + 256 + bj * 128 + wc * 32 + n * 16 + 4 * fq);
        } else {
            load_rstd(rowss, row0, fq, rs);
#pragma unroll
            for (int bj = 0; bj < 2; ++bj)
#pragma unroll
                for (int n = 0; n < 2; ++n) cs[bj][n] = (f32x4){1.f, 1.f, 1.f, 1.f};
        }
        if constexpr (V == 1) {
            if (g < 16) emit<true>(acc, row0, fq, rs, cs, (bf16_t*)(R + R_CQ) + 64 * g, 1024, g0, C2);
            else if (g < 32) emit<true>(acc, row0, fq, rs, cs, (bf16_t*)(R + R_CK) + 64 * (g - 16), 1024, g1, 1.0f);
            else emit<false>(acc, row0, fq, rs, cs, (bf16_t*)(R + R_CV) + 64 * (g - 32), 1024, nullptr, 1.0f);
        } else if constexpr (V == 0) {
            if (g < 8) emit<true>(acc, row0, fq, rs, cs, (bf16_t*)(R + R_AQ) + 64 * g, 512, g0, C2);
            else if (g < 16) emit<true>(acc, row0, fq, rs, cs, (bf16_t*)(R + R_AK) + 64 * (g - 8), 512, g1, 1.0f);
            else if (g < 24) emit<false>(acc, row0, fq, rs, cs, (bf16_t*)(R + R_AV) + 64 * (g - 16), 512, nullptr, 1.0f);
            else if (g < 32) emit<true>(acc, row0, fq, rs, cs, (bf16_t*)(R + R_BQ) + 64 * (g - 24), 512, g2, C2);
            else if (g < 40) emit<true>(acc, row0, fq, rs, cs, (bf16_t*)(R + R_BK) + 64 * (g - 32), 512, g3, 1.0f);
            else emit<false>(acc, row0, fq, rs, cs, (bf16_t*)(R + R_BV) + 64 * (g - 40), 512, nullptr, 1.0f);
        } else {
            if (g < 8) emit<false>(acc, row0, fq, rs, cs, (bf16_t*)(R + R_IQ) + 64 * g, 512, nullptr, 1.0f);
            else if (g == 8) emit<true>(acc, row0, fq, rs, cs, (bf16_t*)(R + R_IK), 64, g0, 1.0f);
            else if (g == 9) {
                if (fq == 0) {
                    float* iw = (float*)(R + R_IW);
#pragma unroll
                    for (int ai = 0; ai < 2; ++ai)
#pragma unroll
                        for (int m = 0; m < 4; ++m) { float* p = iw + (size_t)(row0 + ai * 128 + m * 16) * 8;
                            *(f32x4*)p = acc[ai][0][m][0] * rs[ai][m]; *(f32x4*)(p + 4) = acc[ai][0][m][1] * rs[ai][m]; }
                }
            }
        }
    }
};

enum { MAP_P8 = 0, MAP_GU = 1, MAP_H64_L0 = 2, MAP_H64_L1 = 3, MAP_H64Q_L0 = 4, MAP_H64I_L0 = 5 };
__device__ __forceinline__ int conv_src(int mode, int Tg, int& which) {
    const int pn = Tg >> 8, T = Tg & 255, bj = T >> 7, wc = (T >> 5) & 3, n = (T >> 4) & 1, fq = (T >> 2) & 3, j = T & 3;
    which = 0;
    if (mode == MAP_P8) return 256 * pn + 128 * bj + 32 * wc + 8 * fq + 4 * n + j;
    if (mode == MAP_GU) { which = n; return 128 * pn + 32 * wc + 8 * fq + 4 * bj + j; }
    const int Lu = 64 * wc + 32 * bj + 8 * fq + 4 * n + j;
    if (mode == MAP_H64_L1) return 256 * pn + Lu;
    const int g = 4 * pn + (Lu >> 6), d = Lu & 63;
    if (mode == MAP_H64Q_L0) return g < 24 ? g * 64 + d : 2120 + (g - 24) * 64 + d;
    if (mode == MAP_H64I_L0) { if (g < 8) return 1536 + g * 64 + d; if (g == 8) return 2048 + d; if (g == 9) return d < 8 ? 2112 + d : -1; return -1; }
    if (g < 32) return g * 64 + d;
    if (g == 32) return 2048 + d;
    if (g == 33) return d < 8 ? 2112 + d : -1;
    if (g < 58) return 2120 + (g - 34) * 64 + d;
    return -1;
}
__device__ __forceinline__ void conv_load(const float* src0, const float* src1, const float* gain, int Nsrc, int Nrows, int mode, int item, int lane, f32x4 (&v)[8]) {
    const int nT = Nrows / 32, kb = item / nT, tb = item % nT, k0 = 64 * kb, T0 = 32 * tb;
    int which; const int col = conv_src(mode, T0 + 4 * (lane & 7), which);
    const size_t sel = which ? (size_t)(src1 - src0) : (size_t)0;
    const float* src = src0 + sel; const int kr = lane >> 3;
#pragma unroll
    for (int i = 0; i < 8; ++i) { const int kk = 8 * i + kr;
        f32x4 t = (f32x4){0.f, 0.f, 0.f, 0.f}; if (col >= 0) { t = *(const f32x4*)(src + (size_t)(k0 + kk) * Nsrc + col); if (gain) t = t * gain[k0 + kk]; }
        v[i] = t; }
}
__device__ __forceinline__ void conv_store(bf16_t* dst, int K, int Nrows, int item, LAS float* scr, int lane, const f32x4 (&v)[8]) {
    const int nT = Nrows / 32, kb = item / nT, tb = item % nT, k0 = 64 * kb, T0 = 32 * tb;
    const int tq = lane & 7, kr = lane >> 3;
#pragma unroll
    for (int i = 0; i < 8; ++i) { LAS float* p = scr + (8 * i + kr) * 33 + 4 * tq; p[0] = v[i][0]; p[1] = v[i][1]; p[2] = v[i][2]; p[3] = v[i][3]; }
    asm volatile("s_waitcnt lgkmcnt(0)" ::: "memory");
    const int c = lane & 7;
#pragma unroll
    for (int j = 0; j < 4; ++j) { const int n = (lane >> 3) + 8 * j; const LAS float* s = scr + (8 * c) * 33 + n;
        u32x4 o; o.x = cvt_pk_bf16(s[0 * 33], s[1 * 33]); o.y = cvt_pk_bf16(s[2 * 33], s[3 * 33]); o.z = cvt_pk_bf16(s[4 * 33], s[5 * 33]); o.w = cvt_pk_bf16(s[6 * 33], s[7 * 33]);
        *(u32x4*)(dst + (size_t)(T0 + n) * K + k0 + 8 * c) = o; }
    asm volatile("s_waitcnt lgkmcnt(0)" ::: "memory");
}
template <int MODE>
__device__ __forceinline__ void convq_item(const float* wg, const float* wu, int Nsrc, const float* gain, signed char* dst, float* sb, int item, LAS float* scr, LAS float* xch, int wave, int lane) {
    const int T0 = 32 * item, tq = lane & 7, kr = lane >> 3;
    int which; const int col = conv_src(MODE, T0 + 4 * tq, which);
    const size_t sel = which ? (size_t)(wu - wg) : (size_t)0; const float* src = wg + sel;
    f32x4 v[2][8]; f32x4 mx = (f32x4){0.f, 0.f, 0.f, 0.f};
#pragma unroll
    for (int kbi = 0; kbi < 2; ++kbi)
#pragma unroll
        for (int i = 0; i < 8; ++i) { const int k = 64 * (2 * wave + kbi) + 8 * i + kr; const f32x4 t = *(const f32x4*)(src + (size_t)k * Nsrc + col) * gain[k]; v[kbi][i] = t;
            mx[0] = fmaxf(mx[0], fabsf(t[0])); mx[1] = fmaxf(mx[1], fabsf(t[1])); mx[2] = fmaxf(mx[2], fabsf(t[2])); mx[3] = fmaxf(mx[3], fabsf(t[3])); }
#pragma unroll
    for (int j = 0; j < 4; ++j) { float m_ = mx[j]; m_ = fmaxf(m_, __shfl_xor(m_, 8)); m_ = fmaxf(m_, __shfl_xor(m_, 16)); m_ = fmaxf(m_, __shfl_xor(m_, 32)); mx[j] = m_; }
    if (kr == 0) { LAS float* p = xch + wave * 32 + 4 * tq; p[0] = mx[0]; p[1] = mx[1]; p[2] = mx[2]; p[3] = mx[3]; }
    asm volatile("s_waitcnt lgkmcnt(0)" ::: "memory"); __syncthreads();
    f32x4 inv;
#pragma unroll
    for (int j = 0; j < 4; ++j) { float c = 0.f;
#pragma unroll
        for (int w = 0; w < 8; ++w) c = fmaxf(c, xch[w * 32 + 4 * tq + j]);
        inv[j] = c > 0.f ? 127.0f / c : 0.f; if (wave == 0 && kr == 0) sb[T0 + 4 * tq + j] = c > 0.f ? c * (1.0f / 127.0f) : 1.0f; }
    const int c8 = lane & 7;
#pragma unroll
    for (int kbi = 0; kbi < 2; ++kbi) {
#pragma unroll
        for (int i = 0; i < 8; ++i) { LAS float* p = scr + (8 * i + kr) * 33 + 4 * tq; const f32x4 t = v[kbi][i] * inv; p[0] = __builtin_rintf(t[0]); p[1] = __builtin_rintf(t[1]); p[2] = __builtin_rintf(t[2]); p[3] = __builtin_rintf(t[3]); }
        asm volatile("s_waitcnt lgkmcnt(0)" ::: "memory");
#pragma unroll
        for (int jj = 0; jj < 4; ++jj) { const int n = (lane >> 3) + 8 * jj; const LAS float* s = scr + (8 * c8) * 33 + n;
            const unsigned lo = (unsigned)((int)s[0 * 33] & 0xff) | ((unsigned)((int)s[1 * 33] & 0xff) << 8) | ((unsigned)((int)s[2 * 33] & 0xff) << 16) | ((unsigned)(int)s[3 * 33] << 24);
            const unsigned hi = (unsigned)((int)s[4 * 33] & 0xff) | ((unsigned)((int)s[5 * 33] & 0xff) << 8) | ((unsigned)((int)s[6 * 33] & 0xff) << 16) | ((unsigned)(int)s[7 * 33] << 24);
            *(u32x2*)(dst + (size_t)(T0 + n) * D + 64 * (2 * wave + kbi) + 8 * c8) = (u32x2){lo, hi}; }
        asm volatile("s_waitcnt lgkmcnt(0)" ::: "memory");
    }
    __syncthreads();
}
__device__ __forceinline__ void row_load(const float* xrow, int lane, f32x4 (&v)[4]) {
    const f32x4* xr = (const f32x4*)xrow + lane;
#pragma unroll
    for (int j = 0; j < 4; ++j) v[j] = xr[64 * j];
}
__device__ __forceinline__ void row_to_q8(const f32x4 (&v)[4], signed char* qrow, float* dq, float* ssp, int lane) {
    float s = 0.f;
#pragma unroll
    for (int j = 0; j < 4; ++j) s += (v[j].x * v[j].x + v[j].y * v[j].y) + (v[j].z * v[j].z + v[j].w * v[j].w);
    s = wave_sum(s);
    const float q = (127.0f / QRANGE) * __builtin_amdgcn_rsqf(s * (1.0f / D) + EPS);
    unsigned* o4 = (unsigned*)qrow + lane;
#pragma unroll
    for (int j = 0; j < 4; ++j) o4[64 * j] = q8_pack4(v[j], q);
    if (lane < 16) ssp[lane] = lane == 0 ? s : 0.f;
    if (lane == 0) *dq = 1.0f / q;
}
__device__ __forceinline__ void row_to_bf16(const float* xrow, bf16_t* orow, float* ssp, int lane) {
    const f32x4* xr = (const f32x4*)xrow + lane; f32x4 v[4]; float s = 0.f;
#pragma unroll
    for (int j = 0; j < 4; ++j) { v[j] = xr[64 * j]; s += (v[j].x * v[j].x + v[j].y * v[j].y) + (v[j].z * v[j].z + v[j].w * v[j].w); }
    s = wave_sum(s);
    u32x2* o8 = (u32x2*)orow + lane;
#pragma unroll
    for (int j = 0; j < 4; ++j) { u32x2 w; w.x = cvt_pk_bf16(v[j].x, v[j].y); w.y = cvt_pk_bf16(v[j].z, v[j].w); o8[64 * j] = w; }
    if (lane < 16) ssp[lane] = lane == 0 ? s : 0.f;
}

__device__ __forceinline__ void glds16(const void* gsrc, unsigned lds_dst) { unsigned keep;
    asm volatile("s_mov_b32 %0, m0\n\ts_mov_b32 m0, %2\n\ts_nop 0\n\tglobal_load_lds_dwordx4 %1, off\n\ts_mov_b32 m0, %0" : "=&s"(keep) : "v"(gsrc), "s"(lds_dst) : "memory"); }
#define WAITV_BAR(N) do { asm volatile("s_waitcnt vmcnt(" #N ") lgkmcnt(0)" ::: "memory"); __builtin_amdgcn_s_barrier(); asm volatile("" ::: "memory"); } while (0)
#define DMA_SYNC() do { asm volatile("s_waitcnt vmcnt(0) lgkmcnt(0)" ::: "memory"); __syncthreads(); } while (0)
__device__ __forceinline__ int crow(int r, int hi) { return (r & 3) + 8 * (r >> 2) + 4 * hi; }
enum { AM_T5 = 0, AM_T5_BITMAP = 1, AM_BAND = 2, AM_MEM = 3 };
constexpr int ATT_NS = 4;
constexpr int ATT_LUT_OFF = 135168, ATT_WSF_OFF = ATT_LUT_OFF + 2560;
typedef short v4i16_t __attribute__((ext_vector_type(4)));
__device__ __forceinline__ s16x4 vtr(const LAS unsigned char* p) { return __builtin_bit_cast(s16x4, __builtin_amdgcn_ds_read_tr16_b64_v4i16((LAS v4i16_t*)p)); }
__device__ __forceinline__ void glds16x2(const void* g0, unsigned d0, const void* g1, unsigned d1) { unsigned keep;
    asm volatile("s_mov_b32 %0, m0\n\ts_mov_b32 m0, %3\n\ts_nop 0\n\tglobal_load_lds_dwordx4 %1, off\n\ts_mov_b32 m0, %4\n\ts_nop 0\n\tglobal_load_lds_dwordx4 %2, off\n\ts_mov_b32 m0, %0"
                 : "=&s"(keep) : "v"(g0), "v"(g1), "s"(d0), "s"(d1) : "memory"); }
__device__ __forceinline__ void glds16x3(const void* g0, unsigned d0, const void* g1, unsigned d1, const void* g2, unsigned d2) { unsigned keep;
    asm volatile("s_mov_b32 %0, m0\n\ts_mov_b32 m0, %4\n\ts_nop 0\n\tglobal_load_lds_dwordx4 %1, off\n\ts_mov_b32 m0, %5\n\ts_nop 0\n\tglobal_load_lds_dwordx4 %2, off\n\t"
                 "s_mov_b32 m0, %6\n\ts_nop 0\n\tglobal_load_lds_dwordx4 %3, off\n\ts_mov_b32 m0, %0"
                 : "=&s"(keep) : "v"(g0), "v"(g1), "v"(g2), "s"(d0), "s"(d1), "s"(d2) : "memory"); }
__device__ __forceinline__ void glds16x2_4(const void* g0, unsigned d0, const void* g1, unsigned d1, const void* g2, unsigned d2) { unsigned keep;
    asm volatile("s_mov_b32 %0, m0\n\ts_mov_b32 m0, %4\n\ts_nop 0\n\tglobal_load_lds_dwordx4 %1, off\n\ts_mov_b32 m0, %5\n\ts_nop 0\n\tglobal_load_lds_dwordx4 %2, off\n\t"
                 "s_mov_b32 m0, %6\n\ts_nop 0\n\tglobal_load_lds_dword %3, off\n\ts_mov_b32 m0, %0"
                 : "=&s"(keep) : "v"(g0), "v"(g1), "v"(g2), "s"(d0), "s"(d1), "s"(d2) : "memory"); }
__device__ __forceinline__ void glds4(const void* gsrc, unsigned lds_dst) { unsigned keep;
    asm volatile("s_mov_b32 %0, m0\n\ts_mov_b32 m0, %2\n\ts_nop 0\n\tglobal_load_lds_dword %1, off\n\ts_mov_b32 m0, %0" : "=&s"(keep) : "v"(gsrc), "s"(lds_dst) : "memory"); }
template <int N> __device__ __forceinline__ void waitv_bar() { asm volatile("s_waitcnt vmcnt(%0) lgkmcnt(0)" :: "n"(N) : "memory"); __builtin_amdgcn_s_barrier(); asm volatile("" ::: "memory"); }

template <int DQK, int DV, int MODE>
__device__ __forceinline__ void attn_unit(LAS unsigned char* lds, const bf16_t* __restrict__ Q, int qpitch, const bf16_t* __restrict__ K, int kpitch, const bf16_t* __restrict__ V, int vpitch,
                                          bf16_t* O, int opitch, int q0, const float* lut, const unsigned* bitmapT, const float* qgain) {
    constexpr int KB = 64 * DQK * 2, VB = 64 * DV * 2, NKP = DQK / 64, NVP = DV / 64;
    constexpr int BMB = (MODE == AM_T5_BITMAP) ? 2048 : 0, SLOT = KB + VB + BMB;
    constexpr int ND = (NKP + NVP) + (MODE == AM_T5_BITMAP ? 1 : 0);
    constexpr int NKS = DQK / 16, NDB = DV / 32;
    constexpr int EOFF = (MODE == AM_BAND) ? 575 : 191, LUTN = (MODE == AM_BAND) ? 640 : 256;
    static_assert(ATT_NS * SLOT <= ATT_LUT_OFF && 8 * 32 * DV * 2 <= ATT_LUT_OFF, "attention LDS map");
    int tid = threadIdx.x; asm volatile("" : "+v"(tid));
    const int lane = tid & 63, r32 = lane & 31, hi = lane >> 5; const int wid = __builtin_amdgcn_readfirstlane(tid >> 6);
    const int qrow = q0 + 32 * wid + r32;
    const int cqw = (q0 + 32 * wid) >> 6;
    int tlo, thi, wlo, whi;
    if (MODE == AM_MEM) { tlo = 0; thi = 3; wlo = 0; whi = 3; }
    else if (MODE == AM_BAND) { tlo = (q0 >> 6) - 8; if (tlo < 0) tlo = 0; thi = (q0 + 255) >> 6; wlo = cqw - 8; if (wlo < 0) wlo = 0; whi = cqw; }
    else { tlo = 0; thi = (q0 + 255) >> 6; wlo = 0; whi = cqw; }
    LAS float* lutl = (LAS float*)(lds + ATT_LUT_OFF);
    LAS float* wsf = (LAS float*)(lds + ATT_WSF_OFF) + wid * 64;
    const unsigned ldsb = (unsigned)(uintptr_t)lds;
#define ATT_KSRC(t, p_) (K + (size_t)((t) * 64 + lane) * kpitch + (wid + 8 * (p_)) * 8)
#define ATT_KDST(p_) ((unsigned)__builtin_amdgcn_readfirstlane((int)(sb_ + (wid + 8 * (p_)) * 1024)))
#define ATT_VSRC(t, p_) (V + (size_t)((t) * 64 + 16 * ((wid + 8 * (p_)) & 3) + (lane >> 2)) * vpitch + 32 * ((wid + 8 * (p_)) >> 2) + (lane & 3) * 8)
#define ATT_VDST(p_) ((unsigned)__builtin_amdgcn_readfirstlane((int)(sb_ + KB + (wid + 8 * (p_)) * 1024)))
#define ATT_DMA(t) do { const unsigned sb_ = (unsigned)__builtin_amdgcn_readfirstlane((int)(ldsb + (((t) - tlo) & 3) * SLOT)); \
        if (MODE == AM_T5_BITMAP && NKP == 1 && NVP == 1) glds16x2_4(ATT_KSRC(t, 0), ATT_KDST(0), ATT_VSRC(t, 0), ATT_VDST(0), bitmapT + (size_t)(2 * (t) + hi) * S + qrow, (unsigned)__builtin_amdgcn_readfirstlane((int)(sb_ + KB + VB + wid * 256))); \
        else if (MODE != AM_T5_BITMAP && NKP == 1 && NVP == 1) glds16x2(ATT_KSRC(t, 0), ATT_KDST(0), ATT_VSRC(t, 0), ATT_VDST(0)); \
        else if (MODE != AM_T5_BITMAP && NKP == 1 && NVP == 2) glds16x3(ATT_KSRC(t, 0), ATT_KDST(0), ATT_VSRC(t, 0), ATT_VDST(0), ATT_VSRC(t, 1), ATT_VDST(1)); \
        else { \
        _Pragma("unroll") for (int p_ = 0; p_ < NKP; ++p_) glds16(ATT_KSRC(t, p_), ATT_KDST(p_)); \
        _Pragma("unroll") for (int p_ = 0; p_ < NVP; ++p_) glds16(ATT_VSRC(t, p_), ATT_VDST(p_)); \
        if (MODE == AM_T5_BITMAP) glds4(bitmapT + (size_t)(2 * (t) + hi) * S + qrow, (unsigned)__builtin_amdgcn_readfirstlane((int)(sb_ + KB + VB + wid * 256))); } \
    } while (0)
    ATT_DMA(tlo); if (tlo + 1 <= thi) ATT_DMA(tlo + 1); if (tlo + 2 <= thi) ATT_DMA(tlo + 2);
    bf16x8 qr[NKS];
    if (MODE == AM_MEM) {
        float qf[NKS][8]; float ss = 0.f;
#pragma unroll
        for (int d0 = 0; d0 < NKS; ++d0) { const bf16x8 t = *(const bf16x8*)(Q + (size_t)qrow * qpitch + d0 * 16 + hi * 8);
#pragma unroll
            for (int j = 0; j < 8; ++j) { qf[d0][j] = bf2f((unsigned short)t[j]); ss += qf[d0][j] * qf[d0][j]; } }
        ss += __shfl_xor(ss, 32);
        const float inv = (1.0f / sqrtf(ss * (1.0f / DQK) + EPS)) * (LOG2E / sqrtf((float)DQK));
#pragma unroll
        for (int d0 = 0; d0 < NKS; ++d0) { const f32x4 ga = *(const f32x4*)(qgain + d0 * 16 + hi * 8), gb = *(const f32x4*)(qgain + d0 * 16 + hi * 8 + 4);
            u32x4 w; w.x = cvt_pk_bf16(qf[d0][0] * inv * ga[0], qf[d0][1] * inv * ga[1]); w.y = cvt_pk_bf16(qf[d0][2] * inv * ga[2], qf[d0][3] * inv * ga[3]);
            w.z = cvt_pk_bf16(qf[d0][4] * inv * gb[0], qf[d0][5] * inv * gb[1]); w.w = cvt_pk_bf16(qf[d0][6] * inv * gb[2], qf[d0][7] * inv * gb[3]);
            qr[d0] = __builtin_bit_cast(bf16x8, w); }
    } else {
#pragma unroll
        for (int d0 = 0; d0 < NKS; ++d0) qr[d0] = *(const bf16x8*)(Q + (size_t)qrow * qpitch + d0 * 16 + hi * 8);
    }
    if (MODE != AM_MEM) { for (int i = tid; i < LUTN; i += NTHREADS) lutl[i] = lut[i]; }
#pragma unroll
    for (int d0 = 0; d0 < NKS; ++d0) asm volatile("" : "+v"(qr[d0]));
    asm volatile("s_waitcnt vmcnt(0)" ::: "memory");
    f32x16 o[NDB];
#pragma unroll
    for (int d = 0; d < NDB; ++d) o[d] = f32x16{};
    float l_reg = 0.f;
    const int qoff = (32 * wid + r32 + q0) & 63;
    const int vb0 = ((lane >> 4) & 1) * 32 + (lane & 3) * 8 + (4 * hi + ((lane & 15) >> 2)) * 64;
    constexpr int NQK = 2 * NKS, CH = 32 / NQK;
    constexpr bool PIPE = (MODE != AM_MEM);
    f32x16 c0 = f32x16{}, c1 = f32x16{};
#define ATT_KFRAG(kb_, i) (*(const LAS bf16x8*)((kb_) + (2 * ((i) >> 1) + hi) * 1024 + (32 * ((i) & 1) + r32) * 16))
#define ATT_QK1(kb_, i, n0, n1) do { if ((i) == 0) n0 = __builtin_amdgcn_mfma_f32_32x32x16_bf16(ATT_KFRAG(kb_, i), qr[0], f32x16{}, 0, 0, 0); \
                                     else if ((i) == 1) n1 = __builtin_amdgcn_mfma_f32_32x32x16_bf16(ATT_KFRAG(kb_, i), qr[0], f32x16{}, 0, 0, 0); \
                                     else if (((i) & 1) == 0) n0 = __builtin_amdgcn_mfma_f32_32x32x16_bf16(ATT_KFRAG(kb_, i), qr[(i) >> 1], n0, 0, 0, 0); \
                                     else n1 = __builtin_amdgcn_mfma_f32_32x32x16_bf16(ATT_KFRAG(kb_, i), qr[(i) >> 1], n1, 0, 0, 0); } while (0)
#define ATT_SMB4(cv, b, bwv, P) asm volatile( \
        "v_exp_f32 %0, %7\n\tv_exp_f32 %1, %8\n\tv_exp_f32 %2, %9\n\tv_exp_f32 %3, %10\n\t" \
        "v_bfe_i32 %5, %11, %12, 1\n\tv_bfe_i32 %6, %11, %13, 1\n\tv_and_b32 %0, %0, %5\n\tv_and_b32 %1, %1, %6\n\t" \
        "v_bfe_i32 %5, %11, %14, 1\n\tv_bfe_i32 %6, %11, %15, 1\n\tv_and_b32 %2, %2, %5\n\tv_and_b32 %3, %3, %6\n\t" \
        "v_add_f32 %4, %4, %0\n\tv_add_f32 %4, %4, %1\n\tv_add_f32 %4, %4, %2\n\tv_add_f32 %4, %4, %3" \
        : "=&v"(pe[P]), "=&v"(pe[(P) + 1]), "=&v"(pe[(P) + 2]), "=&v"(pe[(P) + 3]), "+v"(sacc), "=&v"(tm0_), "=&v"(tm1_) \
        : "v"(cv[b]), "v"(cv[(b) + 1]), "v"(cv[(b) + 2]), "v"(cv[(b) + 3]), "v"(bwv), "n"(2 * (b)), "n"(2 * (b) + 1), "n"(2 * (b) + 2), "n"(2 * (b) + 3))
#define ATT_SMX4(cv, b, P) asm volatile( \
        "v_exp_f32 %0, %5\n\tv_exp_f32 %1, %6\n\tv_exp_f32 %2, %7\n\tv_exp_f32 %3, %8\n\t" \
        "v_add_f32 %4, %4, %0\n\tv_add_f32 %4, %4, %1\n\tv_add_f32 %4, %4, %2\n\tv_add_f32 %4, %4, %3" \
        : "=&v"(pe[P]), "=&v"(pe[(P) + 1]), "=&v"(pe[(P) + 2]), "=&v"(pe[(P) + 3]), "+v"(sacc) \
        : "v"(cv[b]), "v"(cv[(b) + 1]), "v"(cv[(b) + 2]), "v"(cv[(b) + 3]))
#define ATT_SM1(i) do { if (MODE == AM_T5_BITMAP) { float tm0_, tm1_; if ((i) < 4) ATT_SMB4(c0, 4 * (i), bw0, 4 * (i)); else ATT_SMB4(c1, 4 * ((i) - 4), bw1, 16 + 4 * ((i) - 4)); } \
    else if (MODE != AM_MEM) { if ((i) < 4) ATT_SMX4(c0, 4 * (i), 4 * (i)); else ATT_SMX4(c1, 4 * ((i) - 4), 16 + 4 * ((i) - 4)); } else \
    _Pragma("unroll") for (int v_ = CH * (i); v_ < CH * (i) + CH; ++v_) { \
        if (v_ < 16) { float e_ = __builtin_amdgcn_exp2f(c0[v_]); if (MODE == AM_T5_BITMAP) e_ = __uint_as_float(__float_as_uint(e_) & (unsigned)__builtin_amdgcn_sbfe((int)bw0, (v_ & 3) + 8 * (v_ >> 2), 1)); asm volatile("" : "+v"(e_)); c0[v_] = e_; sacc += e_; } \
        else { const int u_ = v_ - 16; float e_ = __builtin_amdgcn_exp2f(c1[u_]); if (MODE == AM_T5_BITMAP) e_ = __uint_as_float(__float_as_uint(e_) & (unsigned)__builtin_amdgcn_sbfe((int)bw1, (u_ & 3) + 8 * (u_ >> 2), 1)); asm volatile("" : "+v"(e_)); c1[u_] = e_; sacc += e_; } } \
        asm volatile("" : "+v"(sacc)); } while (0)
    if (tlo + 2 <= thi) waitv_bar<2 * ND>(); else if (tlo + 1 <= thi) waitv_bar<ND>(); else waitv_bar<0>();
    if (PIPE) {   const LAS unsigned char* kb = lds;
#pragma unroll
        for (int i = 0; i < NQK; ++i) ATT_QK1(kb, i, c0, c1);
        asm volatile("s_nop 7\n\ts_nop 7\n\ts_nop 3" : "+v"(c0), "+v"(c1));
    }
    for (int t = tlo; t <= thi; ++t) {
        const bool has_next = PIPE && (t + 1 <= thi);
        const bool nxt_act = has_next && (t + 1 >= wlo) && (t + 1 <= whi);
        if (!PIPE) { if (t > tlo) { if (t + 2 <= thi) waitv_bar<2 * ND>(); else if (t + 1 <= thi) waitv_bar<ND>(); else waitv_bar<0>(); } }
        else if (has_next) { if (t + 2 <= thi) waitv_bar<ND>(); else waitv_bar<0>(); }
        if (!PIPE && t + 3 <= thi) ATT_DMA(t + 3);
        const LAS unsigned char* kcur = lds + ((t - tlo) & 3) * SLOT; const LAS unsigned char* vbuf = kcur + KB;
        const LAS unsigned char* knxt = lds + ((t + 1 - tlo) & 3) * SLOT;
        f32x16 n0, n1;
        if (!PIPE) {
            bf16x8 kq[4];
#pragma unroll
            for (int i = 0; i < 4; ++i) kq[i] = ATT_KFRAG(kcur, i);
#pragma unroll
            for (int i = 0; i < NQK; ++i) {
                if (i == 0) c0 = __builtin_amdgcn_mfma_f32_32x32x16_bf16(kq[0], qr[0], f32x16{}, 0, 0, 0);
                else if (i == 1) c1 = __builtin_amdgcn_mfma_f32_32x32x16_bf16(kq[1], qr[0], f32x16{}, 0, 0, 0);
                else if ((i & 1) == 0) c0 = __builtin_amdgcn_mfma_f32_32x32x16_bf16(kq[i & 3], qr[i >> 1], c0, 0, 0, 0);
                else c1 = __builtin_amdgcn_mfma_f32_32x32x16_bf16(kq[i & 3], qr[i >> 1], c1, 0, 0, 0);
                if (i + 4 < NQK) kq[i & 3] = ATT_KFRAG(kcur, i + 4);
            }
        }
        const bool act = (t >= wlo && t <= whi);
        constexpr int NPV = NDB * 4;
        float pe[32]; s16x4 vlo[4], vhi[4];
#define ATT_VLD(j) do { vlo[(j) & 3] = vtr(vbuf + vb0 + ((j) >> 2) * 4096 + ((j) & 3) * 1024); vhi[(j) & 3] = vtr(vbuf + vb0 + ((j) >> 2) * 4096 + ((j) & 3) * 1024 + 512); } while (0)
        if (act) {
            unsigned bw0 = 0, bw1 = 0;
            if (MODE == AM_T5_BITMAP) { const LAS unsigned* bw = (const LAS unsigned*)(vbuf + VB + wid * 256); bw0 = bw[r32] >> (4 * hi); bw1 = bw[32 + r32] >> (4 * hi); }
            if (MODE != AM_MEM) {
                const int dt = cqw - t;
                if (dt <= (MODE == AM_BAND ? 4 : 2)) {
                    const LAS float* lp = lutl + (EOFF - 64 * dt - qoff + 4 * hi);
#pragma unroll
                    for (int r = 0; r < 16; ++r) { c0[r] += lp[(r & 3) + 8 * (r >> 2)]; c1[r] += lp[32 + (r & 3) + 8 * (r >> 2)]; }
                }
            }
            float sacc = 0.f;
            bf16x8 kf[4];
            if (nxt_act) {
#pragma unroll
                for (int i = 0; i < 4; ++i) kf[i] = ATT_KFRAG(knxt, i);
                __builtin_amdgcn_sched_barrier(0);
#pragma unroll
                for (int i = 0; i < NQK; ++i) {
                    ATT_SM1(i);
                    __builtin_amdgcn_sched_barrier(0);
                    if (i == 0) n0 = __builtin_amdgcn_mfma_f32_32x32x16_bf16(kf[0], qr[0], f32x16{}, 0, 0, 0);
                    else if (i == 1) n1 = __builtin_amdgcn_mfma_f32_32x32x16_bf16(kf[1], qr[0], f32x16{}, 0, 0, 0);
                    else if ((i & 1) == 0) n0 = __builtin_amdgcn_mfma_f32_32x32x16_bf16(kf[i & 3], qr[i >> 1], n0, 0, 0, 0);
                    else n1 = __builtin_amdgcn_mfma_f32_32x32x16_bf16(kf[i & 3], qr[i >> 1], n1, 0, 0, 0);
                    if (i + 4 < NQK) kf[i & 3] = ATT_KFRAG(knxt, i + 4);
                    else ATT_VLD(i + 4 - NQK);
                    __builtin_amdgcn_sched_barrier(0);
                }
            } else {
#pragma unroll
                for (int j = 0; j < 4; ++j) ATT_VLD(j);
#pragma unroll
                for (int i = 0; i < NQK; ++i) ATT_SM1(i);
            }
            l_reg += sacc;
        } else if (nxt_act) {
#pragma unroll
            for (int i = 0; i < NQK; ++i) ATT_QK1(knxt, i, n0, n1);
        }
        if (PIPE && t + 3 <= thi) ATT_DMA(t + 3);
        if (act) {
            bf16x8 pw[4];
#pragma unroll
            for (int ks = 0; ks < 2; ++ks) {
                u32x4 a, c;
#define ATT_P0(v) (MODE != AM_MEM ? pe[v] : c0[v])
#define ATT_P1(v) (MODE != AM_MEM ? pe[16 + (v)] : c1[v])
                a.x = cvt_pk_bf16(ATT_P0(8 * ks + 0), ATT_P0(8 * ks + 1)); a.y = cvt_pk_bf16(ATT_P0(8 * ks + 2), ATT_P0(8 * ks + 3)); a.z = cvt_pk_bf16(ATT_P0(8 * ks + 4), ATT_P0(8 * ks + 5)); a.w = cvt_pk_bf16(ATT_P0(8 * ks + 6), ATT_P0(8 * ks + 7));
                c.x = cvt_pk_bf16(ATT_P1(8 * ks + 0), ATT_P1(8 * ks + 1)); c.y = cvt_pk_bf16(ATT_P1(8 * ks + 2), ATT_P1(8 * ks + 3)); c.z = cvt_pk_bf16(ATT_P1(8 * ks + 4), ATT_P1(8 * ks + 5)); c.w = cvt_pk_bf16(ATT_P1(8 * ks + 6), ATT_P1(8 * ks + 7));
#undef ATT_P0
#undef ATT_P1
                pw[ks] = __builtin_bit_cast(bf16x8, a); pw[2 + ks] = __builtin_bit_cast(bf16x8, c);
            }
            __builtin_amdgcn_sched_barrier(0);
#pragma unroll
            for (int j = 0; j < NPV; ++j) {
                const bf16x8 vf = (bf16x8){vlo[j & 3][0], vlo[j & 3][1], vlo[j & 3][2], vlo[j & 3][3], vhi[j & 3][0], vhi[j & 3][1], vhi[j & 3][2], vhi[j & 3][3]};
                o[j >> 2] = __builtin_amdgcn_mfma_f32_32x32x16_bf16(pw[j & 3], vf, o[j >> 2], 0, 0, 0);
                if (j + 4 < NPV) ATT_VLD(j + 4);
                __builtin_amdgcn_sched_barrier(0);
            }
        }
#undef ATT_VLD
        if (PIPE) { c0 = n0; c1 = n1; }
    }
#undef ATT_KFRAG
#undef ATT_QK1
#undef ATT_SM1
#undef ATT_SMB4
#undef ATT_SMX4
#undef ATT_DMA
#undef ATT_KSRC
#undef ATT_KDST
#undef ATT_VSRC
#undef ATT_VDST
    waitv_bar<0>();
    l_reg += __shfl_xor(l_reg, 32);
    if (hi == 0) wsf[r32] = l_reg;
    asm volatile("s_waitcnt lgkmcnt(0)" ::: "memory");
    float rli[16];
#pragma unroll
    for (int r = 0; r < 16; ++r) rli[r] = 1.0f / wsf[crow(r, hi)];
    LAS bf16_t* stg = (LAS bf16_t*)lds + wid * (32 * DV);
#pragma unroll
    for (int r = 0; r < 16; ++r) { const int orow = crow(r, hi);
#pragma unroll
        for (int db = 0; db < NDB; ++db) stg[orow * DV + db * 32 + r32] = (bf16_t)f2bf(o[db][r] * rli[r]); }
    asm volatile("s_waitcnt lgkmcnt(0)" ::: "memory");
    constexpr int LPR = DV / 8, RPI = 64 / LPR;
#pragma unroll
    for (int i = 0; i < 32 / RPI; ++i) { const int row = i * RPI + lane / LPR, ch = lane % LPR;
        const u32x4 v = *(const LAS u32x4*)(stg + row * DV + ch * 8);
        *(u32x4*)(O + (size_t)(q0 + 32 * wid + row) * opitch + ch * 8) = v; }
    DMA_SYNC();
}

constexpr int SEL_NB = 1024, SEL_TIECAP = 128, SEL_POOLCAP = 2048;
__device__ __forceinline__ void sel_pool_put(unsigned* pool, LAS unsigned* pcnt, float s, unsigned kq) {
    const unsigned g = __hip_atomic_fetch_add(pcnt, 1u, __ATOMIC_RELAXED, __HIP_MEMORY_SCOPE_WORKGROUP);
    if (g < (unsigned)SEL_POOLCAP) { __hip_atomic_store(pool + 2 * g, __float_as_uint(s), __ATOMIC_RELAXED, __HIP_MEMORY_SCOPE_AGENT); __hip_atomic_store(pool + 2 * g + 1, kq, __ATOMIC_RELAXED, __HIP_MEMORY_SCOPE_AGENT); }
}
__device__ __forceinline__ unsigned sel_pool_get(unsigned* pool, unsigned i) { return __hip_atomic_load(pool + i, __ATOMIC_RELAXED, __HIP_MEMORY_SCOPE_AGENT); }
constexpr int SEL_HIST_OFF = 0, SEL_TIE_OFF = 65536, SEL_IK_OFF = 98304, SEL_QI_OFF = 131072;
__device__ __forceinline__ void dsa_select_unit(LAS unsigned char* lds, int u, const bf16_t* __restrict__ iq, const bf16_t* __restrict__ ik, const float* __restrict__ iw, const float* __restrict__ ikgain, unsigned* bitmapT, unsigned* pool) {
    int tid = threadIdx.x; asm volatile("" : "+v"(tid));
    const int lane = tid & 63, r32 = lane & 31, hc = lane >> 5; const int wid = __builtin_amdgcn_readfirstlane(tid >> 6);
    const int cq = u >> 1, NT = cq + 1, qbase = 32 * u;
    if (cq <= 3) {
        for (int i = tid; i < 2 * NT * 32; i += NTHREADS) bitmapT[(size_t)(i >> 5) * S + qbase + (i & 31)] = 0xffffffffu;
        return;
    }
    LAS unsigned* hist = (LAS unsigned*)(lds + SEL_HIST_OFF);
    LAS unsigned* tie = (LAS unsigned*)(lds + SEL_TIE_OFF);
    LAS float* qinfo = (LAS float*)(lds + SEL_QI_OFF);
    const int rr = r32, half_r = (rr >> 2) & 1, reggrp = rr >> 4, head_r = ((rr >> 3) & 1) * 4 + (rr & 3), qi_r = 2 * half_r + reggrp;
    const int qrow_r = qbase + 4 * wid + qi_r;
    bf16x8 af[4]; float nrm = 0.f; float afv[4][8];
#pragma unroll
    for (int ks = 0; ks < 4; ++ks) { const bf16x8 t = *(const bf16x8*)(iq + (size_t)qrow_r * 512 + head_r * 64 + ks * 16 + hc * 8);
#pragma unroll
        for (int j = 0; j < 8; ++j) { afv[ks][j] = bf2f((unsigned short)t[j]); nrm += afv[ks][j] * afv[ks][j]; } }
    nrm += __shfl_xor(nrm, 32); nrm = sqrtf(nrm);
    float kmax = fabsf(ikgain[lane]);
#pragma unroll
    for (int o_ = 1; o_ < 64; o_ <<= 1) kmax = fmaxf(kmax, __shfl_xor(kmax, o_));
    kmax *= 8.0f * 1.02f;
    const float bound = nrm * kmax, rs_ = bound > 0.f ? 1.0f / bound : 0.f;
#pragma unroll
    for (int ks = 0; ks < 4; ++ks) { u32x4 w; w.x = cvt_pk_bf16(afv[ks][0] * rs_, afv[ks][1] * rs_); w.y = cvt_pk_bf16(afv[ks][2] * rs_, afv[ks][3] * rs_);
        w.z = cvt_pk_bf16(afv[ks][4] * rs_, afv[ks][5] * rs_); w.w = cvt_pk_bf16(afv[ks][6] * rs_, afv[ks][7] * rs_);
        af[ks] = __builtin_bit_cast(bf16x8, w); }
    LAS float* wtab = qinfo + 256;
    { const float wp = iw[(size_t)qrow_r * 8 + head_r] * bound;
      float cp = fmaxf(wp, 0.f), cm = fmaxf(-wp, 0.f);
      cp += __shfl_xor(cp, 1); cp += __shfl_xor(cp, 2); cp += __shfl_xor(cp, 8);
      cm += __shfl_xor(cm, 1); cm += __shfl_xor(cm, 2); cm += __shfl_xor(cm, 8);
      if (hc == 0) { const int ql = 4 * wid + qi_r; wtab[ql * 8 + head_r] = wp;
          if (head_r == 0) { const float lo_ = -cm, rng_ = fmaxf(cp + cm, 1e-20f); qinfo[ql * 8 + 0] = lo_; qinfo[ql * 8 + 1] = ((float)SEL_NB * (1.0f - 4e-6f)) / rng_; qinfo[ql * 8 + 4] = 0.f; } } }
    for (int i = tid; i < 32 * 512 / 4; i += NTHREADS) ((LAS u32x4*)hist)[i] = (u32x4){0u, 0u, 0u, 0u};
    LAS unsigned* pcnt = (LAS unsigned*)(qinfo + 512);
    if (tid == 0) *pcnt = 0u;
    DMA_SYNC();
    const int ql0 = 4 * wid + 2 * hc, ql1 = ql0 + 1;
    float wv[16];
#pragma unroll
    for (int i = 0; i < 16; ++i) wv[i] = wtab[(ql0 + (i >> 3)) * 8 + (i & 7)];
    float lo0 = qinfo[ql0 * 8 + 0], inv0 = qinfo[ql0 * 8 + 1], lo1 = qinfo[ql1 * 8 + 0], inv1 = qinfo[ql1 * 8 + 1];
#pragma unroll
    for (int i = 0; i < 16; ++i) asm volatile("" : "+v"(wv[i]));
#pragma unroll
    for (int ks = 0; ks < 4; ++ks) asm volatile("" : "+v"(af[ks]));
    lo0 = -lo0 * inv0 + 1e-3f; lo1 = -lo1 * inv1 + 1e-3f;
    asm volatile("" : "+v"(lo0), "+v"(inv0), "+v"(lo1), "+v"(inv1));
    const unsigned ikdst = (unsigned)__builtin_amdgcn_readfirstlane((int)((unsigned)(uintptr_t)lds + SEL_IK_OFF + wid * 1024));
#define SEL_DMA(t) glds16(ik + (size_t)((t) * 64 + lane) * 64 + wid * 8, (unsigned)__builtin_amdgcn_readfirstlane((int)(ikdst + (((t) & 3) * 8192))))
#define SEL_RELU(x) __builtin_amdgcn_fmed3f((x), 0.f, 1.0f)
#define SEL_FMAC(acc, a, b) do { float b_ = (b); asm volatile("v_fmac_f32 %0, %1, %2" : "+v"(acc) : "v"(a), "v"(b_)); } while (0)
#define SEL_FRAG(kb_, i) (*(const LAS bf16x8*)((kb_) + (2 * ((i) >> 1) + hc) * 1024 + (32 * ((i) & 1) + r32) * 16))
#define SEL_REDUCE1(A0, A1, i) do { float t0_, t1_; asm volatile( \
        "v_max_f32_e64 %4, %7, %7 clamp\n\tv_max_f32_e64 %5, %8, %8 clamp\n\tv_fmac_f32 %0, %6, %4\n\tv_fmac_f32 %1, %11, %5\n\t" \
        "v_max_f32_e64 %4, %9, %9 clamp\n\tv_max_f32_e64 %5, %10, %10 clamp\n\tv_fmac_f32 %2, %6, %4\n\tv_fmac_f32 %3, %11, %5" \
        : "+v"(sc[0][0]), "+v"(sc[0][1]), "+v"(sc[1][0]), "+v"(sc[1][1]), "=&v"(t0_), "=&v"(t1_) \
        : "v"(wv[i]), "v"(A0[i]), "v"(A0[8 + (i)]), "v"(A1[i]), "v"(A1[8 + (i)]), "v"(wv[8 + (i)])); } while (0)
#define SEL_LOOP_BEGIN() SEL_DMA(0); if (NT > 1) SEL_DMA(1); if (NT > 2) SEL_DMA(2); \
    WAITV_BAR(0); \
    f32x16 a0 = f32x16{}, a1 = f32x16{}, n0 = f32x16{}, n1 = f32x16{}; \
    { const LAS unsigned char* kb0_ = lds + SEL_IK_OFF; bf16x8 bfr_[8]; \
      _Pragma("unroll") for (int i = 0; i < 8; ++i) bfr_[i] = SEL_FRAG(kb0_, i); \
      _Pragma("unroll") for (int i = 0; i < 8; ++i) { if ((i & 1) == 0) a0 = __builtin_amdgcn_mfma_f32_32x32x16_bf16(af[i >> 1], bfr_[i], a0, 0, 0, 0); else a1 = __builtin_amdgcn_mfma_f32_32x32x16_bf16(af[i >> 1], bfr_[i], a1, 0, 0, 0); } } \
    asm volatile("s_nop 7\n\ts_nop 7\n\ts_nop 3" : "+v"(a0), "+v"(a1));
#define SEL_STEP(A0, A1, N0, N1, t, BODY, FIRST) do { \
        const bool has_next = (t) + 1 < NT; \
        if (FIRST) WAITV_BAR(0);                                      \
        float sc[2][2] = {{0.f, 0.f}, {0.f, 0.f}}; \
        if (has_next) { const LAS unsigned char* kbn_ = lds + SEL_IK_OFF + (((t) + 1) & 3) * 8192; bf16x8 bfr_[8]; \
            _Pragma("unroll") for (int i = 0; i < 8; ++i) bfr_[i] = SEL_FRAG(kbn_, i); \
            __builtin_amdgcn_sched_barrier(0); \
            _Pragma("unroll") for (int i = 0; i < 8; ++i) { \
                if (i == 0) N0 = __builtin_amdgcn_mfma_f32_32x32x16_bf16(af[0], bfr_[0], f32x16{}, 0, 0, 0); \
                else if (i == 1) N1 = __builtin_amdgcn_mfma_f32_32x32x16_bf16(af[0], bfr_[1], f32x16{}, 0, 0, 0); \
                else if ((i & 1) == 0) N0 = __builtin_amdgcn_mfma_f32_32x32x16_bf16(af[i >> 1], bfr_[i], N0, 0, 0, 0); else N1 = __builtin_amdgcn_mfma_f32_32x32x16_bf16(af[i >> 1], bfr_[i], N1, 0, 0, 0); \
                SEL_REDUCE1(A0, A1, i); __builtin_amdgcn_sched_barrier(0); } \
        } else { _Pragma("unroll") for (int i = 0; i < 8; ++i) SEL_REDUCE1(A0, A1, i); } \
        if (FIRST) { if ((t) + 3 < NT) SEL_DMA((t) + 3); if ((t) + 4 < NT) SEL_DMA((t) + 4); }     \
        BODY(t) } while (0)
#define SEL_LOOP(BODY) for (int t = 0; t < NT; t += 2) { SEL_STEP(a0, a1, n0, n1, t, BODY, true); if (t + 1 < NT) SEL_STEP(n0, n1, a0, a1, t + 1, BODY, false); }
#define SEL_F(s, nlo_, inv_) ({ float f_; asm("v_fma_f32 %0, %1, %2, %3" : "=v"(f_) : "v"(s), "v"(inv_), "v"(nlo_)); f_; })
    LAS unsigned* hrow = hist + (ql0 >> 1) * SEL_NB;
#define SEL_BODY1(t) _Pragma("unroll") for (int sub = 0; sub < 2; ++sub) { \
            const unsigned b0 = (unsigned)(int)SEL_F(sc[sub][0], lo0, inv0) & (unsigned)(SEL_NB - 1), b1 = (unsigned)(int)SEL_F(sc[sub][1], lo1, inv1) & (unsigned)(SEL_NB - 1); \
            __hip_atomic_fetch_add(hrow + b0, 1u, __ATOMIC_RELAXED, __HIP_MEMORY_SCOPE_WORKGROUP); \
            __hip_atomic_fetch_add(hrow + b1, 65536u, __ATOMIC_RELAXED, __HIP_MEMORY_SCOPE_WORKGROUP); }
    { SEL_LOOP_BEGIN() SEL_LOOP(SEL_BODY1) }
#undef SEL_BODY1
    DMA_SYNC();
    for (int qi = 0; qi < 4; ++qi) {
        const int ql = 4 * wid + qi;
        unsigned hw[16];
        { const LAS u32x4* hp = (const LAS u32x4*)(hist + (ql >> 1) * SEL_NB + 16 * lane); const int sh = 16 * (ql & 1);
#pragma unroll
          for (int j = 0; j < 4; ++j) { const u32x4 h4 = hp[j]; hw[4 * j + 0] = (h4.x >> sh) & 0xffffu; hw[4 * j + 1] = (h4.y >> sh) & 0xffffu; hw[4 * j + 2] = (h4.z >> sh) & 0xffffu; hw[4 * j + 3] = (h4.w >> sh) & 0xffffu; } }
        unsigned ls = 0;
#pragma unroll
        for (int j = 0; j < 16; ++j) ls += hw[j];
        unsigned suf = ls;
#pragma unroll
        for (int d = 1; d < 64; d <<= 1) { const unsigned t_ = __shfl_down(suf, d); if (lane + d < 64) suf += t_; }
        const unsigned excl = suf - ls;
        if (excl < 256u && suf >= 256u) {
            unsigned c = excl; int bstar = -1; unsigned cgt = 0;
#pragma unroll
            for (int bb = 15; bb >= 0; --bb) { const unsigned cnt = hw[bb];
                if (bstar < 0) { if (c + cnt >= 256u) { bstar = 16 * lane + bb; cgt = c; } else c += cnt; } }
            qinfo[ql * 8 + 2] = __int_as_float(bstar); qinfo[ql * 8 + 3] = __uint_as_float(cgt);
        }
    }
    DMA_SYNC();
    const int bs0 = __float_as_int(qinfo[ql0 * 8 + 2]), bs1 = __float_as_int(qinfo[ql1 * 8 + 2]);
    LAS unsigned* bm = hist;
    LAS unsigned* tcnt0 = (LAS unsigned*)(qinfo + ql0 * 8 + 4); LAS unsigned* tcnt1 = (LAS unsigned*)(qinfo + ql1 * 8 + 4);
    const float fl0 = (float)bs0, fh0 = (float)(bs0 + 1), fl1 = (float)bs1, fh1 = (float)(bs1 + 1);
#define SEL_BODY2(t) _Pragma("unroll") for (int sub = 0; sub < 2; ++sub) { \
            const float s0 = sc[sub][0], s1 = sc[sub][1]; \
            const float f0 = SEL_F(s0, lo0, inv0), f1 = SEL_F(s1, lo1, inv1); \
            const unsigned long long m0 = __ballot(f0 >= fh0), m1 = __ballot(f1 >= fh1); \
            if (r32 == 0) { bm[(2 * (t) + sub) * 32 + ql0] = hc ? (unsigned)(m0 >> 32) : (unsigned)m0; bm[(2 * (t) + sub) * 32 + ql1] = hc ? (unsigned)(m1 >> 32) : (unsigned)m1; } \
            const unsigned key = (unsigned)((t) * 64 + sub * 32 + r32); \
            const bool t0_ = (f0 >= fl0) && !(f0 >= fh0), t1_ = (f1 >= fl1) && !(f1 >= fh1); \
            if (__ballot(t0_ || t1_) != 0ull) {                  \
                if (t0_) { const unsigned slot = __hip_atomic_fetch_add(tcnt0, 1u, __ATOMIC_RELAXED, __HIP_MEMORY_SCOPE_WORKGROUP); \
                    if (slot < SEL_TIECAP) { tie[(ql0 * SEL_TIECAP + slot) * 2] = __float_as_uint(s0); tie[(ql0 * SEL_TIECAP + slot) * 2 + 1] = key; } \
                    else sel_pool_put(pool, pcnt, s0, key | ((unsigned)ql0 << 16)); } \
                if (t1_) { const unsigned slot = __hip_atomic_fetch_add(tcnt1, 1u, __ATOMIC_RELAXED, __HIP_MEMORY_SCOPE_WORKGROUP); \
                    if (slot < SEL_TIECAP) { tie[(ql1 * SEL_TIECAP + slot) * 2] = __float_as_uint(s1); tie[(ql1 * SEL_TIECAP + slot) * 2 + 1] = key; } \
                    else sel_pool_put(pool, pcnt, s1, key | ((unsigned)ql1 << 16)); } } }
    { SEL_LOOP_BEGIN() SEL_LOOP(SEL_BODY2) }
#undef SEL_BODY2
    DMA_SYNC();
#undef SEL_STEP
#undef SEL_LOOP
#undef SEL_F
#undef SEL_LOOP_BEGIN
#undef SEL_DMA
#undef SEL_FRAG
#undef SEL_REDUCE1
#undef SEL_RELU
#undef SEL_FMAC
    const unsigned pn = min(*pcnt, (unsigned)SEL_POOLCAP);
    LAS unsigned* pl = (LAS unsigned*)(lds + SEL_IK_OFF);
    if (pn) { for (unsigned i = tid; i < 2 * pn; i += NTHREADS) pl[i] = sel_pool_get(pool, i); DMA_SYNC(); }
    for (int qi = 0; qi < 4; ++qi) {
        const int ql = 4 * wid + qi;
        const unsigned tot = *(LAS unsigned*)(qinfo + ql * 8 + 4);
        const unsigned n = min(tot, (unsigned)SEL_TIECAP);
        const unsigned need = 256u - __float_as_uint(qinfo[ql * 8 + 3]);
        const LAS unsigned* tl = tie + ql * SEL_TIECAP * 2;
        if (tot <= (unsigned)SEL_TIECAP) {
            for (unsigned i0 = 0; i0 < n; i0 += 64) {
                const unsigned i = i0 + lane; const bool act = i < n;
                const float si = act ? __uint_as_float(tl[2 * i]) : 0.f; const unsigned ki = act ? tl[2 * i + 1] : 0u;
                unsigned rank = 0;
                for (unsigned j = 0; j < n; ++j) { const float sj = __uint_as_float(tl[2 * j]); const unsigned kj = tl[2 * j + 1]; rank += (sj > si || (sj == si && kj < ki)) ? 1u : 0u; }
                if (act && rank < need) __hip_atomic_fetch_or(bm + (ki >> 5) * 32 + ql, 1u << (ki & 31u), __ATOMIC_RELAXED, __HIP_MEMORY_SCOPE_WORKGROUP);
            }
        } else {
            const unsigned nt = n + pn;
#define SEL_ENT(i, valid, us, kr) do { unsigned sb_, kq_; if ((i) < n) { sb_ = tl[2 * (i)]; kq_ = tl[2 * (i) + 1] | ((unsigned)ql << 16); } else { sb_ = pl[2 * ((i) - n)]; kq_ = pl[2 * ((i) - n) + 1]; } \
            valid = (kq_ >> 16) == (unsigned)ql; sb_ = (sb_ == 0x80000000u) ? 0u : sb_; us = sb_ ^ ((unsigned)((int)sb_ >> 31) | 0x80000000u); kr = 16383u - (kq_ & 0xffffu); } while (0)
            if (nt <= 512u) {
                unsigned eu[8], ek[8]; bool ev[8];
#pragma unroll
                for (int r = 0; r < 8; ++r) { const unsigned i = 64u * r + lane; ev[r] = false; eu[r] = 0u; ek[r] = 0u; if (i < nt) SEL_ENT(i, ev[r], eu[r], ek[r]); }
                unsigned ts = 0u;
                for (int bit = 31; bit >= 0; --bit) { const unsigned cand = ts | (1u << bit); unsigned c = 0u;
#pragma unroll
                    for (int r = 0; r < 8; ++r) c += (unsigned)__popcll(__ballot(ev[r] && eu[r] >= cand));
                    if (c >= need) ts = cand; }
                unsigned cg = 0u;
#pragma unroll
                for (int r = 0; r < 8; ++r) cg += (unsigned)__popcll(__ballot(ev[r] && eu[r] > ts));
                const unsigned need2 = need - cg;
                unsigned kt = 0u;
                for (int bit = 13; bit >= 0; --bit) { const unsigned cand = kt | (1u << bit); unsigned c = 0u;
#pragma unroll
                    for (int r = 0; r < 8; ++r) c += (unsigned)__popcll(__ballot(ev[r] && eu[r] == ts && ek[r] >= cand));
                    if (c >= need2) kt = cand; }
#pragma unroll
                for (int r = 0; r < 8; ++r) if (ev[r] && (eu[r] > ts || (eu[r] == ts && ek[r] >= kt))) { const unsigned ki = 16383u - ek[r];
                    __hip_atomic_fetch_or(bm + (ki >> 5) * 32 + ql, 1u << (ki & 31u), __ATOMIC_RELAXED, __HIP_MEMORY_SCOPE_WORKGROUP); }
            } else {
            unsigned ts = 0u;
            for (int bit = 31; bit >= 0; --bit) { const unsigned cand = ts | (1u << bit); unsigned c = 0u;
                for (unsigned i0 = 0; i0 < nt; i0 += 64) { const unsigned i = i0 + lane; bool v = false; unsigned us = 0u, kr = 0u; if (i < nt) SEL_ENT(i, v, us, kr); c += (unsigned)__popcll(__ballot(v && us >= cand)); }
                if (c >= need) ts = cand; }
            unsigned cg = 0u;
            for (unsigned i0 = 0; i0 < nt; i0 += 64) { const unsigned i = i0 + lane; bool v = false; unsigned us = 0u, kr = 0u; if (i < nt) SEL_ENT(i, v, us, kr); cg += (unsigned)__popcll(__ballot(v && us > ts)); }
            const unsigned need2 = need - cg;
            unsigned kt = 0u;
            for (int bit = 13; bit >= 0; --bit) { const unsigned cand = kt | (1u << bit); unsigned c = 0u;
                for (unsigned i0 = 0; i0 < nt; i0 += 64) { const unsigned i = i0 + lane; bool v = false; unsigned us = 0u, kr = 0u; if (i < nt) SEL_ENT(i, v, us, kr); c += (unsigned)__popcll(__ballot(v && us == ts && kr >= cand)); }
                if (c >= need2) kt = cand; }
            for (unsigned i = lane; i < nt; i += 64) { bool v; unsigned us, kr; SEL_ENT(i, v, us, kr);
                if (v && (us > ts || (us == ts && kr >= kt))) { const unsigned ki = 16383u - kr; __hip_atomic_fetch_or(bm + (ki >> 5) * 32 + ql, 1u << (ki & 31u), __ATOMIC_RELAXED, __HIP_MEMORY_SCOPE_WORKGROUP); } }
            }
#undef SEL_ENT
        }
    }
    DMA_SYNC();
    for (int i = tid; i < 2 * NT * 32; i += NTHREADS) bitmapT[(size_t)(i >> 5) * S + qbase + (i & 31)] = bm[i];
    DMA_SYNC();
}

#define XB_TMO      128
#define XB_XCNT(j)  (256  + 64 * (j))
#define XB_XSUB(j)  (1280 + 64 * (j))
#define XB_XGEN(j)  (2304 + 64 * (j))
#define XB_TOP      3328
#define XB_TOPGEN   3392
#define XCD_BAR_WORDS 3456
#define XB_SPIN_CAP (1u << 22)
__device__ __forceinline__ unsigned xb_ld(unsigned* p)              { return __hip_atomic_load(p, __ATOMIC_RELAXED, __HIP_MEMORY_SCOPE_AGENT); }
__device__ __forceinline__ unsigned xb_add(unsigned* p, unsigned v) { return __hip_atomic_fetch_add(p, v, __ATOMIC_RELAXED, __HIP_MEMORY_SCOPE_AGENT); }
__device__ __forceinline__ unsigned xb_xcc_id() { return (unsigned)__builtin_amdgcn_s_getreg((3 << 11) | 20) & 0xFu; }
#define XB_SPIN(cond, bar) do { unsigned _sp = 0; while (cond) { __builtin_amdgcn_s_sleep(1); \
    if ((++_sp & 255u) == 0u) { if (xb_ld(&(bar)[XB_TMO])) break; if (_sp > XB_SPIN_CAP) { atomicAdd(&(bar)[XB_TMO], 1u); break; } } } } while (0)
struct XcdBarrier { unsigned* bar; unsigned x; volatile LAS unsigned* st; };
__device__ __forceinline__ XcdBarrier xcd_barrier_post(unsigned* bar, volatile LAS unsigned* st) {
    XcdBarrier b; b.bar = bar; b.x = xb_xcc_id(); b.st = st;
    return b;
}
__device__ __forceinline__ void xcd_barrier_complete(unsigned* bar, unsigned x, unsigned& nloc, unsigned& nx) {
    const unsigned G = gridDim.x * gridDim.y * gridDim.z;
    unsigned sum, cnt, mine, sp = 0u;
    for (;;) {
        sum = 0u; cnt = 0u; mine = 0u;
#pragma unroll
        for (unsigned j = 0; j < 16; ++j) { const unsigned c = xb_ld(&bar[XB_XCNT(j)]); sum += c; cnt += (c > 0u) ? 1u : 0u; mine = (j == x) ? c : mine; }
        if (sum == G) break;
        __builtin_amdgcn_s_sleep(1);
        if ((++sp & 255u) == 0u) { if (xb_ld(&bar[XB_TMO])) break; if (sp > XB_SPIN_CAP) { atomicAdd(&bar[XB_TMO], 1u); break; } }
    }
    nloc = mine > 0u ? mine : 1u; nx = cnt > 0u ? cnt : 1u;
}
__device__ __forceinline__ void xcd_barrier(const XcdBarrier& b) {
    asm volatile("s_waitcnt vmcnt(0)" ::: "memory");
    __syncthreads();
    if (threadIdx.x == 0) {
        unsigned* bar = b.bar;
        __builtin_amdgcn_s_waitcnt(0);
        unsigned nloc = b.st[0], nx = b.st[1];
        if (nloc == 0u) { xcd_barrier_complete(bar, b.x, nloc, nx); b.st[0] = nloc; b.st[1] = nx; }
        const unsigned old = xb_add(&bar[XB_XSUB(b.x)], 1u);
        const unsigned gen = old / nloc;
        if (old + 1u == (gen + 1u) * nloc) {
            __builtin_amdgcn_fence(__ATOMIC_RELEASE, "agent");
            asm volatile("s_waitcnt vmcnt(0)" ::: "memory");
            const unsigned og = xb_add(&bar[XB_TOP], 1u);
            const unsigned tg = og / nx;
            if (og + 1u == (tg + 1u) * nx) xb_add(&bar[XB_TOPGEN], 1u);
            else XB_SPIN(xb_ld(&bar[XB_TOPGEN]) == tg, bar);
            __builtin_amdgcn_fence(__ATOMIC_ACQUIRE, "agent");
            xb_add(&bar[XB_XGEN(b.x)], 1u);
            asm volatile("s_waitcnt vmcnt(0)" ::: "memory");
        } else {
            XB_SPIN(xb_ld(&bar[XB_XGEN(b.x)]) == gen, bar);
            __builtin_amdgcn_fence(__ATOMIC_ACQUIRE, "agent");
            asm volatile("s_waitcnt vmcnt(0)" ::: "memory");
        }
    }
    __syncthreads();
}

struct Args { const float* in[52]; float* out; unsigned char* ws; int ph_lo, ph_hi; };
enum { P_CONV = 0, P_KV, P_GU1, P_D1, P_WIN, P_MIXA, P_MIXB, P_MIXC, P_WOUT, P_WQ, P_MATT, P_WO, P_GU2, P_D2, P_PER_LAYER };
constexpr int PH_END = 2 * P_PER_LAYER;
#ifndef DBG_LAST
#define DBG_LAST PH_END
#endif

#define CONV_RUN(src0, src1, gain, dst, Nsrc, K, Nrows, mode) do { const int nitems_ = ((Nrows) / 32) * ((K) / 64); \
    f32x4 va_[8], vb_[8]; int it_ = gw; \
    if (it_ < nitems_) conv_load(src0, src1, gain, Nsrc, Nrows, mode, it_, lane, va_); \
    while (it_ < nitems_) { \
        if (it_ + NGW < nitems_) conv_load(src0, src1, gain, Nsrc, Nrows, mode, it_ + NGW, lane, vb_); \
        conv_store(dst, K, Nrows, it_, scr, lane, va_); it_ += NGW; if (it_ >= nitems_) break; \
        if (it_ + NGW < nitems_) conv_load(src0, src1, gain, Nsrc, Nrows, mode, it_ + NGW, lane, va_); \
        conv_store(dst, K, Nrows, it_, scr, lane, vb_); it_ += NGW; } } while (0)

__device__ __forceinline__ int t5_bucket(int rel) {
    const int off = rel < 0 ? 16 : 0; const int n = rel < 0 ? -rel : rel;
    if (n < 8) return off + n;
    int large = 8 + (int)(logf((float)n / 8.0f) / 2.772588722239781f * 8.0f);
    if (n == 64) large = 13;
    if (large > 15) large = 15;
    return off + large;
}

template <int L>
__device__ __forceinline__ void run_layer(const Args& a, LAS unsigned char* lds, cg::grid_group& grid, const XcdBarrier& xbar, int lo, int hi) {
    const int tid = threadIdx.x, lane = tid & 63, wave = __builtin_amdgcn_readfirstlane(tid >> 6);
    const int G = gridDim.x, bx = blockIdx.x;
    const int gw = bx * 8 + wave, NGW = G * 8;
    const int vcu = (G % 8 == 0) ? (bx % 8) * (G / 8) + bx / 8 : bx;
    unsigned char* ws = a.ws;
    constexpr int IB = (L == 0) ? 3 : 31;
    constexpr int MB = IB + ((L == 0) ? 17 : 10);
    constexpr int PB = L * P_PER_LAYER;
#define IN(k) (lo <= (PB + (k)) && (PB + (k)) < hi)
#define SYNC(k) do { if (IN(k) && (PB + (k) + 1) < hi) { if (PB + (k) == 0) { \
        if (bx == 0) { for (int i_ = threadIdx.x; i_ < XCD_BAR_WORDS; i_ += NTHREADS) __hip_atomic_store(&xbar.bar[i_], 0u, __ATOMIC_RELAXED, __HIP_MEMORY_SCOPE_AGENT); }     \
        grid.sync(); \
        if (threadIdx.x == 0) (void)xb_add(&xbar.bar[XB_XCNT(xbar.x)], 1u); } \
    else xcd_barrier(xbar); } } while (0)
    float* rsp = (float*)(ws + WS_RS); float* rsm = (float*)(ws + WS_RSM);
#define RSP(i) (rsp + (size_t)((i) & 1) * S * 16)
    bf16_t* hb = (bf16_t*)(ws + WS_HB); bf16_t* rb = (bf16_t*)a.out;
    bf16_t* osub = rb + (size_t)S * D;
    bf16_t* ocat = (bf16_t*)(ws + WS_OCAT);
    unsigned char* R = ws + WS_R;
    bf16_t* act = (bf16_t*)(R + R_ACT);
    float* lut5 = (float*)(ws + WS_LUT5); float* lutb = (float*)(ws + WS_LUTB);
    signed char* hq = (signed char*)(ws + WS_OCAT);
    float* qs = (float*)(ws + WS_QS); float* sb1 = (float*)(ws + WS_SB); float* sb2 = sb1 + 2 * FF; float* sbw = sb2 + 2 * FF;

#define CONVQ_RUN(MODE_, wg_, wu_, Nsrc_, Nrows_, gain_, dst_, sb_, first_, stride_) do { LAS float* xch_ = (LAS float*)(lds + 131072); \
        for (int it_ = (first_); it_ < (Nrows_) / 32; it_ += (stride_)) convq_item<MODE_>(wg_, wu_, Nsrc_, gain_, (signed char*)(dst_), sb_, it_, scr, xch_, wave, lane); } while (0)
#define CV_D1(IBx)   CONV_RUN(a.in[(IBx) + 3], a.in[(IBx) + 3], (const float*)nullptr, (bf16_t*)(ws + W_D1), D, FF, D, MAP_P8)
#define CV_WOUT(MBx) CONV_RUN(a.in[(MBx) - 1], a.in[(MBx) - 1], (const float*)nullptr, (bf16_t*)(ws + W_OUT), D, D, D, MAP_P8)
#define CV_WQ(MBx)   CONV_RUN(a.in[(MBx) + 2], a.in[(MBx) + 2], a.in[(MBx) + 0], (bf16_t*)(ws + W_Q), 512, D, 512, MAP_P8)
#define CV_WKV(MBx, slot_)  CONV_RUN(a.in[(MBx) + 3], a.in[(MBx) + 3], a.in[(MBx) + 1], (bf16_t*)(ws + (slot_)), D, D, D, MAP_P8)
#define CV_WO(MBx)   CONV_RUN(a.in[(MBx) + 6], a.in[(MBx) + 6], (const float*)nullptr, (bf16_t*)(ws + W_O), D, 512, D, MAP_P8)
#define CV_D2(MBx)   CONV_RUN(a.in[(MBx) + 10], a.in[(MBx) + 10], (const float*)nullptr, (bf16_t*)(ws + W_D2), D, FF, D, MAP_P8)
#define CV_GU1Q(IBx, f_, s_) CONVQ_RUN(MAP_GU, a.in[(IBx) + 1], a.in[(IBx) + 2], FF, 2 * FF, a.in[(IBx) + 0], ws + W_GU1, sb1, f_, s_)
#define CV_GU2Q(MBx, f_, s_) CONVQ_RUN(MAP_GU, a.in[(MBx) + 8], a.in[(MBx) + 9], FF, 2 * FF, a.in[(MBx) + 7], ws + W_GU2, sb2, f_, s_)
#define CV_WIN0Q(IBx, f_, s_) CONVQ_RUN(MAP_H64Q_L0, a.in[(IBx) + 5], a.in[(IBx) + 5], 3656, NWINQ, a.in[(IBx) + 4], ws + W_IN, sbw, f_, s_)
#define CV_WIN1Q(IBx, f_, s_) CONVQ_RUN(MAP_H64_L1, a.in[(IBx) + 5], a.in[(IBx) + 5], 3072, NWINQ, a.in[(IBx) + 4], ws + W_IN, sbw, f_, s_)
#define CV_WIN0I(IBx) CONV_RUN(a.in[(IBx) + 5], a.in[(IBx) + 5], a.in[(IBx) + 4], (bf16_t*)(ws + W_INI), 3656, D, NWINI, MAP_H64I_L0)
#define SIDE_BEGIN(fb, nb) if (bx >= (fb) && bx < (fb) + (nb)) { const int sf_ = bx - (fb), ss_ = (nb); const int gw = sf_ * 8 + wave, NGW = ss_ * 8; LAS float* scr = (LAS float*)(lds + wave * 16384); (void)gw; (void)NGW; (void)scr;
#define SIDE_END() }
#define KV_GEMM(cb, slot_, raw_) do { if (bx >= (cb) && bx < (cb) + 4) { \
        pg8::Gemm g_{(const bf16_t*)(ws + WS_MEMB), (const bf16_t*)(ws + (slot_)), NMEM, D, D}; pg8::StaticOrder so_; so_.init(NMEM, D, G, bx - (cb)); \
        EpiF32 E_{(float*)(ws + (raw_)), D, rsm}; pg8::gemm_phase(lds, g_, so_, E_); } } while (0)
#define KV_NORM(kgp, cb, raw_) do { if (bx >= (cb) && bx < (cb) + 8) { \
        const float* kv = (const float*)(ws + (raw_)); bf16_t* km = (bf16_t*)(ws + WS_KMEM); bf16_t* vm = (bf16_t*)(ws + WS_VMEM); const float* kg = (kgp); \
        for (int m = (bx - (cb)) * 8 + wave; m < NMEM; m += 64) { \
            const f32x4 k0 = *(const f32x4*)(kv + (size_t)m * D + 8 * lane), k1 = *(const f32x4*)(kv + (size_t)m * D + 8 * lane + 4); \
            float ss = (k0[0] * k0[0] + k0[1] * k0[1]) + (k0[2] * k0[2] + k0[3] * k0[3]) + (k1[0] * k1[0] + k1[1] * k1[1]) + (k1[2] * k1[2] + k1[3] * k1[3]); \
            ss += __shfl_xor(ss, 1); ss += __shfl_xor(ss, 2); ss += __shfl_xor(ss, 4); ss += __shfl_xor(ss, 8); \
            const float inv = 1.0f / sqrtf(ss * (1.0f / 128.0f) + EPS); \
            const int d = (8 * lane) & 127; const f32x4 ga = *(const f32x4*)(kg + d), gb = *(const f32x4*)(kg + d + 4); \
            u32x4 w; w.x = cvt_pk_bf16(k0[0] * inv * ga[0], k0[1] * inv * ga[1]); w.y = cvt_pk_bf16(k0[2] * inv * ga[2], k0[3] * inv * ga[3]); \
            w.z = cvt_pk_bf16(k1[0] * inv * gb[0], k1[1] * inv * gb[1]); w.w = cvt_pk_bf16(k1[2] * inv * gb[2], k1[3] * inv * gb[3]); \
            *(u32x4*)(km + (size_t)m * 512 + 8 * lane) = w; \
            const f32x4 v0 = *(const f32x4*)(kv + (size_t)m * D + 512 + 8 * lane), v1 = *(const f32x4*)(kv + (size_t)m * D + 512 + 8 * lane + 4); \
            u32x4 x; x.x = cvt_pk_bf16(v0[0], v0[1]); x.y = cvt_pk_bf16(v0[2], v0[3]); x.z = cvt_pk_bf16(v1[0], v1[1]); x.w = cvt_pk_bf16(v1[2], v1[3]); \
            *(u32x4*)(vm + (size_t)m * 512 + 8 * lane) = x; } } } while (0)
    const int SLK = G >> 1;

    if (L == 0 && IN(P_CONV)) {
        LAS float* scr = (LAS float*)(lds + wave * 16384);
        CV_GU1Q(3, bx, G);
        { f32x4 va[4], vb[4]; int m = gw;
          if (m < S) row_load(a.in[0] + (size_t)m * D, lane, va);
          while (m < S) {
              if (m + NGW < S) row_load(a.in[0] + (size_t)(m + NGW) * D, lane, vb);
              row_to_q8(va, hq + (size_t)m * D, qs + m, RSP(0) + (size_t)m * 16, lane); m += NGW; if (m >= S) break;
              if (m + NGW < S) row_load(a.in[0] + (size_t)(m + NGW) * D, lane, va);
              row_to_q8(vb, hq + (size_t)m * D, qs + m, RSP(0) + (size_t)m * 16, lane); m += NGW; } }
    }
    if (L == 0) SYNC(P_CONV);
    if (IN(P_GU1)) {
        pg8::Gemm g{(const bf16_t*)hq, (const bf16_t*)(ws + W_GU1), S, 2 * FF, D / 2}; pg8::StaticOrder so; so.init(S, 2 * FF, G, bx);
        LAS float* tab = (LAS float*)(lds + pg8::STAGE_BYTES); guq_prep<true>(tab, so, RSP(4 * L + 0), qs, sb1);
        EpiGUq E{act, tab};
        pg8::gemm_phase(lds, g, so, E);
        if (L == 0) { SIDE_BEGIN(SLK, G - SLK) CV_D1(3); CV_WIN0Q(3, sf_, ss_); CV_WIN0I(3); CV_WKV(20, W_KV);
        for (int m = gw; m < NMEM; m += NGW) row_to_bf16(a.in[1] + (size_t)m * D, (bf16_t*)(ws + WS_MEMB) + (size_t)m * D, rsm + (size_t)m * 16, lane);
        for (int i = sf_ * NTHREADS + tid; i < 12 * 256; i += ss_ * NTHREADS) { const int h = i >> 8, e = i & 255; const int rel = 191 - e;
            lut5[i] = (a.in[2][t5_bucket(rel) * 12 + h] - a.in[2][15 * 12 + h]) * LOG2E; }
        for (int i = sf_ * NTHREADS + tid; i < 16 * 640; i += ss_ * NTHREADS) { const int h = i / 640, e = i % 640; int rel = 575 - e; rel = rel < -256 ? -256 : (rel > 256 ? 256 : rel);
            lutb[i] = (a.in[39][(rel + 256) * 16 + h] - a.in[39][512 * 16 + h]) * LOG2E; }
            SIDE_END() }
        else { SIDE_BEGIN(SLK, G - SLK) CV_WIN1Q(31, sf_, ss_); CV_WOUT(41); CV_WQ(41); CV_WO(41); SIDE_END() }
    }
    SYNC(P_GU1);
    if (IN(P_D1)) {
        pg8::Gemm g{act, (const bf16_t*)(ws + W_D1), S, D, FF}; pg8::StaticOrder so; so.init(S, D, G, bx);
        if (L == 0) { EpiRes<true, true, false, true> E{a.in[0], rb, hq, RSP(4 * L + 1), qs, RSP(4 * L + 0)}; pg8::gemm_phase(lds, g, so, E); }
        else { EpiRes<true, false, false, true> E{rb, rb, hq, RSP(4 * L + 1), qs, RSP(4 * L + 0)}; pg8::gemm_phase(lds, g, so, E); }
    }
    SYNC(P_D1);
    if (IN(P_WIN)) {
        pg8::Gemm g{(const bf16_t*)hq, (const bf16_t*)(ws + W_IN), S, NWINQ, D / 2}; pg8::StaticOrder so; so.init(S, NWINQ, G, bx);
        LAS float* tab = (LAS float*)(lds + pg8::STAGE_BYTES); guq_prep<false>(tab, so, RSP(4 * L + 1), qs, sbw);
        if (L == 0) {
            { EpiWin<0> E{R, nullptr, tab, a.in[IB + 6], a.in[IB + 7], a.in[IB + 9], a.in[IB + 10]}; pg8::gemm_phase(lds, g, so, E); }
            pg8::Gemm gi{rb, (const bf16_t*)(ws + W_INI), S, NWINI, D}; pg8::StaticOrder si; si.init(S, NWINI, G, bx);
            EpiWin<2> Ei{R, RSP(4 * L + 1), nullptr, a.in[IB + 8], nullptr, nullptr, nullptr}; pg8::gemm_phase(lds, gi, si, Ei);
        } else { EpiWin<1> E{R, nullptr, tab, a.in[IB + 6], a.in[IB + 7], nullptr, nullptr}; pg8::gemm_phase(lds, g, so, E); }
        if (L == 0) { KV_GEMM((3 * G) >> 2, W_KV, WS_KVRAW);
            SIDE_BEGIN(((3 * G) >> 2) + 4, G - ((3 * G) >> 2) - 4) CV_WOUT(20); CV_WQ(20); CV_WO(20); CV_D1(31); CV_WKV(41, W_KV2); SIDE_END() }
    }
    SYNC(P_WIN);
    if (L == 0) {
        if (IN(P_MIXA)) {
            for (int pr = vcu; pr < 256; pr += G) {
                dsa_select_unit(lds, 511 - pr, (const bf16_t*)(R + R_IQ), (const bf16_t*)(R + R_IK), (const float*)(R + R_IW), a.in[IB + 8], (unsigned*)hb, (unsigned*)(ws + W_GU1 + 6 * MiB) + (size_t)bx * 2 * SEL_POOLCAP);
                dsa_select_unit(lds, pr, (const bf16_t*)(R + R_IQ), (const bf16_t*)(R + R_IK), (const float*)(R + R_IW), a.in[IB + 8], (unsigned*)hb, (unsigned*)(ws + W_GU1 + 6 * MiB) + (size_t)bx * 2 * SEL_POOLCAP);
            }
            for (int pr = vcu; pr < 256; pr += G) { const int hm = pr >> 5, s = pr & 31;
#pragma unroll 1
                for (int k = 0; k < 2; ++k) { const int qb = k ? s : 63 - s;
                    attn_unit<64, 128, AM_T5>(lds, (const bf16_t*)(R + R_BQ) + hm * 64, 512, (const bf16_t*)(R + R_BK) + hm * 64, 512, (const bf16_t*)(R + R_BV) + (hm >> 1) * 128, 512,
                                              osub + hm * 128, 1024, qb * 256, lut5 + (8 + (hm >> 1)) * 256, nullptr, nullptr); }
            }
        }
        SYNC(P_MIXA);
        if (IN(P_MIXB)) {
            const float lq1 = a.in[IB + 11][lane], lk1 = a.in[IB + 12][lane], lq2 = a.in[IB + 13][lane], lk2 = a.in[IB + 14][lane];
            const float lam = __expf(wave_sum(lq1 * lk1)) - __expf(wave_sum(lq2 * lk2)) + 0.2f;
            const float g0 = a.in[IB + 15][2 * lane], g1 = a.in[IB + 15][2 * lane + 1];
            unsigned wn[8];
            if (gw < S) {
#pragma unroll
                for (int j = 0; j < 8; ++j) wn[j] = *(const unsigned*)(osub + (size_t)gw * 1024 + j * 128 + 2 * lane);
            }
            for (int m = gw; m < S; m += NGW) {
                unsigned w[8];
#pragma unroll
                for (int j = 0; j < 8; ++j) w[j] = wn[j];
                if (m + NGW < S) {
#pragma unroll
                    for (int j = 0; j < 8; ++j) wn[j] = *(const unsigned*)(osub + (size_t)(m + NGW) * 1024 + j * 128 + 2 * lane);
                }
                asm volatile("" ::: "memory");
#pragma unroll
                for (int h = 0; h < 4; ++h) {
                    const float a0 = bf2f((unsigned short)(w[2 * h] & 0xffffu)) - lam * bf2f((unsigned short)(w[2 * h + 1] & 0xffffu));
                    const float a1 = bf2f((unsigned short)(w[2 * h] >> 16)) - lam * bf2f((unsigned short)(w[2 * h + 1] >> 16));
                    const float inv = 0.8f / sqrtf(wave_sum(a0 * a0 + a1 * a1) * (1.0f / 128.0f) + EPS);
                    *(unsigned*)(ocat + (size_t)m * 1024 + 512 + h * 128 + 2 * lane) = cvt_pk_bf16(a0 * inv * g0, a1 * inv * g1);
                }
            }
        }
        if (IN(P_MIXC)) {
            for (int pr = vcu; pr < 256; pr += G) { const int hd = pr >> 5, s = pr & 31;
#pragma unroll 1
                for (int k = 0; k < 2; ++k) { const int qb = k ? s : 63 - s;
                    attn_unit<64, 64, AM_T5_BITMAP>(lds, (const bf16_t*)(R + R_AQ) + hd * 64, 512, (const bf16_t*)(R + R_AK) + hd * 64, 512, (const bf16_t*)(R + R_AV) + hd * 64, 512,
                                                    ocat + hd * 64, 1024, qb * 256, lut5 + hd * 256, (const unsigned*)hb, nullptr); }
            }
        }
        SYNC(P_MIXC);
    } else {
        if (IN(P_MIXA)) {
            for (int u = vcu; u < 1024; u += G) { const int hd = u >> 6, qb = u & 63;
                attn_unit<64, 64, AM_BAND>(lds, (const bf16_t*)(R + R_CQ) + hd * 64, 1024, (const bf16_t*)(R + R_CK) + hd * 64, 1024, (const bf16_t*)(R + R_CV) + hd * 64, 1024,
                                           ocat + hd * 64, 1024, qb * 256, lutb + hd * 640, nullptr, nullptr); }
        }
        SYNC(P_MIXA);
    }
    if (IN(P_WOUT)) {
        pg8::Gemm g{ocat, (const bf16_t*)(ws + W_OUT), S, D, D}; pg8::StaticOrder so; so.init(S, D, G, bx);
        EpiRes<false, false, false, false> E{rb, rb, nullptr, RSP(4 * L + 2), nullptr, nullptr};
        pg8::gemm_phase(lds, g, so, E);
    }
    SYNC(P_WOUT);
    if (IN(P_WQ)) {
        pg8::Gemm g{rb, (const bf16_t*)(ws + W_Q), S, 512, D}; pg8::StaticOrder so; so.init(S, 512, G, bx);
        EpiBf16 E{(bf16_t*)(R + R_QM), 512, RSP(4 * L + 2)};
        pg8::gemm_phase(lds, g, so, E);
        KV_NORM(a.in[MB + 5], G - 8, L == 0 ? WS_KVRAW : WS_KVRAW2);
        if (L == 0) { KV_GEMM(G - 12, W_KV2, WS_KVRAW2);
            SIDE_BEGIN(SLK, G - SLK - 12) CV_GU2Q(20, sf_, ss_); CV_D2(20); SIDE_END() }
        else { SIDE_BEGIN(SLK, G - SLK - 8) CV_GU2Q(41, sf_, ss_); CV_D2(41); SIDE_END() }
    }
    SYNC(P_WQ);
    if (IN(P_MATT)) {
        for (int u = vcu; u < 256; u += G) { const int hd = u >> 6, qb = u & 63;
            attn_unit<128, 128, AM_MEM>(lds, (const bf16_t*)(R + R_QM) + hd * 128, 512, (const bf16_t*)(ws + WS_KMEM) + hd * 128, 512, (const bf16_t*)(ws + WS_VMEM) + hd * 128, 512,
                                        (bf16_t*)(R + R_OM) + hd * 128, 512, qb * 256, nullptr, nullptr, a.in[MB + 4]); }
    }
    SYNC(P_MATT);
    if (IN(P_WO)) {
        pg8::Gemm g{(const bf16_t*)(R + R_OM), (const bf16_t*)(ws + W_O), S, D, 512}; pg8::StaticOrder so; so.init(S, D, G, bx);
        EpiRes<false, false, false, true> E{rb, L == 1 ? hb : rb, hq, RSP(4 * L + 3), qs, RSP(4 * L + 2)};
        pg8::gemm_phase(lds, g, so, E);
    }
    SYNC(P_WO);
    if (IN(P_GU2)) {
        pg8::Gemm g{(const bf16_t*)hq, (const bf16_t*)(ws + W_GU2), S, 2 * FF, D / 2}; pg8::StaticOrder so; so.init(S, 2 * FF, G, bx);
        LAS float* tab = (LAS float*)(lds + pg8::STAGE_BYTES); guq_prep<true>(tab, so, RSP(4 * L + 3), qs, sb2);
        EpiGUq E{act, tab};
        pg8::gemm_phase(lds, g, so, E);
        if (L == 0) { SIDE_BEGIN(SLK, G - SLK) CV_GU1Q(31, sf_, ss_); SIDE_END() }
    }
    SYNC(P_GU2);
    if (IN(P_D2)) {
        pg8::Gemm g{act, (const bf16_t*)(ws + W_D2), S, D, FF}; pg8::StaticOrder so; so.init(S, D, G, bx);
        if (L == 0) { EpiRes<true, false, false, true> E{rb, rb, hq, RSP(4), qs, RSP(3)}; pg8::gemm_phase(lds, g, so, E); }
        else { EpiRes<true, false, true, false> E{hb, a.out, nullptr, nullptr, nullptr, nullptr}; pg8::gemm_phase(lds, g, so, E); }
    }
    SYNC(P_D2);
#undef IN
#undef SYNC
}

__global__ void __launch_bounds__(NTHREADS, 2) mk_fwd(Args a) {
    extern __shared__ __attribute__((aligned(16))) unsigned char lds_raw[];
    LAS unsigned char* lds = (LAS unsigned char*)lds_raw;
    cg::grid_group grid = cg::this_grid();
    const int lo = a.ph_lo, hi = a.ph_hi;
    if (threadIdx.x < 64) ((LAS unsigned*)(lds + MISC_OFF))[threadIdx.x] = 0u;
    __syncthreads();
    const XcdBarrier xbar = xcd_barrier_post((unsigned*)(a.ws + WS_BAR), (volatile LAS unsigned*)(lds + MISC_OFF) + 8);
    run_layer<0>(a, lds, grid, xbar, lo, hi);
    run_layer<1>(a, lds, grid, xbar, lo, hi);
}

extern "C" void kernel_launch(void* const* d_in, const int* in_sizes, int n_in, void* d_out, int out_size, void* d_ws, size_t ws_size, hipStream_t stream) {
    static int grid = 0;
    if (grid == 0) {
        if (n_in != 52 || out_size != S * D || ws_size < WS_END) { fprintf(stderr, "kernel_launch: unexpected shapes n_in %d out %d ws %zu\n", n_in, out_size, ws_size); grid = -1; return; }
        int dev = 0, cus = 0, per_cu = 0;
        (void)hipGetDevice(&dev); (void)hipDeviceGetAttribute(&cus, hipDeviceAttributeMultiprocessorCount, dev);
        (void)hipFuncSetAttribute((const void*)mk_fwd, hipFuncAttributeMaxDynamicSharedMemorySize, LDS_BYTES);
        (void)hipOccupancyMaxActiveBlocksPerMultiprocessor(&per_cu, (const void*)mk_fwd, NTHREADS, LDS_BYTES);
        if (per_cu < 1) { fprintf(stderr, "kernel_launch: occupancy query says %d\n", per_cu); per_cu = 1; }
        grid = cus * 1;
        (void)hipGetLastError();
    }
    if (grid < 0) return;
    Args a{};
    for (int i = 0; i < 52; ++i) a.in[i] = (const float*)d_in[i];
    a.out = (float*)d_out; a.ws = (unsigned char*)d_ws;
    a.ph_lo = 0; a.ph_hi = DBG_LAST;
    void* args[] = {&a};
    hipError_t e = hipLaunchCooperativeKernel((const void*)mk_fwd, dim3(grid), dim3(NTHREADS), args, LDS_BYTES, stream);
    if (e != hipSuccess) fprintf(stderr, "kernel_launch: cooperative launch failed: %s\n", hipGetErrorString(e));
}
```
